# Optimizing an MI355X kernel written in HIP

```python
import jax, jax.numpy as jnp
from jax import lax
import numpy as np

D_MODEL = 2048
BATCH = 1
SEQ = 8192
DEPTH = 2

CHUNK = 64
N_META = 16
N_BRANCH = 4
MIX_W = D_MODEL // 4
FOX_HEADS = 4
FOX_HD = MIX_W // FOX_HEADS
FOX_FORGET_BIAS = 3.0
Q_BLOCK = 128
GLA_HEADS = 4
GLA_DK = MIX_W // (2 * GLA_HEADS)
GLA_DV = MIX_W // GLA_HEADS
GLA_RANK = 16
GLA_TAU = 16.0
CONV_W = MIX_W
CONV_K = 3
POOL_WINDOWS = (2, 4, 8, 16)
POOL_GROUPS = len(POOL_WINDOWS)
POOL_GW = MIX_W // POOL_GROUPS
N_EXPERTS = 32
N_GROUPS = 8
EXPERTS_PER_GROUP = N_EXPERTS // N_GROUPS
TOP_K = 2
D_EXPERT = D_MODEL // 2
EXPERT_BLOCK = 128
LN_EPS = 1e-5
DEEPNORM_ALPHA = (2 * DEPTH) ** 0.25
DEEPNORM_BETA = (8 * DEPTH) ** -0.25

IN_SPLITS = (
    MIX_W, MIX_W, MIX_W, FOX_HEADS,
    GLA_HEADS * GLA_DK, GLA_HEADS * GLA_DK, MIX_W, GLA_RANK, MIX_W,
    CONV_W, CONV_W, CONV_W,
    MIX_W,
    N_BRANCH * D_MODEL,
)
P_IN = sum(IN_SPLITS)

kernel_name = 'hybrid_fox_gla_conv_pool_grouped_moe'


def layer_norm(x, g, b):
    xf = x.astype(jnp.float32)
    mu = jnp.mean(xf, -1, keepdims=True)
    var = jnp.mean(jnp.square(xf - mu), -1, keepdims=True)
    return ((xf - mu) * lax.rsqrt(var + LN_EPS) * g + b).astype(x.dtype)


def rms_norm(x, g):
    xf = x.astype(jnp.float32)
    return xf * lax.rsqrt(jnp.mean(jnp.square(xf), -1, keepdims=True) + LN_EPS) * g


def forgetting_attention(q, k, v, log_f):
    bn, seq_len, n_h, hd = q.shape
    lp = -(-seq_len // Q_BLOCK) * Q_BLOCK
    pad = lp - seq_len
    pw = ((0, 0), (0, pad), (0, 0), (0, 0))
    q, k, v = jnp.pad(q, pw), jnp.pad(k, pw), jnp.pad(v, pw)
    c = jnp.pad(jnp.cumsum(log_f, axis=1), ((0, 0), (0, pad), (0, 0)), mode='edge')
    c = jnp.transpose(c, (0, 2, 1))
    k_pos = jnp.arange(lp)
    scale = hd ** -0.5

    def query_block(i):
        start = i * Q_BLOCK
        qb = lax.dynamic_slice_in_dim(q, start, Q_BLOCK, axis=1)
        cq = lax.dynamic_slice_in_dim(c, start, Q_BLOCK, axis=2)
        s = jnp.einsum('bqhd,bkhd->bhqk', qb, k).astype(jnp.float32) * scale
        s = s + cq[..., :, None] - c[..., None, :]
        q_pos = start + jnp.arange(Q_BLOCK)
        s = jnp.where(k_pos[None, :] <= q_pos[:, None], s, -jnp.inf)
        p = jax.nn.softmax(s, axis=-1).astype(v.dtype)
        return jnp.einsum('bhqk,bkhd->bqhd', p, v)

    out = lax.map(query_block, jnp.arange(lp // Q_BLOCK))
    out = jnp.moveaxis(out, 0, 1).reshape(bn, lp, n_h, hd)
    return out[:, :seq_len]


def gated_linear_attention(q, k, v, log_a):
    bn, seq_len, n_h, dk = q.shape
    dv = v.shape[-1]
    front = (-N_META) % CHUNK
    back = (-(front + seq_len)) % CHUNK
    pw = ((0, 0), (front, back), (0, 0), (0, 0))
    f32 = jnp.float32
    q = jnp.pad(q.astype(f32) * dk ** -0.5, pw)
    k = jnp.pad(k.astype(f32), pw)
    v = jnp.pad(v.astype(f32), pw)
    log_a = jnp.pad(log_a.astype(f32), pw)
    n_chunks = (front + seq_len + back) // CHUNK

    def to_chunks(a):
        return jnp.moveaxis(a.reshape(bn, n_chunks, CHUNK, n_h, a.shape[-1]), 1, 0)

    tri = jnp.tril(jnp.ones((CHUNK, CHUNK), dtype=bool))

    def chunk_step(state, inp):
        qc, kc, vc, gc = inp
        bc = jnp.cumsum(gc, axis=1)
        o_inter = jnp.einsum('bthk,bhkv->bthv', qc * jnp.exp(bc), state)
        diff = bc[:, :, None] - bc[:, None, :]
        decay = jnp.exp(jnp.where(tri[None, :, :, None, None], diff, -jnp.inf))
        att = jnp.einsum('bthk,bshk,btshk->bths', qc, kc, decay)
        o_intra = jnp.einsum('bths,bshv->bthv', att, vc)
        last = bc[:, -1]
        state = jnp.exp(last)[..., None] * state + jnp.einsum(
            'bshk,bshv->bhkv', kc * jnp.exp(last[:, None] - bc), vc)
        return state, o_intra + o_inter

    s0 = jnp.zeros((bn, n_h, dk, dv), f32)
    _, out = lax.scan(chunk_step, s0, (to_chunks(q), to_chunks(k), to_chunks(v), to_chunks(log_a)))
    out = jnp.moveaxis(out, 0, 1).reshape(bn, n_chunks * CHUNK, n_h, dv)
    return out[:, front:front + seq_len]


def short_gated_conv(b_gate, c_gate, val, conv_w):
    u = c_gate * val
    y = lax.conv_general_dilated(
        u, conv_w.astype(u.dtype)[:, None, :], window_strides=(1,),
        padding=[(CONV_K - 1, 0)], dimension_numbers=('NWC', 'WIO', 'NWC'),
        feature_group_count=u.shape[-1])
    return b_gate * y


def multiscale_pool(p, pool_w, pool_scale):
    seq_len = p.shape[1]
    pf = p.astype(jnp.float32)
    t1 = jnp.arange(1, seq_len + 1, dtype=jnp.float32)
    outs = []
    for g, w in enumerate(POOL_WINDOWS):
        xg = pf[..., g * POOL_GW:(g + 1) * POOL_GW]
        cs = jnp.cumsum(xg, axis=1)
        lower = jnp.pad(cs[:, :seq_len - w], ((0, 0), (w, 0), (0, 0)))
        cnt = jnp.minimum(t1, float(w))[None, :, None]
        pooled = (cs - lower) / cnt - xg
        outs.append(jnp.einsum('blc,cd->bld', pooled.astype(p.dtype), pool_w[g]))
    return jnp.concatenate(outs, axis=-1) * pool_scale


def grouped_moe(x, router_w, router_b, w_gate, w_up, w_down):
    bn, seq_len, d = x.shape
    n_tok = bn * seq_len
    xt = x.reshape(n_tok, d)
    logits = jnp.dot(xt.astype(jnp.float32), router_w.astype(jnp.float32))
    aff = jax.nn.sigmoid(logits)
    sel = (aff + router_b.astype(jnp.float32)).reshape(n_tok, N_GROUPS, EXPERTS_PER_GROUP)
    group_score = jnp.sum(lax.top_k(sel, TOP_K)[0], axis=-1)
    grp = jnp.argmax(group_score, axis=-1)
    tok_ids = jnp.arange(n_tok)
    _, idx = lax.top_k(sel[tok_ids, grp], TOP_K)
    eid = grp[:, None] * EXPERTS_PER_GROUP + idx
    wts = aff[tok_ids[:, None], eid]
    wts = wts / jnp.sum(wts, axis=-1, keepdims=True)

    flat_e = eid.reshape(-1)
    flat_tok = jnp.repeat(tok_ids, TOP_K)
    flat_w = wts.reshape(-1)
    order = jnp.argsort(flat_e)
    se = flat_e[order]
    counts = jnp.bincount(flat_e, length=N_EXPERTS)
    padded = (counts + EXPERT_BLOCK - 1) // EXPERT_BLOCK * EXPERT_BLOCK
    pad_end = jnp.cumsum(padded)
    pad_start = pad_end - padded
    start = jnp.cumsum(counts) - counts
    dest = pad_start[se] + jnp.arange(n_tok * TOP_K) - start[se]
    n_blocks = -(-(n_tok * TOP_K) // EXPERT_BLOCK) + N_EXPERTS
    n_rows = n_blocks * EXPERT_BLOCK
    row_tok = jnp.full((n_rows,), n_tok, dtype=jnp.int32).at[dest].set(flat_tok[order].astype(jnp.int32))
    row_w = jnp.zeros((n_rows,), jnp.float32).at[dest].set(flat_w[order])
    block_e = jnp.minimum(
        jnp.searchsorted(pad_end, jnp.arange(n_blocks) * EXPERT_BLOCK, side='right'), N_EXPERTS - 1)
    x_rows = jnp.concatenate([xt, jnp.zeros((1, d), xt.dtype)], axis=0)[row_tok]
    x_rows = x_rows.reshape(n_blocks, EXPERT_BLOCK, d)

    def expert_block(args):
        xb, e = args
        h = jax.nn.silu(xb @ w_gate[e]) * (xb @ w_up[e])
        return h @ w_down[e]

    y_rows = lax.map(expert_block, (x_rows, block_e)).reshape(n_rows, d)
    out = jax.ops.segment_sum(y_rows.astype(jnp.float32) * row_w[:, None], row_tok,
                              num_segments=n_tok + 1)[:n_tok]
    return out.reshape(bn, seq_len, d).astype(x.dtype)


def setup_inputs(seed: int = 0) -> dict:
    key = jax.random.key(seed)
    ks = jax.random.split(key, 24)
    f32 = jnp.float32

    def nrm(k, shape, scale):
        return jax.random.normal(k, shape, f32) * scale

    return {
        'x': nrm(ks[0], (BATCH, SEQ, D_MODEL), 1.0),
        'meta_tokens': nrm(ks[1], (N_META, D_MODEL), 1.0),
        'ln_in_g': 1.0 + nrm(ks[2], (D_MODEL,), 0.02),
        'ln_in_b': nrm(ks[3], (D_MODEL,), 0.02),
        'w_in': nrm(ks[4], (DEPTH, D_MODEL, P_IN), D_MODEL ** -0.5),
        'fox_f_bias': FOX_FORGET_BIAS + nrm(ks[5], (DEPTH, FOX_HEADS), 0.5),
        'gla_wa2': nrm(ks[6], (DEPTH, GLA_RANK, GLA_HEADS * GLA_DK), GLA_RANK ** -0.5),
        'gla_ba': nrm(ks[7], (DEPTH, GLA_HEADS * GLA_DK), 0.1),
        'gla_norm_g': 1.0 + nrm(ks[8], (DEPTH, MIX_W), 0.02),
        'conv_w': nrm(ks[9], (DEPTH, CONV_K, CONV_W), CONV_K ** -0.5),
        'pool_w': nrm(ks[10], (DEPTH, POOL_GROUPS, POOL_GW, POOL_GW), POOL_GW ** -0.5),
        'pool_scale': 1.0 + nrm(ks[11], (DEPTH, MIX_W), 0.02),
        'gate_b': nrm(ks[12], (DEPTH, N_BRANCH, D_MODEL), 0.02),
        'w_branch': nrm(ks[13], (DEPTH, N_BRANCH, MIX_W, D_MODEL), MIX_W ** -0.5),
        'w_out': nrm(ks[14], (DEPTH, D_MODEL, D_MODEL), D_MODEL ** -0.5 * DEEPNORM_BETA),
        'ln1_g': 1.0 + nrm(ks[15], (DEPTH, D_MODEL), 0.02),
        'ln1_b': nrm(ks[16], (DEPTH, D_MODEL), 0.02),
        'router_w': nrm(ks[17], (D_MODEL, N_EXPERTS), D_MODEL ** -0.5),
        'router_b': nrm(ks[18], (N_EXPERTS,), 0.01),
        'w_gate': nrm(ks[19], (DEPTH, N_EXPERTS, D_MODEL, D_EXPERT), D_MODEL ** -0.5),
        'w_up': nrm(ks[20], (DEPTH, N_EXPERTS, D_MODEL, D_EXPERT), D_MODEL ** -0.5),
        'w_down': nrm(ks[21], (DEPTH, N_EXPERTS, D_EXPERT, D_MODEL), D_EXPERT ** -0.5 * DEEPNORM_BETA),
        'ln2_g': 1.0 + nrm(ks[22], (DEPTH, D_MODEL), 0.02),
        'ln2_b': nrm(ks[23], (DEPTH, D_MODEL), 0.02),
    }


def reference(x, meta_tokens, ln_in_g, ln_in_b, w_in, fox_f_bias, gla_wa2, gla_ba, gla_norm_g,
              conv_w, pool_w, pool_scale, gate_b, w_branch, w_out, ln1_g, ln1_b,
              router_w, router_b, w_gate, w_up, w_down, ln2_g, ln2_b):
    bn = x.shape[0]
    meta = jnp.broadcast_to(meta_tokens[None].astype(x.dtype), (bn, N_META, D_MODEL))
    h = layer_norm(jnp.concatenate([meta, x], axis=1), ln_in_g, ln_in_b)
    seq_len = h.shape[1]
    offsets = [int(o) for o in np.cumsum(IN_SPLITS)[:-1]]
    for l in range(DEPTH):
        z = jnp.einsum('bld,dp->blp', h, w_in[l])
        (fq, fk, fv, ff, gq, gk, gv, ga, gr, cb, cc, cv, pz, gz) = jnp.split(z, offsets, axis=-1)
        log_f = jax.nn.log_sigmoid((ff + fox_f_bias[l]).astype(jnp.float32))
        o_a = forgetting_attention(
            fq.reshape(bn, seq_len, FOX_HEADS, FOX_HD), fk.reshape(bn, seq_len, FOX_HEADS, FOX_HD),
            fv.reshape(bn, seq_len, FOX_HEADS, FOX_HD), log_f).reshape(bn, seq_len, MIX_W)
        log_a = jax.nn.log_sigmoid((ga @ gla_wa2[l] + gla_ba[l]).astype(jnp.float32)) / GLA_TAU
        o = gated_linear_attention(
            gq.reshape(bn, seq_len, GLA_HEADS, GLA_DK), gk.reshape(bn, seq_len, GLA_HEADS, GLA_DK),
            gv.reshape(bn, seq_len, GLA_HEADS, GLA_DV), log_a.reshape(bn, seq_len, GLA_HEADS, GLA_DK))
        o = rms_norm(o, gla_norm_g[l].reshape(GLA_HEADS, GLA_DV)).reshape(bn, seq_len, MIX_W)
        o_b = (o * jax.nn.silu(gr.astype(jnp.float32))).astype(h.dtype)
        o_c = short_gated_conv(cb, cc, cv, conv_w[l])
        o_d = multiscale_pool(pz, pool_w[l], pool_scale[l])
        gates = jax.nn.sigmoid(gz.reshape(bn, seq_len, N_BRANCH, D_MODEL) + gate_b[l])
        mixed = gates[:, :, 0] * jnp.einsum('blc,cd->bld', o_a, w_branch[l, 0])
        for b, ob in ((1, o_b), (2, o_c), (3, o_d)):
            mixed = mixed + gates[:, :, b] * jnp.einsum('blc,cd->bld', ob, w_branch[l, b])
        mix_out = jnp.einsum('bld,de->ble', mixed.astype(h.dtype), w_out[l])
        h = layer_norm(DEEPNORM_ALPHA * h + mix_out, ln1_g[l], ln1_b[l])
        ffn_out = grouped_moe(h, router_w, router_b, w_gate[l], w_up[l], w_down[l])
        h = layer_norm(DEEPNORM_ALPHA * h + ffn_out, ln2_g[l], ln2_b[l])
    return h[:, N_META:]
```

```cpp
#include <hip/hip_runtime.h>
#include <cstdio>
#include <cstdint>

#ifndef MK_PER_PHASE
#define MK_PER_PHASE 0
#endif
#ifndef MK_REPEAT
#define MK_REPEAT 0u
#endif
#ifndef MK_REPBAR
#define MK_REPBAR 0
#endif
#ifndef MK_MASK
#define MK_MASK 0xFFFu
#endif

#define GAS __attribute__((address_space(1)))
#define LAS __attribute__((address_space(3)))
typedef unsigned short bf16;
typedef unsigned short bf16_t;
typedef short bf16x8 __attribute__((ext_vector_type(8)));
typedef short s16x4 __attribute__((ext_vector_type(4)));
typedef float f32x4 __attribute__((ext_vector_type(4)));
typedef float f32x2 __attribute__((ext_vector_type(2)));
typedef float f32x16 __attribute__((ext_vector_type(16)));
typedef unsigned u32x4 __attribute__((ext_vector_type(4)));
typedef unsigned u32x2 __attribute__((ext_vector_type(2)));
typedef GAS unsigned gu32;
#define RLX_AGENT __ATOMIC_RELAXED, __HIP_MEMORY_SCOPE_AGENT
#define LDS_WAIT() asm volatile("s_waitcnt lgkmcnt(0)" ::: "memory")
#define VM_WAIT() asm volatile("s_waitcnt vmcnt(0)" ::: "memory")
#define SBAR() __builtin_amdgcn_sched_barrier(0)

constexpr int D = 2048, SEQ = 8192, NMETA = 16, NTOK = SEQ + NMETA  , MP = 8448  , DEPTH = 2;
constexpr int MIXW = 512, P_IN = 13332, NIN_T = 13568  , ZP = 13312  ;
constexpr int NEXP = 32, DEXP = 1024, NROWS_MAX = 24576;
constexpr float LN_EPS = 1e-5f, ALPHA = 1.41421356237309515f, LOG2E = 1.4426950408889634f;
constexpr int ZC_FQ = 0, ZC_FK = 512, ZC_FV = 1024, ZC_GQ = 1536, ZC_GK = 1792, ZC_GV = 2048, ZC_GR = 2560, ZC_CB = 3072, ZC_CC = 3584, ZC_CV = 4096, ZC_PZ = 4608, ZC_GZ = 5120;
constexpr int NCHUNK = 129, GLA_FRONT = 48;
constexpr int ATT_SEG = 20, ATT_NQB = 33, ATT_MAXNS = 7;
__host__ __device__ constexpr int att_ns(int qb) { return (qb + 5) / 5; }
__host__ __device__ constexpr int att_sbase(int s) { return 4 * (33 * s - 5 * s * (s - 1) / 2); }
constexpr int ATT_NU = att_sbase(ATT_MAXNS);
static_assert(att_ns(32) == ATT_MAXNS && ATT_NU == 504, "attention unit table");
constexpr int SCAN_ITEMS = 64;

constexpr size_t al256(size_t x) { return (x + 255) & ~(size_t)255; }
constexpr size_t WS_CTL = 0, CTL_BYTES = 1u << 20;
constexpr size_t WS_HF = WS_CTL + CTL_BYTES;
constexpr size_t WS_HB = WS_HF + al256((size_t)MP * D * 4);
constexpr size_t WS_Z = WS_HB + al256((size_t)MP * D * 2);
constexpr size_t WS_ZS = WS_Z + al256((size_t)MP * ZP * 2);
constexpr size_t WS_C2 = WS_ZS + al256((size_t)MP * 32 * 4);
constexpr size_t WS_OM = WS_C2 + al256((size_t)4 * MP * 4);
constexpr size_t WS_OPART = WS_OM + al256((size_t)MP * D * 2);
constexpr size_t WS_ML = WS_OPART + al256((size_t)ATT_NU * 256 * 128 * 4);
constexpr size_t WS_UT = WS_ML + al256((size_t)ATT_NU * 256 * 2 * 4);
constexpr size_t WS_DEC = WS_UT + al256((size_t)NCHUNK * 4 * 128 * 64 * 4);
constexpr size_t WS_ST = WS_DEC + al256((size_t)NCHUNK * 4 * 64 * 4);
constexpr size_t WS_MXF = WS_ST + al256((size_t)NCHUNK * 4 * 128 * 64 * 2);
constexpr size_t WS_MX = WS_MXF + al256((size_t)MP * D * 4);
constexpr size_t WS_MO = WS_MX + al256((size_t)MP * D * 2);
constexpr size_t WS_EID = WS_MO + al256((size_t)MP * D * 4);
constexpr size_t WS_WTS = WS_EID + al256((size_t)MP * 2 * 4);
constexpr size_t WS_DST = WS_WTS + al256((size_t)MP * 2 * 4);
constexpr size_t WS_XR = WS_DST + al256((size_t)MP * 2 * 4);
constexpr size_t WS_HM = WS_XR + al256((size_t)NROWS_MAX * D * 2);
constexpr size_t WS_Y = WS_HM + al256((size_t)NROWS_MAX * DEXP * 2);
constexpr size_t WS_WIN = WS_Y + al256((size_t)NROWS_MAX * D * 2);
constexpr size_t WS_WBR = WS_WIN + al256((size_t)DEPTH * NIN_T * D * 2);
constexpr size_t WS_WOUT = WS_WBR + al256((size_t)DEPTH * D * D * 2);
constexpr size_t WS_PW = WS_WOUT + al256((size_t)DEPTH * D * D * 2);
constexpr size_t WS_HQ = WS_PW + al256((size_t)DEPTH * 4 * 128 * 128 * 2);
constexpr size_t WS_WQ = WS_HQ + al256((size_t)MP * D);
constexpr size_t WS_CNT = WS_WQ + al256((size_t)DEPTH * 4 * D * D);
constexpr size_t WS_END = WS_CNT + al256((size_t)DEPTH * 2 * (NTOK / 16) * NEXP * 4);
constexpr float WQ_SCALE = 32.f;
static_assert(WS_END <= 2147483648ull, "workspace map exceeds 4x the largest input tensor");

constexpr int CW_TMO = 0;
constexpr int CW_QATT = 64;
constexpr int CW_ECNT = 256;
constexpr int CW_NRM = 1024;
constexpr int CW_BAR = 4096;
constexpr int CW_RDY = 8192;
constexpr int CW_QG1 = 10240;
constexpr int CW_QMOE = 9216;

constexpr int LDS_BYTES = 147456, LDSCTL_OFF = LDS_BYTES - 1024, MISC_OFF = LDSCTL_OFF;
constexpr int NWAVES = 8;

__device__ __forceinline__ int opaque_tid() { int t = threadIdx.x; asm volatile("" : "+v"(t)); return t; }
__device__ __forceinline__ unsigned f2bf(float f) { unsigned u = __builtin_bit_cast(unsigned, f); return (u + 0x7fffu + ((u >> 16) & 1u)) >> 16; }
__device__ __forceinline__ unsigned pk2(float lo, float hi) { return f2bf(lo) | (f2bf(hi) << 16); }
__device__ __forceinline__ unsigned pk4_fp8(float a, float b, float c, float d) {
    a = fminf(fmaxf(a, -448.f), 448.f); b = fminf(fmaxf(b, -448.f), 448.f); c = fminf(fmaxf(c, -448.f), 448.f); d = fminf(fmaxf(d, -448.f), 448.f);
    int w = 0; w = __builtin_amdgcn_cvt_pk_fp8_f32(a, b, w, false); w = __builtin_amdgcn_cvt_pk_fp8_f32(c, d, w, true); return (unsigned)w; }
__device__ __forceinline__ float bf2f(unsigned short b) { return __builtin_bit_cast(float, ((unsigned)b) << 16); }
__device__ __forceinline__ float bflo(unsigned w) { return __builtin_bit_cast(float, w << 16); }
__device__ __forceinline__ float bfhi(unsigned w) { return __builtin_bit_cast(float, w & 0xffff0000u); }
__device__ __forceinline__ unsigned cvt_pk_bf16(float lo, float hi) { unsigned r; asm volatile("v_cvt_pk_bf16_f32 %0, %1, %2" : "=v"(r) : "v"(lo), "v"(hi)); return r; }
__device__ __forceinline__ float wave_sum(float v) {
#pragma unroll
    for (int o = 1; o < 64; o <<= 1) v += __shfl_xor(v, o);
    return v;
}
__device__ __forceinline__ float sigmoidf_fast(float x) { return __builtin_amdgcn_rcpf(1.0f + __builtin_amdgcn_exp2f(-x * LOG2E)); }
__device__ __forceinline__ float log_sigmoidf(float x) { return fminf(x, 0.f) - log1pf(__expf(-fabsf(x))); }

namespace pg8 {
constexpr int BM = 256, BK = 64, HALF = 128, HTB = HALF * BK * 2, STAGE_BYTES = 8 * HTB, NXCD = 8, WGM = 8;
__host__ __device__ __forceinline__ int lds_byte(int r, int c) { const int st = (r >> 4) * 2 + (c >> 5), rr = r & 15, cc = c & 31, ob = rr * 64 + cc * 2; return st * 1024 + (ob ^ (((ob >> 9) & 1) << 5)); }
__host__ __device__ __forceinline__ void stage_rc(int b, int& R, int& C) { const int st = b / 1024, sb = b % 1024, swz = sb ^ (((sb >> 9) & 1) << 5); R = (st >> 1) * 16 + swz / 64; C = (st & 1) * 32 + (swz % 64) / 2; }
__host__ __device__ __forceinline__ int perm32(int rho) { const int n = rho >> 4, i = rho & 15; return 8 * (i >> 2) + 4 * n + (i & 3); }

struct Unit { const char* A; const char* B; int pm, pn, aux, aux2; };
struct Gemm { int lda, ldb, K; };

__device__ __forceinline__ void tile_of(int L, int nM, int nN, int& pm, int& pn) {
    const int nwg = nM * nN; int wgid = L; { const int q = nwg / NXCD, r = nwg % NXCD, xcd = wgid % NXCD, off = wgid / NXCD; wgid = (xcd < r ? xcd * (q + 1) : r * (q + 1) + (xcd - r) * q) + off; }
    const int nig = WGM * nN, gid = wgid / nig, fm = gid * WGM, gsz = (nM - fm) < WGM ? (nM - fm) : WGM;
    pm = fm + ((wgid % nig) % gsz); pn = (wgid % nig) / gsz;
}

__device__ __forceinline__ void ho_arrive(unsigned* cnt);
typedef int i32x8 __attribute__((ext_vector_type(8))); typedef int i32x4v __attribute__((ext_vector_type(4)));
__device__ __forceinline__ i32x8 cat8(bf16x8 a, bf16x8 b) { const i32x4v x = __builtin_bit_cast(i32x4v, a), y = __builtin_bit_cast(i32x4v, b); return __builtin_shufflevector(x, y, 0, 1, 2, 3, 4, 5, 6, 7); }
template <bool F8> struct FragSel { typedef bf16x8 T; };
template <> struct FragSel<true> { typedef i32x8 T; };
template <class T> __device__ __forceinline__ T frag_one(bf16x8 a);
template <> __device__ __forceinline__ bf16x8 frag_one<bf16x8>(bf16x8 a) { return a; }
template <> __device__ __forceinline__ i32x8 frag_one<i32x8>(bf16x8 a) { return cat8(a, a); }
template <class T> __device__ __forceinline__ T frag_cat(bf16x8 a, bf16x8 b);
template <> __device__ __forceinline__ bf16x8 frag_cat<bf16x8>(bf16x8 a, bf16x8) { return a; }
template <> __device__ __forceinline__ i32x8 frag_cat<i32x8>(bf16x8 a, bf16x8 b) { return cat8(a, b); }
__device__ __forceinline__ f32x4 frag_mma(bf16x8 b, bf16x8 a, f32x4 c) { return __builtin_amdgcn_mfma_f32_16x16x32_bf16(b, a, c, 0, 0, 0); }
__device__ __forceinline__ f32x4 frag_mma(i32x8 b, i32x8 a, f32x4 c) {
    asm volatile("v_mfma_f32_16x16x128_f8f6f4 %0, %1, %2, %0" : "+v"(c) : "v"(b), "v"(a)); return c; }
template <class Epi, class Sched, bool ALIGN_EPI = true, bool F8 = false>
__device__ __forceinline__ void gemm_phase(LAS unsigned char* lds, const Gemm g, const Sched& S, const Epi& E) {
    const int tid = opaque_tid(), wid = __builtin_amdgcn_readfirstlane(tid >> 6), lane = tid & 63, wr = wid >> 2, wc = wid & 3, fr = lane & 15, fq = lane >> 4;
    using FragT = typename FragSel<F8>::T; constexpr int NKF = F8 ? 1 : 2;
    const int K = g.K, nt = K / BK;
    unsigned voffA[2], voffB[2];
#pragma unroll
    for (int i = 0; i < 2; ++i) { int R, C; stage_rc(tid * 16 + i * 8192, R, C); const int Rb = Epi::PERM ? ((R & ~31) + perm32(R & 31)) : R;
        voffA[i] = (unsigned)(R * g.lda + C) * 2u; voffB[i] = (unsigned)(Rb * g.ldb + C) * 2u; }
    const size_t kstep = (size_t)(BK * 2);
    const size_t hstepA = (size_t)HALF * g.lda * 2, hstepB = (size_t)HALF * g.ldb * 2;
    const unsigned ldsw = (unsigned)wid * 1024u;
    const int aoff = F8 ? lds_byte(wr * 64 + fr, (fq >> 1) * 32 + (fq & 1) * 16) : lds_byte(wr * 64 + fr, fq * 8), boff = F8 ? lds_byte(wc * 32 + fr, (fq >> 1) * 32 + (fq & 1) * 16) : lds_byte(wc * 32 + fr, fq * 8);
#define PG8_SA(b, h) (((b) * 2 + (h)) * HTB)
#define PG8_SB(b, h) ((4 + (b) * 2 + (h)) * HTB)
#define PG8_STAGE(bufoff, gbase, voff) do { _Pragma("unroll") for (int _i = 0; _i < 2; ++_i) \
        __builtin_amdgcn_global_load_lds((const unsigned*)((const char*)(gbase) + (voff)[_i]), (LAS unsigned*)(lds + (bufoff) + ldsw + _i * 8192), 16, 0, 0); } while (0)
#define PG8_LD1(dst, base) do { _Pragma("unroll") for (int k = 0; k < NKF; ++k) dst[k] = *(const LAS FragT*)(lds + (base) + k * 1024); } while (0)
#define PG8_LDA(dst, b, h) do { _Pragma("unroll") for (int m = 0; m < 4; ++m) PG8_LD1(dst[m], PG8_SA(b, h) + aoff + m * 2048); } while (0)
#define PG8_LDB(dst, b, h) do { _Pragma("unroll") for (int n = 0; n < 2; ++n) PG8_LD1(dst[n], PG8_SB(b, h) + boff + n * 2048); } while (0)
#define PG8_MMA(ai, bj, At, Bt) do { __builtin_amdgcn_s_setprio(1); _Pragma("unroll") for (int m = 0; m < 4; ++m) _Pragma("unroll") for (int n = 0; n < 2; ++n) { \
        _Pragma("unroll") for (int k = 0; k < NKF; ++k) acc[ai][bj][m][n] = frag_mma(Bt[n][k], At[m][k], acc[ai][bj][m][n]); } \
        __builtin_amdgcn_s_setprio(0); } while (0)
#define PG8_WAIT_V(n) asm volatile("s_waitcnt vmcnt(" #n ")" ::: "memory")
#define PG8_WAIT_L(n) asm volatile("s_waitcnt lgkmcnt(" #n ")" ::: "memory")
#define PG8_BAR __builtin_amdgcn_s_barrier()
#define PG8_SCHED __builtin_amdgcn_sched_barrier(0)
    Unit cur, nxt; int ui = 0;
    if (!S.next(0, cur)) return;
    f32x4 acc[2][2][4][2];
#pragma unroll
    for (int a = 0; a < 2; ++a)
#pragma unroll
        for (int b = 0; b < 2; ++b)
#pragma unroll
            for (int m = 0; m < 4; ++m)
#pragma unroll
                for (int n = 0; n < 2; ++n) acc[a][b][m][n] = (f32x4){0.f, 0.f, 0.f, 0.f};
    FragT At[4][NKF], B0[2][NKF], B1[2][NKF];
    const char* cA = cur.A; const char* cB = cur.B;
    PG8_STAGE(PG8_SB(0, 0), cB, voffB); PG8_STAGE(PG8_SB(0, 1), cB + hstepB, voffB); PG8_STAGE(PG8_SA(0, 0), cA, voffA); PG8_STAGE(PG8_SA(0, 1), cA + hstepA, voffA);
    if (wr == 1) PG8_BAR;
    PG8_WAIT_V(2); PG8_BAR;
    PG8_STAGE(PG8_SB(1, 0), cB + kstep, voffB); PG8_STAGE(PG8_SA(1, 0), cA + kstep, voffA); PG8_STAGE(PG8_SB(1, 1), cB + hstepB + kstep, voffB);
    PG8_WAIT_V(6); PG8_BAR;
    for (;;) {
        const bool has_next = S.next(ui + 1, nxt);
        const char* nA = has_next ? nxt.A : cA; const char* nB = has_next ? nxt.B : cB;
        for (int t = 0; t < nt; t += 2) {
            if constexpr (Epi::SEG) { if (t != 0 && (t & 7) == 0) { PG8_SCHED; E.seg(acc, cur, t >> 3, wr, wc, fr, fq); PG8_SCHED; } }
            const bool last = (t == nt - 2);
            const char* a1 = cA + (size_t)(t + 1) * kstep;
            const char* a2 = last ? nA : cA + (size_t)(t + 2) * kstep; const char* b2 = last ? nB : cB + (size_t)(t + 2) * kstep;
            const char* a3 = a2 + kstep; const char* b3 = b2 + kstep;
            PG8_LDB(B0, 0, 0); PG8_LDB(B1, 0, 1); PG8_SCHED; PG8_LDA(At, 0, 0); PG8_STAGE(PG8_SA(1, 1), a1 + hstepA, voffA);
            PG8_WAIT_V(8); PG8_WAIT_L(0); PG8_BAR; PG8_MMA(0, 0, At, B0); PG8_MMA(0, 1, At, B1); PG8_BAR; PG8_SCHED;
            PG8_LDA(At, 0, 1); PG8_STAGE(PG8_SB(0, 0), b2, voffB); PG8_STAGE(PG8_SB(0, 1), b2 + hstepB, voffB); PG8_STAGE(PG8_SA(0, 0), a2, voffA);
            PG8_WAIT_V(8); PG8_WAIT_L(0); PG8_BAR; PG8_MMA(1, 0, At, B0); PG8_MMA(1, 1, At, B1); PG8_BAR; PG8_SCHED;
            PG8_LDB(B0, 1, 0); PG8_LDB(B1, 1, 1); PG8_SCHED; PG8_LDA(At, 1, 0); PG8_STAGE(PG8_SA(0, 1), a2 + hstepA, voffA);
            PG8_WAIT_V(8); PG8_WAIT_L(0); PG8_BAR; PG8_MMA(0, 0, At, B0); PG8_MMA(0, 1, At, B1); PG8_BAR; PG8_SCHED;
            PG8_LDA(At, 1, 1); PG8_STAGE(PG8_SB(1, 0), b3, voffB); PG8_STAGE(PG8_SB(1, 1), b3 + hstepB, voffB); PG8_STAGE(PG8_SA(1, 0), a3, voffA);
            PG8_WAIT_V(8); PG8_WAIT_L(0); PG8_BAR; PG8_MMA(1, 0, At, B0); PG8_MMA(1, 1, At, B1); PG8_BAR; PG8_SCHED;
        }
        if constexpr (ALIGN_EPI) { if (wr == 0) PG8_BAR; }
        if constexpr (F8) asm volatile("s_nop 15\n\ts_nop 15" ::: "memory");
        E(acc, cur, wr, wc, fr, fq);
        if (!has_next) break;
#pragma unroll
        for (int a = 0; a < 2; ++a)
#pragma unroll
            for (int b = 0; b < 2; ++b)
#pragma unroll
                for (int m = 0; m < 4; ++m)
#pragma unroll
                    for (int n = 0; n < 2; ++n) acc[a][b][m][n] = (f32x4){0.f, 0.f, 0.f, 0.f};
        cur = nxt; cA = nA; cB = nB; ++ui;
        if constexpr (ALIGN_EPI) { if (wr == 1) PG8_BAR; }
    }
    PG8_WAIT_V(0);
    if constexpr (!ALIGN_EPI) { if (wr == 0) PG8_BAR; }
    PG8_BAR;
#undef PG8_SA
#undef PG8_SB
#undef PG8_STAGE
#undef PG8_LDA
#undef PG8_LD1
#undef PG8_LDB
#undef PG8_MMA
#undef PG8_WAIT_V
#undef PG8_WAIT_L
#undef PG8_BAR
#undef PG8_SCHED
}

struct UnitF { const char* A; const char* B; const char* B2; int pm, pn, aux, aux2; };
template <class Epi, class Sched>
__device__ __forceinline__ void gemm_phase_breg(LAS unsigned char* lds, const Gemm g, const Sched& S, const Epi& E) {
    static_assert(Epi::PERM, "gemm_phase_breg stages B rows in perm32 order");
    const int tid = opaque_tid(), wid = __builtin_amdgcn_readfirstlane(tid >> 6), lane = tid & 63, wr = wid >> 2, wc = wid & 3, fr = lane & 15, fq = lane >> 4;
    const int K = g.K, nt = K / BK;
    unsigned voffA[2];
#pragma unroll
    for (int i = 0; i < 2; ++i) { int R, C; stage_rc(tid * 16 + i * 8192, R, C); voffA[i] = (unsigned)(R * g.lda + C) * 2u; }
    const size_t kstep = (size_t)(BK * 2);
    const size_t hstepA = (size_t)HALF * g.lda * 2;
    const unsigned ldsw = (unsigned)wid * 1024u;
    const int aoff = lds_byte(wr * 64 + fr, fq * 8), boff = lds_byte(wc * 32 + fr, fq * 8);
    const int bh = wid & 1, kg = (wid >> 1) * 2 + (lane >> 5), nn = 4 * (lane & 31);
    const int rho0 = (nn & ~31) + (((nn & 31) >> 2) & 1) * 16 + (((nn & 31) >> 3) << 2);
    const unsigned bdst = (unsigned)(4 * HTB + bh * HTB + lds_byte(rho0, 8 * kg));
    const unsigned browB = (unsigned)g.ldb * 4u;
    const unsigned bthr = (unsigned)(8 * kg) * browB + (unsigned)nn * 4u;
#define PG8_SA(b, h) (((b) * 2 + (h)) * HTB)
#define PG8_SB(b, h) ((4 + (b) * 2 + (h)) * HTB)
#define PG8_STAGE(bufoff, gbase, voff) do { _Pragma("unroll") for (int _i = 0; _i < 2; ++_i) \
        __builtin_amdgcn_global_load_lds((const unsigned*)((const char*)(gbase) + (voff)[_i]), (LAS unsigned*)(lds + (bufoff) + ldsw + _i * 8192), 16, 0, 0); } while (0)
#define PG8_LDA(dst, b, h) do { _Pragma("unroll") for (int m = 0; m < 4; ++m) _Pragma("unroll") for (int k = 0; k < 2; ++k) dst[m][k] = *(const LAS bf16x8*)(lds + PG8_SA(b, h) + aoff + m * 2048 + k * 1024); } while (0)
#define PG8_LDB(dst, b, h) do { _Pragma("unroll") for (int n = 0; n < 2; ++n) _Pragma("unroll") for (int k = 0; k < 2; ++k) dst[n][k] = *(const LAS bf16x8*)(lds + PG8_SB(b, h) + boff + n * 2048 + k * 1024); } while (0)
#define PG8_MMA(ai, bj, At, Bt) do { __builtin_amdgcn_s_setprio(1); _Pragma("unroll") for (int m = 0; m < 4; ++m) _Pragma("unroll") for (int n = 0; n < 2; ++n) _Pragma("unroll") for (int k = 0; k < 2; ++k) \
        acc[ai][bj][m][n] = __builtin_amdgcn_mfma_f32_16x16x32_bf16(Bt[n][k], At[m][k], acc[ai][bj][m][n], 0, 0, 0); __builtin_amdgcn_s_setprio(0); } while (0)
#define PG8_WAIT_V(n) asm volatile("s_waitcnt vmcnt(" #n ")" ::: "memory")
#define PG8_WAIT_L(n) asm volatile("s_waitcnt lgkmcnt(" #n ")" ::: "memory")
#define PG8_BAR __builtin_amdgcn_s_barrier()
#define PG8_SCHED __builtin_amdgcn_sched_barrier(0)
#define PG8_LOADB(tau) do { const int t_ = (tau); const char* p_ = (t_ < nt ? cBt : nBt); const unsigned o_ = bthr + (unsigned)(t_ < nt ? t_ : t_ - nt) * (64u * browB); \
        asm volatile("s_nop 4\n\tglobal_load_dwordx4 %0, %1, %2" : "=v"(breg[0]) : "v"(o_), "s"(p_) : "memory");     \
        _Pragma("unroll") for (int j_ = 1; j_ < 8; ++j_) asm volatile("global_load_dwordx4 %0, %1, %2" : "=v"(breg[j_]) : "v"(o_ + (unsigned)j_ * browB), "s"(p_) : "memory"); } while (0)
#define PG8_WAITB(n) asm volatile("s_waitcnt vmcnt(" #n ")" : "+v"(breg[0]), "+v"(breg[1]), "+v"(breg[2]), "+v"(breg[3]), "+v"(breg[4]), "+v"(breg[5]), "+v"(breg[6]), "+v"(breg[7]) :: "memory")
#define PG8_WRITEB(buf) do { _Pragma("unroll") for (int i_ = 0; i_ < 4; ++i_) { u32x4 w_; \
            w_.x = cvt_pk_bf16(breg[0][i_], breg[1][i_]); w_.y = cvt_pk_bf16(breg[2][i_], breg[3][i_]); w_.z = cvt_pk_bf16(breg[4][i_], breg[5][i_]); w_.w = cvt_pk_bf16(breg[6][i_], breg[7][i_]); \
            *(LAS u32x4*)(lds + bdst + (buf) * (2 * HTB) + 64 * i_) = w_; } } while (0)
    UnitF cur, nxt; int ui = 0;
    if (!S.next(0, cur)) return;
    f32x4 acc[2][2][4][2];
#pragma unroll
    for (int a = 0; a < 2; ++a)
#pragma unroll
        for (int b = 0; b < 2; ++b)
#pragma unroll
            for (int m = 0; m < 4; ++m)
#pragma unroll
                for (int n = 0; n < 2; ++n) acc[a][b][m][n] = (f32x4){0.f, 0.f, 0.f, 0.f};
    bf16x8 At[4][2], B0[2][2], B1[2][2]; f32x4 breg[8];
    const char* cA = cur.A; const char* cBt = bh ? cur.B2 : cur.B; const char* nBt = cBt;
    PG8_LOADB(0); PG8_STAGE(PG8_SA(0, 0), cA, voffA); PG8_STAGE(PG8_SA(0, 1), cA + hstepA, voffA);
    PG8_WAITB(4); PG8_WRITEB(0);
    PG8_LOADB(1);
    PG8_WAITB(0); PG8_WRITEB(1);
    PG8_LOADB(2); PG8_STAGE(PG8_SA(1, 0), cA + kstep, voffA);
    PG8_WAIT_V(10); PG8_WAIT_L(0);
    if (wr == 1) PG8_BAR;
    PG8_BAR;
    for (;;) {
        const bool has_next = S.next(ui + 1, nxt);
        const char* nA = has_next ? nxt.A : cA; nBt = has_next ? (bh ? nxt.B2 : nxt.B) : cBt;
        for (int t = 0; t < nt; t += 2) {
            const bool last = (t == nt - 2);
            const char* a1 = cA + (size_t)(t + 1) * kstep;
            const char* a2 = last ? nA : cA + (size_t)(t + 2) * kstep;
            const char* a3 = a2 + kstep;
            PG8_LDB(B0, 0, 0); PG8_LDB(B1, 0, 1); PG8_SCHED; PG8_LDA(At, 0, 0); PG8_STAGE(PG8_SA(1, 1), a1 + hstepA, voffA);
            PG8_WAIT_V(12); PG8_WAIT_L(0); PG8_BAR; PG8_MMA(0, 0, At, B0); PG8_MMA(0, 1, At, B1); PG8_BAR; PG8_SCHED;
            PG8_LDA(At, 0, 1); PG8_SCHED; PG8_WAITB(4); PG8_WRITEB(0); PG8_SCHED; PG8_LOADB(t + 3); PG8_STAGE(PG8_SA(0, 0), a2, voffA);
            PG8_WAIT_V(12); PG8_WAIT_L(0); PG8_BAR; PG8_MMA(1, 0, At, B0); PG8_MMA(1, 1, At, B1); PG8_BAR; PG8_SCHED;
            PG8_LDB(B0, 1, 0); PG8_LDB(B1, 1, 1); PG8_SCHED; PG8_LDA(At, 1, 0); PG8_STAGE(PG8_SA(0, 1), a2 + hstepA, voffA);
            PG8_WAIT_V(12); PG8_WAIT_L(0); PG8_BAR; PG8_MMA(0, 0, At, B0); PG8_MMA(0, 1, At, B1); PG8_BAR; PG8_SCHED;
            PG8_LDA(At, 1, 1); PG8_SCHED; PG8_WAITB(4); PG8_WRITEB(1); PG8_SCHED; PG8_LOADB(t + 4); PG8_STAGE(PG8_SA(1, 0), a3, voffA);
            PG8_WAIT_V(12); PG8_WAIT_L(0); PG8_BAR; PG8_MMA(1, 0, At, B0); PG8_MMA(1, 1, At, B1); PG8_BAR; PG8_SCHED;
        }
        if (wr == 0) PG8_BAR;
        E(acc, cur, wr, wc, fr, fq);
        if constexpr (Epi::ARRIVE) ho_arrive(E.ready + cur.pm);
        if (!has_next) break;
#pragma unroll
        for (int a = 0; a < 2; ++a)
#pragma unroll
            for (int b = 0; b < 2; ++b)
#pragma unroll
                for (int m = 0; m < 4; ++m)
#pragma unroll
                    for (int n = 0; n < 2; ++n) acc[a][b][m][n] = (f32x4){0.f, 0.f, 0.f, 0.f};
        cur = nxt; cA = nA; cBt = nBt; ++ui;
        if (wr == 1) PG8_BAR;
    }
    PG8_WAITB(0);
    PG8_BAR;
#undef PG8_SA
#undef PG8_SB
#undef PG8_STAGE
#undef PG8_LDA
#undef PG8_LDB
#undef PG8_MMA
#undef PG8_WAIT_V
#undef PG8_WAIT_L
#undef PG8_BAR
#undef PG8_SCHED
#undef PG8_LOADB
#undef PG8_WAITB
#undef PG8_WRITEB
}
}

namespace pg8 {
struct EpiZ {
    static constexpr bool SEG = false; static constexpr bool PERM = true;
    bf16_t* Z; float* Zs; float sc;
    __device__ __forceinline__ void operator()(const f32x4 (&acc)[2][2][4][2], const Unit& u, int wr, int wc, int fr, int fq) const {
        const int row0 = u.pm * BM + wr * 64 + fr;
        if (u.pn == 52) {
            if (wc == 0 && fq < 3) {
#pragma unroll
                for (int ai = 0; ai < 2; ++ai)
#pragma unroll
                    for (int m = 0; m < 4; ++m) { float* rowp = Zs + (size_t)(row0 + ai * HALF + m * 16) * 32 + 8 * fq;
                        *(GAS f32x4*)(rowp) = acc[ai][0][m][0]; if (fq < 2) *(GAS f32x4*)(rowp + 4) = acc[ai][0][m][1]; }
            }
            return;
        }
        const int col0 = u.pn * BM + wc * 32 + 8 * fq;
#pragma unroll
        for (int ai = 0; ai < 2; ++ai)
#pragma unroll
            for (int m = 0; m < 4; ++m) { bf16_t* rowp = Z + (size_t)(row0 + ai * HALF + m * 16) * ZP + col0;
#pragma unroll
                for (int bj = 0; bj < 2; ++bj) { const f32x4 v0 = acc[ai][bj][m][0], v1 = acc[ai][bj][m][1];
                    u32x4 w; w.x = cvt_pk_bf16(v0[0], v0[1]); w.y = cvt_pk_bf16(v0[2], v0[3]); w.z = cvt_pk_bf16(v1[0], v1[1]); w.w = cvt_pk_bf16(v1[2], v1[3]);
                    *(GAS u32x4*)(rowp + bj * HALF) = w; } }
    }
};
struct EpiZG {
    static constexpr bool SEG = false; static constexpr bool PERM = true;
    bf16_t* Z; const float* gb; float sc;
    __device__ __forceinline__ void operator()(const f32x4 (&acc)[2][2][4][2], const Unit& u, int wr, int wc, int fr, int fq) const {
        const int row0 = u.pm * BM + wr * 64 + fr, col0 = u.pn * BM + wc * 32 + 8 * fq; const float* gq = gb + (col0 - ZC_GZ);
        const float k = -sc * LOG2E, TL = 60.f * LOG2E;
        const f32x4 b00 = *(const GAS f32x4*)(gq) * (-LOG2E), b01 = *(const GAS f32x4*)(gq + 4) * (-LOG2E), b10 = *(const GAS f32x4*)(gq + HALF) * (-LOG2E), b11 = *(const GAS f32x4*)(gq + HALF + 4) * (-LOG2E);
#define ZG_E(t) (1.f + __builtin_amdgcn_exp2f(fminf(fmaxf((t), -TL), TL)))
#pragma unroll
        for (int ai = 0; ai < 2; ++ai)
#pragma unroll
            for (int m = 0; m < 4; ++m) { bf16_t* rowp = Z + (size_t)(row0 + ai * HALF + m * 16) * ZP + col0;
#pragma unroll
                for (int bj = 0; bj < 2; ++bj) { const f32x4 t0 = acc[ai][bj][m][0] * k + (bj ? b10 : b00), t1 = acc[ai][bj][m][1] * k + (bj ? b11 : b01);
                    u32x4 w; w.x = cvt_pk_bf16(ZG_E(t0[0]), ZG_E(t0[1])); w.y = cvt_pk_bf16(ZG_E(t0[2]), ZG_E(t0[3]));
                    w.z = cvt_pk_bf16(ZG_E(t1[0]), ZG_E(t1[1])); w.w = cvt_pk_bf16(ZG_E(t1[2]), ZG_E(t1[3]));
                    *(GAS u32x4*)(rowp + bj * HALF) = w; } }
#undef ZG_E
    }
};
struct EpiMerge {
    static constexpr bool SEG = false; static constexpr bool PERM = true;
    const bf16_t* Z; const float* gate_b; float* MXF; bf16_t* MX; int r0;
    __device__ __forceinline__ void operator()(const f32x4 (&acc)[2][2][4][2], const Unit& u, int wr, int wc, int fr, int fq) const {
        const int row0 = r0 + u.pm * BM + wr * 64 + fr, col0 = u.pn * BM + wc * 32 + 8 * fq, b = u.aux;
        const float* gb = gate_b + b * D + col0;
        f32x4 g0[2], g1[2];
#pragma unroll
        for (int bj = 0; bj < 2; ++bj) { g0[bj] = *(const GAS f32x4*)(gb + bj * HALF); g1[bj] = *(const GAS f32x4*)(gb + bj * HALF + 4); }
        u32x4 zw[2][2]; f32x4 old[2][2][2];
#define EM_LOAD(slot, grp) do { const size_t row_ = (size_t)(row0 + ((grp) >> 2) * HALF + ((grp) & 3) * 16); const bf16_t* zp_ = Z + row_ * ZP + ZC_GZ + b * D + col0; const float* fp_ = MXF + row_ * D + col0; \
        _Pragma("unroll") for (int bj = 0; bj < 2; ++bj) { zw[slot][bj] = *(const GAS u32x4*)(zp_ + bj * HALF); \
            if (b != 0) { old[slot][bj][0] = *(const GAS f32x4*)(fp_ + bj * HALF); old[slot][bj][1] = *(const GAS f32x4*)(fp_ + bj * HALF + 4); } } } while (0)
#define EM_DO(slot, grp) do { const int ai = (grp) >> 2, m = (grp) & 3; const size_t row_ = (size_t)(row0 + ai * HALF + m * 16); float* fp_ = MXF + row_ * D + col0; bf16_t* op_ = MX + row_ * D + col0; \
        _Pragma("unroll") for (int bj = 0; bj < 2; ++bj) { const u32x4 z_ = zw[slot][bj]; f32x4 v0, v1; \
            v0[0] = sigmoidf_fast(bflo(z_.x) + g0[bj][0]) * acc[ai][bj][m][0][0]; v0[1] = sigmoidf_fast(bfhi(z_.x) + g0[bj][1]) * acc[ai][bj][m][0][1]; \
            v0[2] = sigmoidf_fast(bflo(z_.y) + g0[bj][2]) * acc[ai][bj][m][0][2]; v0[3] = sigmoidf_fast(bfhi(z_.y) + g0[bj][3]) * acc[ai][bj][m][0][3]; \
            v1[0] = sigmoidf_fast(bflo(z_.z) + g1[bj][0]) * acc[ai][bj][m][1][0]; v1[1] = sigmoidf_fast(bfhi(z_.z) + g1[bj][1]) * acc[ai][bj][m][1][1]; \
            v1[2] = sigmoidf_fast(bflo(z_.w) + g1[bj][2]) * acc[ai][bj][m][1][2]; v1[3] = sigmoidf_fast(bfhi(z_.w) + g1[bj][3]) * acc[ai][bj][m][1][3]; \
            if (b != 0) { v0 += old[slot][bj][0]; v1 += old[slot][bj][1]; } \
            if (b != 3) { *(GAS f32x4*)(fp_ + bj * HALF) = v0; *(GAS f32x4*)(fp_ + bj * HALF + 4) = v1; } \
            else { u32x4 w_; w_.x = cvt_pk_bf16(v0[0], v0[1]); w_.y = cvt_pk_bf16(v0[2], v0[3]); w_.z = cvt_pk_bf16(v1[0], v1[1]); w_.w = cvt_pk_bf16(v1[2], v1[3]); *(GAS u32x4*)(op_ + bj * HALF) = w_; } } } while (0)
        EM_LOAD(0, 0);
        EM_LOAD(1, 1); EM_DO(0, 0);
        EM_LOAD(0, 2); EM_DO(1, 1);
        EM_LOAD(1, 3); EM_DO(0, 2);
        EM_LOAD(0, 4); EM_DO(1, 3);
        EM_LOAD(1, 5); EM_DO(0, 4);
        EM_LOAD(0, 6); EM_DO(1, 5);
        EM_LOAD(1, 7); EM_DO(0, 6);
        EM_DO(1, 7);
#undef EM_LOAD
#undef EM_DO
    }
};
struct EpiMergeSeg {
    static constexpr bool SEG = true; static constexpr bool PERM = true;
    const bf16_t* Z; const float* gate_b; bf16_t* MX; int r0;
    __device__ __forceinline__ void seg(f32x4 (&acc)[2][2][4][2], const Unit& u, int j, int wr, int wc, int fr, int fq) const {
        const int row0 = r0 + u.pm * BM + wr * 64 + fr, col0 = u.pn * BM + wc * 32 + 8 * fq;
        u32x4 zaA[4], zbA[4], zaB[4], zbB[4];
#define SG_R(zA, zB) ((zB) * __builtin_amdgcn_rcpf(zA))
#define SG_LZ(za, zb, bj, ai) do { const unsigned zoff = (unsigned)((row0 * ZP + ZC_GZ + (j - 1) * D + col0 + (bj) * HALF) * 2); _Pragma("unroll") for (int m = 0; m < 4; ++m) { const unsigned zo_ = zoff + (unsigned)(((ai) * HALF + m * 16) * ZP * 2); \
            za[m] = *(const GAS u32x4*)((const char*)Z + zo_); zb[m] = *(const GAS u32x4*)((const char*)Z + zo_ + D * 2); } } while (0)
#define SG_C(za, zb, bj, ai) do { _Pragma("unroll") for (int m = 0; m < 4; ++m) { const u32x4 a_ = za[m], b_ = zb[m]; \
            const f32x4 r0_ = {__builtin_amdgcn_rcpf(bflo(a_.x)), __builtin_amdgcn_rcpf(bfhi(a_.x)), __builtin_amdgcn_rcpf(bflo(a_.y)), __builtin_amdgcn_rcpf(bfhi(a_.y))}, \
                        r1_ = {__builtin_amdgcn_rcpf(bflo(a_.z)), __builtin_amdgcn_rcpf(bfhi(a_.z)), __builtin_amdgcn_rcpf(bflo(a_.w)), __builtin_amdgcn_rcpf(bfhi(a_.w))}, \
                        e0_ = {bflo(b_.x), bfhi(b_.x), bflo(b_.y), bfhi(b_.y)}, e1_ = {bflo(b_.z), bfhi(b_.z), bflo(b_.w), bfhi(b_.w)}; \
            acc[ai][bj][m][0] *= e0_ * r0_; acc[ai][bj][m][1] *= e1_ * r1_; } } while (0)
        SG_LZ(zaA, zbA, 0, 0); SG_LZ(zaB, zbB, 0, 1);
        __builtin_amdgcn_sched_barrier(0);
        SG_C(zaA, zbA, 0, 0);
        __builtin_amdgcn_sched_barrier(0);
        SG_LZ(zaA, zbA, 1, 0);
        __builtin_amdgcn_sched_barrier(0);
        SG_C(zaB, zbB, 0, 1);
        __builtin_amdgcn_sched_barrier(0);
        SG_LZ(zaB, zbB, 1, 1);
        __builtin_amdgcn_sched_barrier(0);
        SG_C(zaA, zbA, 1, 0);
        __builtin_amdgcn_sched_barrier(0);
        SG_C(zaB, zbB, 1, 1);
#undef SG_R
#undef SG_LZ
#undef SG_C
    }
    __device__ __forceinline__ void operator()(const f32x4 (&acc)[2][2][4][2], const Unit& u, int wr, int wc, int fr, int fq) const {
        const int row0 = r0 + u.pm * BM + wr * 64 + fr, col0 = u.pn * BM + wc * 32 + 8 * fq;
#define FG_G(z, k, n) __builtin_amdgcn_rcpf(z)
#pragma unroll
        for (int bj = 0; bj < 2; ++bj) { u32x4 zz[8]; const unsigned zoff = (unsigned)((row0 * ZP + ZC_GZ + 3 * D + col0 + bj * HALF) * 2);
#pragma unroll
            for (int grp = 0; grp < 8; ++grp) zz[grp] = *(const GAS u32x4*)((const char*)Z + zoff + (unsigned)(((grp >> 2) * HALF + (grp & 3) * 16) * ZP * 2));
#pragma unroll
            for (int grp = 0; grp < 8; ++grp) { const int ai = grp >> 2, m = grp & 3; bf16_t* op_ = MX + (size_t)(row0 + ai * HALF + m * 16) * D + col0; const u32x4 z_ = zz[grp]; u32x4 w_;
                const f32x4 g0_ = {FG_G(bflo(z_.x), 0, 0), FG_G(bfhi(z_.x), 1, 0), FG_G(bflo(z_.y), 2, 0), FG_G(bfhi(z_.y), 3, 0)}, g1_ = {FG_G(bflo(z_.z), 0, 1), FG_G(bfhi(z_.z), 1, 1), FG_G(bflo(z_.w), 2, 1), FG_G(bfhi(z_.w), 3, 1)};
                const f32x4 o0_ = acc[ai][bj][m][0] * g0_, o1_ = acc[ai][bj][m][1] * g1_;
                w_.x = cvt_pk_bf16(o0_[0], o0_[1]); w_.y = cvt_pk_bf16(o0_[2], o0_[3]); w_.z = cvt_pk_bf16(o1_[0], o1_[1]); w_.w = cvt_pk_bf16(o1_[2], o1_[3]);
                *(GAS u32x4*)(op_ + bj * HALF) = w_; } }
#undef FG_G
#define FG_LOAD(a, b)
#undef FG_LOAD
    }
};
struct EpiF32 {
    static constexpr bool SEG = false; static constexpr bool PERM = false;
    float* C; int ldc; int r0;
    __device__ __forceinline__ void operator()(const f32x4 (&acc)[2][2][4][2], const Unit& u, int wr, int wc, int fr, int fq) const {
        const int row0 = r0 + u.pm * BM + wr * 64 + fr, col0 = u.pn * BM + wc * 32 + 4 * fq;
#pragma unroll
        for (int ai = 0; ai < 2; ++ai)
#pragma unroll
            for (int m = 0; m < 4; ++m) { float* rowp = C + (size_t)(row0 + ai * HALF + m * 16) * ldc + col0;
#pragma unroll
                for (int bj = 0; bj < 2; ++bj)
#pragma unroll
                    for (int n = 0; n < 2; ++n) *(GAS f32x4*)(rowp + bj * HALF + n * 16) = acc[ai][bj][m][n]; }
    }
};
struct EpiSwiGLU {
    static constexpr bool SEG = false; static constexpr bool PERM = true; static constexpr bool ARRIVE = true;
    bf16_t* HM; unsigned* ready;
    template <class U> __device__ __forceinline__ void operator()(const f32x4 (&acc)[2][2][4][2], const U& u, int wr, int wc, int fr, int fq) const {
        const int row0 = u.pm * BM + wr * 64 + fr, col0 = u.pn * HALF + wc * 32 + 8 * fq;
#pragma unroll
        for (int ai = 0; ai < 2; ++ai)
#pragma unroll
            for (int m = 0; m < 4; ++m) { bf16_t* rowp = HM + (size_t)(row0 + ai * HALF + m * 16) * DEXP + col0;
                f32x4 hv[2];
#pragma unroll
                for (int n = 0; n < 2; ++n) { const f32x4 g = acc[ai][0][m][n], t = g * (-LOG2E);
                    const f32x4 r = {__builtin_amdgcn_rcpf(1.f + __builtin_amdgcn_exp2f(t[0])), __builtin_amdgcn_rcpf(1.f + __builtin_amdgcn_exp2f(t[1])), __builtin_amdgcn_rcpf(1.f + __builtin_amdgcn_exp2f(t[2])), __builtin_amdgcn_rcpf(1.f + __builtin_amdgcn_exp2f(t[3]))};
                    hv[n] = (g * acc[ai][1][m][n]) * r; }
                u32x4 w; w.x = cvt_pk_bf16(hv[0][0], hv[0][1]); w.y = cvt_pk_bf16(hv[0][2], hv[0][3]); w.z = cvt_pk_bf16(hv[1][0], hv[1][1]); w.w = cvt_pk_bf16(hv[1][2], hv[1][3]);
                *(GAS u32x4*)(rowp) = w; }
    }
};
struct EpiBf16 {
    static constexpr bool SEG = false; static constexpr bool PERM = true; static constexpr bool ARRIVE = false;
    bf16_t* O; int ldc; int r0;
    template <class U> __device__ __forceinline__ void operator()(const f32x4 (&acc)[2][2][4][2], const U& u, int wr, int wc, int fr, int fq) const {
        const int row0 = r0 + u.pm * BM + wr * 64 + fr, col0 = u.pn * BM + wc * 32 + 8 * fq;
#pragma unroll
        for (int ai = 0; ai < 2; ++ai)
#pragma unroll
            for (int m = 0; m < 4; ++m) { bf16_t* rowp = O + (size_t)(row0 + ai * HALF + m * 16) * ldc + col0;
#pragma unroll
                for (int bj = 0; bj < 2; ++bj) { const f32x4 v0 = acc[ai][bj][m][0], v1 = acc[ai][bj][m][1];
                    u32x4 w; w.x = cvt_pk_bf16(v0[0], v0[1]); w.y = cvt_pk_bf16(v0[2], v0[3]); w.z = cvt_pk_bf16(v1[0], v1[1]); w.w = cvt_pk_bf16(v1[2], v1[3]);
                    *(GAS u32x4*)(rowp + bj * HALF) = w; } }
    }
};

struct OrderDense {
    const char* A0; const char* B0; size_t tA, tB; int nM, nN, G, c;
    __device__ __forceinline__ bool next(int i, Unit& u) const {
        const long L = (long)i * G + c; if (L >= (long)nM * nN) return false;
        tile_of((int)L, nM, nN, u.pm, u.pn); u.A = A0 + (size_t)u.pm * tA; u.B = B0 + (size_t)u.pn * tB; u.aux = 0; u.aux2 = 0; return true;
    }
};
struct OrderDenseR {
    const char* A0; const char* B0; size_t tA, tB; int nM, nN, G, c, last_pn;
    __device__ __forceinline__ bool next(int i, Unit& u) const {
        const long L = (long)i * G + c; if (L >= (long)nM * nN) return false;
        tile_of((int)L, nM, nN, u.pm, u.pn); if (u.pn == nN - 1) u.pn = last_pn; u.A = A0 + (size_t)u.pm * tA; u.B = B0 + (size_t)u.pn * tB; u.aux = 0; u.aux2 = 0; return true;
    }
};
struct OrderMerge {
    const char* A0; const char* B0; size_t tA, tB; int nM, nN, G, c;
    __device__ __forceinline__ bool next(int i, Unit& u) const {
        const long L = (long)(i >> 2) * G + c; if (L >= (long)nM * nN) return false;
        const int b = i & 3; tile_of((int)L, nM, nN, u.pm, u.pn);
        u.A = A0 + (size_t)u.pm * tA + (size_t)b * MIXW * 2; u.B = B0 + (size_t)u.pn * tB + (size_t)b * MIXW * 2; u.aux = b; u.aux2 = 0; return true;
    }
};
struct OrderMoe {
    const char* A0; const char* B0; unsigned tA, tB, eB; const LAS int* tt; int ntiles, nN, G, c;
    __device__ __forceinline__ bool next(int i, Unit& u) const {
        const int L = i * G + c; if (L >= ntiles * 8) return false;
        const int j = L >> 3; u.pn = L & 7; u.pm = j; const int e = __builtin_amdgcn_readfirstlane(tt[j]);
        u.A = A0 + (size_t)((unsigned)j * tA); u.B = B0 + ((size_t)e * eB + (size_t)((unsigned)u.pn * tB)); u.aux = e; u.aux2 = 0; return true;
    }
};
struct OrderMoeF {
    const char* A0; const float* W0; const float* W1; unsigned tA; const LAS int* tt; int ntiles, G, c; bool up;
    __device__ __forceinline__ bool next(int i, UnitF& u) const {
        const int L = i * G + c; if (L >= ntiles * 8) return false;
        const int j = L >> 3; u.pn = L & 7; u.pm = j; const int e = __builtin_amdgcn_readfirstlane(tt[j]);
        u.A = A0 + (size_t)((unsigned)j * tA);
        const size_t eo = (size_t)e * D * DEXP;
        if (up) { u.B = (const char*)(W0 + eo + u.pn * 128); u.B2 = (const char*)(W1 + eo + u.pn * 128); } else { u.B = (const char*)(W0 + eo + u.pn * 256); u.B2 = u.B + 512; }
        u.aux = e; u.aux2 = 0; return true;
    }
};
}

namespace att {
constexpr int DH = 128, NW = 8, QBLK = 32, KVBLK = 64, QB = 256;
constexpr int SHM_V = KVBLK * DH * 2, SHM_K = KVBLK * DH * 2;
constexpr int OFF_WS = 2 * SHM_V + 2 * SHM_K, OFF_CK = OFF_WS + NW * 64 * 4, OFF_Q = OFF_CK + 2 * 64 * 4, LDS_ATT = OFF_Q + NW * 8 * 1024;
static_assert(LDS_ATT <= LDSCTL_OFF, "attention LDS");
constexpr float SCALE = 0.08838834764831845f, C2 = 1.4426950408889634f * SCALE, THR2 = 8.f * 1.4426950408889634f;
#define KSWZ(row, colB) ((row) * 256 + ((colB) ^ (((row) & 7) << 4)))
__device__ __forceinline__ int v_st(int k, int c) { const int kk = (k & ~0xC) | ((k & 4) << 1) | ((k & 8) >> 1); return ((kk >> 3) * 4 + (c >> 5)) * 512 + ((kk & 7) * 32 + (c & 31)) * 2; }
__device__ __forceinline__ int v_rd_base(int lane) { return ((lane & 3) << 3) | (((lane >> 2) & 3) << 6) | (((lane >> 4) & 1) << 5) | (((lane >> 5) & 1) << 8); }
constexpr int v_rd_off(int d0, int ks, int half) { return d0 * 512 + ks * 4096 + half * 2048; }
__device__ __forceinline__ int crow(int r, int hi) { return (r & 3) + 8 * (r >> 2) + 4 * hi; }
__device__ __forceinline__ bf16x8 load8(const bf16* p) { return *reinterpret_cast<const bf16x8*>(p); }
__device__ __forceinline__ void mask_tile(f32x16& p0, f32x16& p1, int dq) {
    const float NEG = -__builtin_inff();
#pragma unroll
    for (int r = 0; r < 16; ++r) {
        const int c = (r & 3) + 8 * (r >> 2);
        if (dq - c < 0) p0[r] = NEG;
        if (dq - c - 32 < 0) p1[r] = NEG;
    }
}
__device__ __forceinline__ void bias_tile(f32x16& p0, f32x16& p1, const float* ck, int hi) {
#pragma unroll
    for (int g = 0; g < 4; ++g) { const f32x4 c0 = *(const f32x4*)(ck + 8 * g + 4 * hi), c1 = *(const f32x4*)(ck + 32 + 8 * g + 4 * hi);
#pragma unroll
        for (int j = 0; j < 4; ++j) { p0[4 * g + j] = fmaf(p0[4 * g + j], C2, c0[j]); p1[4 * g + j] = fmaf(p1[4 * g + j], C2, c1[j]); } }
}
__device__ __forceinline__ void partialSM(f32x16& p0, f32x16& p1, float& m_reg, float& mn, float& alpha) {
    float pmax = p0[0]; for (int r = 1; r < 16; ++r) pmax = fmaxf(pmax, p0[r]); for (int r = 0; r < 16; ++r) pmax = fmaxf(pmax, p1[r]);
    { auto rr = __builtin_amdgcn_permlane32_swap(__float_as_uint(pmax), __float_as_uint(pmax), false, false);
      pmax = fmaxf(__uint_as_float(rr[0]), __uint_as_float(rr[1])); }
    if (__builtin_expect(__all((pmax - m_reg) <= THR2), 1)) { mn = m_reg; alpha = 1.f; }
    else { mn = fmaxf(m_reg, pmax); alpha = __builtin_amdgcn_exp2f(m_reg - mn); m_reg = mn; }
    for (int r = 0; r < 16; ++r) p0[r] = p0[r] - mn; for (int r = 0; r < 16; ++r) p1[r] = p1[r] - mn;
    for (int r = 0; r < 16; ++r) p0[r] = __builtin_amdgcn_exp2f(p0[r]);
}
__device__ __forceinline__ void finishSM(f32x16& p0, f32x16& p1, float alpha, float& l_reg, bf16x8& pa0, bf16x8& pa1, bf16x8& pa2, bf16x8& pa3) {
    for (int r = 0; r < 16; ++r) p1[r] = __builtin_amdgcn_exp2f(p1[r]);
    float ps = 0; for (int r = 0; r < 16; ++r) ps += p0[r]; for (int r = 0; r < 16; ++r) ps += p1[r];
    { auto rr = __builtin_amdgcn_permlane32_swap(__float_as_uint(ps), __float_as_uint(ps), false, false);
      ps = __uint_as_float(rr[0]) + __uint_as_float(rr[1]); }
    l_reg = l_reg * alpha + ps;
#define PK4(P, B_, OUT) do { unsigned a0 = cvt_pk_bf16(P[B_+0], P[B_+1]), a1 = cvt_pk_bf16(P[B_+2], P[B_+3]);                          \
        unsigned b0 = cvt_pk_bf16(P[B_+4], P[B_+5]), b1 = cvt_pk_bf16(P[B_+6], P[B_+7]);                                             \
        auto r0 = __builtin_amdgcn_permlane32_swap(a0, b0, false, false); auto r1 = __builtin_amdgcn_permlane32_swap(a1, b1, false, false); \
        u32x4 w = {r0[0], r1[0], r0[1], r1[1]}; OUT = *reinterpret_cast<bf16x8*>(&w); } while (0)
    PK4(p0, 0, pa0); PK4(p0, 8, pa1); PK4(p1, 0, pa2); PK4(p1, 8, pa3);
#undef PK4
}
template <int KB>
__device__ __forceinline__ void qkt(f32x16& p0, f32x16& p1, const char* K_lds, int r32, int hi, const char* qs) {
    p0 = f32x16{}; p1 = f32x16{};
    const char* kb[4];
#pragma unroll
    for (int dd = 0; dd < 4; ++dd) kb[dd] = K_lds + KB * SHM_K + KSWZ(r32, (dd * 16 + hi * 8) * 2);
#pragma unroll
    for (int d0 = 0; d0 < 8; ++d0) { const char* a = kb[d0 & 3] + (d0 >> 2) * 128;
        const bf16x8 q = *reinterpret_cast<const bf16x8*>(qs + d0 * 1024);
        bf16x8 b0 = *reinterpret_cast<const bf16x8*>(a);
        bf16x8 b1 = *reinterpret_cast<const bf16x8*>(a + 32 * 256);
        p0 = __builtin_amdgcn_mfma_f32_32x32x16_bf16(b0, q, p0, 0, 0, 0);
        p1 = __builtin_amdgcn_mfma_f32_32x32x16_bf16(b1, q, p1, 0, 0, 0); }
}
template <int VB>
__device__ __forceinline__ void pv_tile(f32x16* o, int vb0, bf16x8 pa0, bf16x8 pa1, bf16x8 pa2, bf16x8 pa3) {
#define TRRD(dst, off) asm volatile("ds_read_b64_tr_b16 %0, %1 offset:%2" : "=&v"(dst) : "v"(vb0), "i"(off) : "memory")
#define PV_D0(d0) do { s16x4 l0, l1, l2, l3, h0, h1, h2, h3; constexpr int b_ = VB * SHM_V + v_rd_off(d0, 0, 0); \
        TRRD(l0, b_); TRRD(h0, b_ + 2048); TRRD(l1, b_ + 4096); TRRD(h1, b_ + 6144); TRRD(l2, b_ + 8192); TRRD(h2, b_ + 10240); TRRD(l3, b_ + 12288); TRRD(h3, b_ + 14336); \
        asm volatile("s_waitcnt lgkmcnt(0)" ::: "memory"); SBAR();   \
        o[d0] = __builtin_amdgcn_mfma_f32_32x32x16_bf16(pa0, (bf16x8){l0[0], l0[1], l0[2], l0[3], h0[0], h0[1], h0[2], h0[3]}, o[d0], 0, 0, 0);   \
        o[d0] = __builtin_amdgcn_mfma_f32_32x32x16_bf16(pa1, (bf16x8){l1[0], l1[1], l1[2], l1[3], h1[0], h1[1], h1[2], h1[3]}, o[d0], 0, 0, 0);   \
        o[d0] = __builtin_amdgcn_mfma_f32_32x32x16_bf16(pa2, (bf16x8){l2[0], l2[1], l2[2], l2[3], h2[0], h2[1], h2[2], h2[3]}, o[d0], 0, 0, 0);   \
        o[d0] = __builtin_amdgcn_mfma_f32_32x32x16_bf16(pa3, (bf16x8){l3[0], l3[1], l3[2], l3[3], h3[0], h3[1], h3[2], h3[3]}, o[d0], 0, 0, 0); } while (0)
    PV_D0(0); PV_D0(1); PV_D0(2); PV_D0(3);
#undef PV_D0
#undef TRRD
}

__device__ __forceinline__ void attn_unit(const bf16* Qp, const bf16* Kp, const bf16* Vp, const float* nck, int P0, int ja, int jb, float* Op, float* MLp, LAS unsigned char* ldsl) {
    char* lds = (char*)ldsl;
    const int tid = opaque_tid(), wid = __builtin_amdgcn_readfirstlane(tid >> 6), lane = tid & 63, r32 = lane & 31, hi = lane >> 5;
    const int NT = jb - ja;
    const int qlo = P0 + wid * QBLK, qm = qlo + r32 - 4 * hi;
    char* V_lds = lds; char* K_lds = lds + 2 * SHM_V;
    float* ws = (float*)(lds + OFF_WS) + wid * 64; float* al_l = ws + 32;
    float* CK = (float*)(lds + OFF_CK);
    float m_reg = -1e30f, l_reg = 0; f32x16 o[4] = {};
    const int sr = tid >> 4, sc = (tid & 15) * 8, vst0 = v_st(sr, sc), vst1 = v_st(32 + sr, sc), kws = KSWZ(sr, sc * 2);
    const int vb0 = (int)(uintptr_t)V_lds + v_rd_base(lane);
    bf16x8 st_v0, st_v1, st_k0, st_k1; const char* qs = lds + OFF_Q + wid * 8192 + lane * 16;
    const unsigned ro0 = (unsigned)(sr * ZP + sc), ro1 = (unsigned)((32 + sr) * ZP + sc);
#define SLOAD_H(k0) do { const unsigned kz_ = (unsigned)(k0) * (unsigned)ZP; st_v0 = load8(Vp + (kz_ + ro0)); st_v1 = load8(Vp + (kz_ + ro1)); st_k0 = load8(Kp + (kz_ + ro0)); st_k1 = load8(Kp + (kz_ + ro1)); } while (0)
#define SWRITE_HK(bf) do { *(bf16x8*)(K_lds + (bf) * SHM_K + kws) = st_k0; *(bf16x8*)(K_lds + (bf) * SHM_K + kws + 32 * 256) = st_k1; } while (0)
#define CK_DMA(k0, bf) do { if (wid == 0) __builtin_amdgcn_global_load_lds((const unsigned*)(nck + (unsigned)(k0) + (unsigned)lane), (LAS unsigned*)(ldsl + OFF_CK + (bf) * 256), 4, 0, 0); } while (0)
#define SWRITE_HV(bf) do { *(bf16x8*)(V_lds + (bf) * SHM_V + vst0) = st_v0; *(bf16x8*)(V_lds + (bf) * SHM_V + vst1) = st_v1; } while (0)
#define SWRITE_H(bf) do { SWRITE_HV(bf); SWRITE_HK(bf); } while (0)
#define RESC(a) do { if (__any((a) < 1.f)) { if (hi == 0) al_l[r32] = (a); asm volatile("s_waitcnt lgkmcnt(0)" ::: "memory");              \
                     for (int d_ = 0; d_ < 4; ++d_) for (int r = 0; r < 16; ++r) o[d_][r] *= al_l[crow(r, hi)]; } } while (0)
#define KBASE(t) ((ja + (t)) * KVBLK)
#define MASKT(P0_, P1_, t) do { const int kb_ = KBASE(t); if (kb_ + KVBLK - 1 > qlo) mask_tile(P0_, P1_, qm - kb_); } while (0)
#pragma unroll
    for (int d0 = 0; d0 < 8; ++d0) *(bf16x8*)(qs + d0 * 1024) = load8(Qp + (unsigned)((qlo + r32) * ZP + d0 * 16 + hi * 8));
    SLOAD_H(KBASE(0)); CK_DMA(KBASE(0), 0); VM_WAIT(); SWRITE_H(0);
    if (NT > 1) { SLOAD_H(KBASE(1)); CK_DMA(KBASE(1), 1); }
    __syncthreads();
    f32x16 pA0, pA1, pB0, pB1; float mnA, mnB, alA, alB; bf16x8 pa0, pa1, pa2, pa3;
    SBAR(); qkt<0>(pA0, pA1, K_lds, r32, hi, qs);
    MASKT(pA0, pA1, 0); bias_tile(pA0, pA1, CK, hi); partialSM(pA0, pA1, m_reg, mnA, alA);
    if (NT > 1) { VM_WAIT(); SWRITE_H(1); }
    __syncthreads();
#define HALF_STEP(PX0, PX1, mnX, alX, PY0, PY1, alY, t, KB, VB, SB) do {                                                      \
        SBAR(); qkt<KB>(PX0, PX1, K_lds, r32, hi, qs);                                                                        \
        finishSM(PY0, PY1, alY, l_reg, pa0, pa1, pa2, pa3); SBAR();                                                           \
        if ((t) + 1 < NT) { SLOAD_H(KBASE((t) + 1)); CK_DMA(KBASE((t) + 1), SB); SBAR(); }                                                                \
        pv_tile<VB>(o, vb0, pa0, pa1, pa2, pa3); MASKT(PX0, PX1, (t)); bias_tile(PX0, PX1, CK + (KB) * 64, hi); partialSM(PX0, PX1, m_reg, mnX, alX);   \
        __syncthreads();                                                                                                      \
        if ((t) + 1 < NT) { VM_WAIT(); SWRITE_H(SB); }                                                                        \
        RESC(alX); __syncthreads(); } while (0)
    for (int t = 1; t + 1 < NT; t += 2) {
        HALF_STEP(pB0, pB1, mnB, alB, pA0, pA1, alA, t, 1, 0, 0);
        HALF_STEP(pA0, pA1, mnA, alA, pB0, pB1, alB, t + 1, 0, 1, 1);
    }
    const bool even = (NT & 1) == 0;
    if (even) { SBAR(); qkt<1>(pB0, pB1, K_lds, r32, hi, qs); SBAR(); }
    finishSM(pA0, pA1, alA, l_reg, pa0, pa1, pa2, pa3); SBAR();
    pv_tile<0>(o, vb0, pa0, pa1, pa2, pa3);
    if (even) { MASKT(pB0, pB1, NT - 1); bias_tile(pB0, pB1, CK + 64, hi); partialSM(pB0, pB1, m_reg, mnB, alB); __syncthreads(); RESC(alB);
        finishSM(pB0, pB1, alB, l_reg, pa0, pa1, pa2, pa3); SBAR(); pv_tile<1>(o, vb0, pa0, pa1, pa2, pa3); }
    float* Ow = Op + (size_t)(wid * QBLK) * DH;
#pragma unroll
    for (int r = 0; r < 16; ++r) { const int orow = crow(r, hi);
#pragma unroll
        for (int d0 = 0; d0 < 4; ++d0) Ow[(size_t)orow * DH + d0 * 32 + r32] = o[d0][r]; }
    if (hi == 0) { *(f32x2*)(MLp + (size_t)(wid * QBLK + r32) * 2) = (f32x2){m_reg, l_reg}; }
    __syncthreads();
#undef SLOAD_H
#undef SWRITE_HK
#undef CK_DMA
#undef SWRITE_HV
#undef SWRITE_H
#undef RESC
#undef KBASE
#undef MASKT
#undef HALF_STEP
}
}

#define XB_TMO      128
#define XB_XCNT(j)  (256  + 64 * (j))
#define XB_XSUB(j)  (1280 + 64 * (j))
#define XB_XGEN(j)  (2304 + 64 * (j))
#define XB_TOP      3328
#define XB_TOPGEN   3392
#define XCD_BAR_WORDS 3456
#define XB_SPIN_CAP (1u << 18)
__device__ __forceinline__ unsigned xb_ld(unsigned* p)              { return __hip_atomic_load(p, __ATOMIC_RELAXED, __HIP_MEMORY_SCOPE_AGENT); }
__device__ __forceinline__ unsigned xb_add(unsigned* p, unsigned v) { return __hip_atomic_fetch_add(p, v, __ATOMIC_RELAXED, __HIP_MEMORY_SCOPE_AGENT); }
__device__ __forceinline__ unsigned xb_xcc_id() { return (unsigned)__builtin_amdgcn_s_getreg((3 << 11) | 20) & 0xFu; }
#define XB_SPIN(cond, bar) do { unsigned _sp = 0; while (cond) { __builtin_amdgcn_s_sleep(1); \
    if ((++_sp & 255u) == 0u) { if (xb_ld(&(bar)[XB_TMO])) break; if (_sp > XB_SPIN_CAP) { atomicAdd(&(bar)[XB_TMO], 1u); break; } } } } while (0)
struct XcdBarrier { unsigned* bar; unsigned x; volatile LAS unsigned* st; };
__device__ __forceinline__ XcdBarrier xcd_barrier_post(unsigned* bar, volatile LAS unsigned* st) {
    XcdBarrier b; b.bar = bar; b.x = xb_xcc_id(); b.st = st;
    if (threadIdx.x == 0) (void)xb_add(&bar[XB_XCNT(b.x)], 1u);
    return b;
}
__device__ __forceinline__ void xcd_barrier_complete(unsigned* bar, unsigned x, unsigned& nloc, unsigned& nx) {
    const unsigned G = gridDim.x * gridDim.y * gridDim.z;
    unsigned sum, cnt, mine, sp = 0u;
    for (;;) {
        sum = 0u; cnt = 0u; mine = 0u;
#pragma nounroll
        for (unsigned j = 0; j < 16; ++j) { const unsigned c = xb_ld(&bar[XB_XCNT(j)]); sum += c; cnt += (c > 0u) ? 1u : 0u; mine = (j == x) ? c : mine; }
        if (sum == G) break;
        __builtin_amdgcn_s_sleep(1);
        if ((++sp & 255u) == 0u) { if (xb_ld(&bar[XB_TMO])) break; if (sp > XB_SPIN_CAP) { atomicAdd(&bar[XB_TMO], 1u); break; } }
    }
    nloc = mine > 0u ? mine : 1u; nx = cnt > 0u ? cnt : 1u;
}
__device__ __forceinline__ void xcd_barrier(const XcdBarrier& b) {
    asm volatile("s_waitcnt vmcnt(0)" ::: "memory");
    __syncthreads();
    if (threadIdx.x == 0) {
        unsigned* bar = b.bar; asm volatile("" : "+s"(bar));
        __builtin_amdgcn_s_waitcnt(0);
        unsigned nloc = b.st[0], nx = b.st[1];
        if (nloc == 0u) { xcd_barrier_complete(bar, b.x, nloc, nx); b.st[0] = nloc; b.st[1] = nx; }
        const unsigned old = xb_add(&bar[XB_XSUB(b.x)], 1u);
        const unsigned gen = old / nloc;
        if (old + 1u == (gen + 1u) * nloc) {
            __builtin_amdgcn_fence(__ATOMIC_RELEASE, "agent");
            asm volatile("s_waitcnt vmcnt(0)" ::: "memory");
            const unsigned og = xb_add(&bar[XB_TOP], 1u);
            const unsigned tg = og / nx;
            if (og + 1u == (tg + 1u) * nx) xb_add(&bar[XB_TOPGEN], 1u);
            else XB_SPIN(xb_ld(&bar[XB_TOPGEN]) == tg, bar);
            __builtin_amdgcn_fence(__ATOMIC_ACQUIRE, "agent");
            xb_add(&bar[XB_XGEN(b.x)], 1u);
            asm volatile("s_waitcnt vmcnt(0)" ::: "memory");
        } else {
            XB_SPIN(xb_ld(&bar[XB_XGEN(b.x)]) == gen, bar);
            __builtin_amdgcn_fence(__ATOMIC_ACQUIRE, "agent");
            asm volatile("s_waitcnt vmcnt(0)" ::: "memory");
        }
    }
    __syncthreads();
}

namespace pg8 {
__device__ __forceinline__ void ho_arrive(unsigned* cnt) {
    asm volatile("s_waitcnt vmcnt(0) lgkmcnt(0)" ::: "memory");
    __syncthreads();
    if (threadIdx.x == 0) { unsigned* c = cnt; asm volatile("" : "+s"(c));
        __builtin_amdgcn_fence(__ATOMIC_RELEASE, "agent"); asm volatile("s_waitcnt vmcnt(0)" ::: "memory");
        (void)xb_add(c, 1u); }
}
struct OrderDenseQ {
    const char* A0; const char* B0; size_t tA, tB; int nM, pn0; unsigned* q; int x; volatile LAS unsigned* slot;
    __device__ __forceinline__ bool next(int i, Unit& u) const {
        if (threadIdx.x == 0) {
            unsigned* qq = q; asm volatile("" : "+s"(qq));
            unsigned L = 0xFFFFFFFFu;
            if (i == 0) L = (unsigned)x * (unsigned)(4 * nM) + (blockIdx.x >> 3);
            else {
#pragma nounroll
            for (int s_ = 0; s_ < 8; ++s_) { const unsigned xx = (unsigned)(x + s_) & 7u; const unsigned v = xb_add(qq + 16 * xx, 1u) + (gridDim.x + 7u - xx) / 8u; if (v < (unsigned)(4 * nM)) { L = xx * (unsigned)(4 * nM) + v; break; } } }
            slot[i & 1] = L;
            asm volatile("s_waitcnt lgkmcnt(0)" ::: "memory");
        }
        __builtin_amdgcn_s_barrier();
        const unsigned L = (unsigned)__builtin_amdgcn_readfirstlane((int)slot[i & 1]);
        if (L == 0xFFFFFFFFu) return false;
        const unsigned xx = L / (unsigned)(4 * nM), v = L % (unsigned)(4 * nM);
        u.pm = (int)(v >> 2); u.pn = pn0 + 4 * (int)xx + (int)(v & 3u); u.A = A0 + (size_t)u.pm * tA; u.B = B0 + (size_t)(u.pn - pn0) * tB; u.aux = 0; u.aux2 = 0; return true;
    }
};
struct OrderMoeDyn {
    const char* A0; const float* W0; unsigned tA; const LAS int* tt; int nunits; unsigned* q; unsigned* ready; unsigned* tmo; volatile LAS unsigned* slot;
    __device__ __forceinline__ bool next(int i, UnitF& u) const {
        if (threadIdx.x == 0) {
            unsigned* qq = q; asm volatile("" : "+s"(qq));
            const unsigned v = xb_add(qq, 1u);
            if (v < (unsigned)nunits) { unsigned* c = ready + (v >> 3); unsigned sp = 0;
                while (xb_ld(c) < 8u) { __builtin_amdgcn_s_sleep(2); if ((++sp & 255u) == 0u) { if (xb_ld(tmo)) break; if (sp > XB_SPIN_CAP) { atomicAdd(tmo, 1u); break; } } }
                __builtin_amdgcn_fence(__ATOMIC_ACQUIRE, "agent"); }
            slot[i & 1] = v;
            asm volatile("s_waitcnt lgkmcnt(0)" ::: "memory");
        }
        __builtin_amdgcn_s_barrier();
        const int L = __builtin_amdgcn_readfirstlane((int)slot[i & 1]);
        if (L >= nunits) return false;
        const int j = L >> 3; u.pn = L & 7; u.pm = j; const int e = __builtin_amdgcn_readfirstlane(tt[j]);
        u.A = A0 + (size_t)((unsigned)j * tA);
        u.B = (const char*)(W0 + (size_t)e * D * DEXP + u.pn * 256); u.B2 = u.B + 512;
        u.aux = e; u.aux2 = 0; return true;
    }
};
}

struct Frame {
    LAS unsigned char* lds; volatile LAS unsigned* MISC; gu32* ctl;
    int tid, lane, wave, vcu, G;
    float* out; GAS unsigned char* ws;
};
struct Args { const float* in[24]; float* out; unsigned char* ws; int ph_lo, ph_hi; };
typedef const __attribute__((address_space(4))) Args* KArgs;
__device__ __forceinline__ KArgs kargs() { KArgs p = (KArgs)__builtin_amdgcn_kernarg_segment_ptr(); asm volatile("" : "+s"(p)); return p; }
enum { I_X = 0, I_META, I_LNIN_G, I_LNIN_B, I_WIN, I_FOXB, I_WA2, I_BA, I_GNORM, I_CONVW, I_POOLW, I_POOLS, I_GATEB, I_WBR, I_WOUT, I_LN1G, I_LN1B, I_RW, I_RB, I_WG, I_WU, I_WD, I_LN2G, I_LN2B };

struct RmId { __device__ __forceinline__ int operator()(int n) const { return n; } };
struct RmIn { __device__ __forceinline__ int operator()(int n) const {
    if (n < 1536) return n; if (n < 1540) return 13312 + (n - 1536); if (n < 2564) return n - 4; if (n < 2580) return 13316 + (n - 2564); return n - 20; } };
struct RmGU { int add; __device__ __forceinline__ int operator()(int n) const { return ((n >> 7) << 8) + add + (n & 127); } };
template <class RM>
__device__ __forceinline__ void tr_item(const float* W, int N, bf16* dst, int dpitch, int koff, const RM& rm, LAS float* scr, int kb, int nb, int lane, unsigned char* dq = nullptr) {
    const int k0 = 64 * kb, n0 = 32 * nb, nn = n0 + (lane & 31); const bool okn = nn < N;
    { const int nc = okn ? nn : N - 1; float v[32];
#pragma unroll
      for (int i = 0; i < 32; ++i) v[i] = W[(size_t)(k0 + 2 * i + (lane >> 5)) * N + nc];
#pragma unroll
      for (int i = 0; i < 32; ++i) scr[(2 * i + (lane >> 5)) * 33 + (lane & 31)] = okn ? v[i] : 0.f; }
    LDS_WAIT(); asm volatile("" ::: "memory");
    const int c = lane & 7;
#pragma unroll
    for (int j = 0; j < 4; ++j) { const int n = (lane >> 3) + 8 * j;
        if (n0 + n < N) { const LAS float* s = scr + (8 * c) * 33 + n;
            const int ro = rm(n0 + n);
            if (dq && ro >= ZC_GZ && ro < ZC_GZ + 4 * D) {
                u32x2 o; o.x = pk4_fp8(s[0 * 33] * WQ_SCALE, s[1 * 33] * WQ_SCALE, s[2 * 33] * WQ_SCALE, s[3 * 33] * WQ_SCALE); o.y = pk4_fp8(s[4 * 33] * WQ_SCALE, s[5 * 33] * WQ_SCALE, s[6 * 33] * WQ_SCALE, s[7 * 33] * WQ_SCALE);
                *(GAS u32x2*)(dq + (size_t)(ro - ZC_GZ) * D + k0 + 8 * c) = o; }
            else {
            u32x4 o; o.x = pk2(s[0 * 33], s[1 * 33]); o.y = pk2(s[2 * 33], s[3 * 33]); o.z = pk2(s[4 * 33], s[5 * 33]); o.w = pk2(s[6 * 33], s[7 * 33]);
            *(GAS u32x4*)(dst + (size_t)ro * dpitch + koff + k0 + 8 * c) = o; } } }
    LDS_WAIT(); asm volatile("" ::: "memory");
}
__device__ __forceinline__ void ln_row_regs(f32x4 (&v)[8], const float* g, const float* beta, int lane) {
    float s = 0.f;
#pragma unroll
    for (int j = 0; j < 8; ++j) s += (v[j].x + v[j].y) + (v[j].z + v[j].w);
    const float mean = wave_sum(s) * (1.f / D); float s2 = 0.f;
#pragma unroll
    for (int j = 0; j < 8; ++j) { v[j] = v[j] - mean; s2 += (v[j].x * v[j].x + v[j].y * v[j].y) + (v[j].z * v[j].z + v[j].w * v[j].w); }
    const float rstd = 1.f / sqrtf(wave_sum(s2) * (1.f / D) + LN_EPS);
#pragma unroll
    for (int j = 0; j < 8; ++j) { const f32x4 gg = *(const f32x4*)(g + 4 * lane + 256 * j), bb = *(const f32x4*)(beta + 4 * lane + 256 * j); v[j] = v[j] * rstd * gg + bb; }
}
struct TrDesc { const float* W; int N; bf16* dst; int dpitch, koff, kb, nb; unsigned char* dq; int rmin; };
__device__ __forceinline__ void tr_load(const TrDesc& t, float (&v)[32], int lane) {
    const int k0 = 64 * t.kb, nn = 32 * t.nb + (lane & 31); const int nc = nn < t.N ? nn : t.N - 1;
    const float* p = t.W + (size_t)(k0 + (lane >> 5)) * t.N + nc; const size_t st = (size_t)2 * t.N;
#pragma unroll
    for (int i = 0; i < 32; ++i) v[i] = p[i * st];
}
__device__ __forceinline__ void tr_finish(const TrDesc& t, const float (&v)[32], LAS float* scr, int lane) {
    const int k0 = 64 * t.kb, n0 = 32 * t.nb; const bool okn = n0 + (lane & 31) < t.N;
#pragma unroll
    for (int i = 0; i < 32; ++i) scr[(2 * i + (lane >> 5)) * 33 + (lane & 31)] = okn ? v[i] : 0.f;
    LDS_WAIT(); asm volatile("" ::: "memory");
    const int c = lane & 7;
#pragma unroll
    for (int j = 0; j < 4; ++j) { const int n = (lane >> 3) + 8 * j;
        if (n0 + n < t.N) { const LAS float* s = scr + (8 * c) * 33 + n;
            const int ro = t.rmin ? RmIn{}(n0 + n) : n0 + n;
            if (t.dq && ro >= ZC_GZ && ro < ZC_GZ + 4 * D) {
                u32x2 o; o.x = pk4_fp8(s[0 * 33] * WQ_SCALE, s[1 * 33] * WQ_SCALE, s[2 * 33] * WQ_SCALE, s[3 * 33] * WQ_SCALE); o.y = pk4_fp8(s[4 * 33] * WQ_SCALE, s[5 * 33] * WQ_SCALE, s[6 * 33] * WQ_SCALE, s[7 * 33] * WQ_SCALE);
                *(GAS u32x2*)(t.dq + (size_t)(ro - ZC_GZ) * D + k0 + 8 * c) = o; }
            else {
                u32x4 o; o.x = pk2(s[0 * 33], s[1 * 33]); o.y = pk2(s[2 * 33], s[3 * 33]); o.z = pk2(s[4 * 33], s[5 * 33]); o.w = pk2(s[6 * 33], s[7 * 33]);
                *(GAS u32x4*)(t.dst + (size_t)ro * t.dpitch + t.koff + k0 + 8 * c) = o; } } }
    LDS_WAIT(); asm volatile("" ::: "memory");
}
__device__ __forceinline__ void ln_row_pre(f32x4 (&v)[8], const f32x4 (&gg)[8], const f32x4 (&bb)[8]) {
    float s = 0.f;
#pragma unroll
    for (int j = 0; j < 8; ++j) s += (v[j].x + v[j].y) + (v[j].z + v[j].w);
    const float mean = wave_sum(s) * (1.f / D); float s2 = 0.f;
#pragma unroll
    for (int j = 0; j < 8; ++j) { v[j] = v[j] - mean; s2 += (v[j].x * v[j].x + v[j].y * v[j].y) + (v[j].z * v[j].z + v[j].w * v[j].w); }
    const float rstd = 1.f / sqrtf(wave_sum(s2) * (1.f / D) + LN_EPS);
#pragma unroll
    for (int j = 0; j < 8; ++j) v[j] = v[j] * rstd * gg[j] + bb[j];
}
__device__ __forceinline__ void store_row(const f32x4 (&v)[8], float* of, bf16* ob, int lane, unsigned char* oq = nullptr) {
#pragma unroll
    for (int j = 0; j < 8; ++j) {
        if (of) *(f32x4*)(of + 4 * lane + 256 * j) = v[j];
        if (oq) *(unsigned*)(oq + 4 * lane + 256 * j) = pk4_fp8(v[j].x, v[j].y, v[j].z, v[j].w);
        if (ob) { u32x2 w; w.x = pk2(v[j].x, v[j].y); w.y = pk2(v[j].z, v[j].w); *(u32x2*)(ob + 4 * lane + 256 * j) = w; } }
}

__device__ __forceinline__ void p0_prologue(Frame& F, KArgs A) {
    LAS float* scr = (LAS float*)(F.lds + F.wave * 16384);
    const int gw = F.vcu * NWAVES + F.wave, NGW = F.G * NWAVES;
    constexpr int I_IN = 32 * 417, I_BR = 4 * 8 * 64, I_OUT = 32 * 64, I_G = NEXP * 32 * 32, I_D = NEXP * 16 * 64, I_PW = 4 * 2 * 4;
    constexpr int PER_LAYER = I_IN + I_BR + I_OUT + I_PW; (void)I_G; (void)I_D;
    auto decode = [&](int it) -> TrDesc {
        const int l = it / PER_LAYER; const int r = it - l * PER_LAYER; const int r1 = r - I_IN, r2 = r1 - I_BR, r3 = r2 - I_OUT;
        const int ty = (r < I_IN) ? 0 : (r1 < I_BR) ? 1 : (r2 < I_OUT) ? 2 : 3;
        const int b = r1 / 512, q1 = r1 % 512, g = r3 / 8, q3 = r3 % 8;
        TrDesc t;
        t.W = ty == 0 ? A->in[I_WIN] + (size_t)l * D * P_IN : ty == 1 ? A->in[I_WBR] + ((size_t)l * 4 + b) * MIXW * D : ty == 2 ? A->in[I_WOUT] + (size_t)l * D * D : A->in[I_POOLW] + ((size_t)l * 4 + g) * 128 * 128;
        t.N = ty == 0 ? P_IN : ty == 3 ? 128 : D;
        t.dst = ty == 0 ? (bf16*)(F.ws + WS_WIN) + (size_t)l * NIN_T * D : ty == 1 ? (bf16*)(F.ws + WS_WBR) + (size_t)l * D * D : ty == 2 ? (bf16*)(F.ws + WS_WOUT) + (size_t)l * D * D : (bf16*)(F.ws + WS_PW) + ((size_t)l * 4 + g) * 128 * 128;
        t.dpitch = ty == 3 ? 128 : D; t.koff = ty == 1 ? b * MIXW : 0;
        t.kb = ty == 0 ? r / 417 : ty == 1 ? q1 / 64 : ty == 2 ? r2 / 64 : q3 / 4;
        t.nb = ty == 0 ? r % 417 : ty == 1 ? q1 % 64 : ty == 2 ? r2 % 64 : q3 % 4;
        t.dq = ty == 0 ? (unsigned char*)(F.ws + WS_WQ + (size_t)l * 4 * D * D) : nullptr; t.rmin = ty == 0;
        return t; };
    { constexpr int TOT = DEPTH * PER_LAYER; float va[32], vb[32]; int it = gw;
      if (it < TOT) { TrDesc ta = decode(it); tr_load(ta, va, F.lane);
        for (;;) {
            const int i1 = it + NGW; const bool h1 = i1 < TOT; const TrDesc tb = decode(h1 ? i1 : it); tr_load(tb, vb, F.lane); __builtin_amdgcn_sched_barrier(0);
            tr_finish(ta, va, scr, F.lane); __builtin_amdgcn_sched_barrier(0);
            if (!h1) break;
            const int i2 = i1 + NGW; const bool h2 = i2 < TOT; ta = decode(h2 ? i2 : i1); tr_load(ta, va, F.lane); __builtin_amdgcn_sched_barrier(0);
            tr_finish(tb, vb, scr, F.lane); __builtin_amdgcn_sched_barrier(0);
            if (!h2) break;
            it = i2; } } }
    for (int it = gw; it < DEPTH * 236; it += NGW) { const int l = it / 236, r = 13332 + it % 236; u32x4* p = (u32x4*)((bf16*)(F.ws + WS_WIN) + ((size_t)l * NIN_T + r) * D);
#pragma unroll
        for (int j = 0; j < 4; ++j) p[F.lane + 64 * j] = (u32x4){0u, 0u, 0u, 0u}; }
    { f32x4 gg[8], bb[8];
#pragma unroll
      for (int j = 0; j < 8; ++j) { gg[j] = *(const f32x4*)(A->in[I_LNIN_G] + 4 * F.lane + 256 * j); bb[j] = *(const f32x4*)(A->in[I_LNIN_B] + 4 * F.lane + 256 * j); }
      int m = gw;
      if (m < MP) {
        f32x4 x[8];
#define P0_SRC(mm) ((mm) < NMETA ? A->in[I_META] + (size_t)(mm) * D : A->in[I_X] + (size_t)(((mm) < NTOK ? (mm) : NTOK - 1) - NMETA) * D)
        { const float* src = P0_SRC(m);
#pragma unroll
          for (int j = 0; j < 8; ++j) x[j] = *(const f32x4*)(src + 4 * F.lane + 256 * j); }
        for (;;) {
            f32x4 v[8];
#pragma unroll
            for (int j = 0; j < 8; ++j) v[j] = x[j];
            const int mn = m + NGW; const bool more = mn < MP; const int mc = more ? mn : m;
            { const float* src = P0_SRC(mc);
#pragma unroll
              for (int j = 0; j < 8; ++j) x[j] = *(const f32x4*)(src + 4 * F.lane + 256 * j); }
            if (m < NTOK) ln_row_pre(v, gg, bb);
            else {
#pragma unroll
                for (int j = 0; j < 8; ++j) v[j] = (f32x4){0.f, 0.f, 0.f, 0.f}; }
            store_row(v, (float*)(F.ws + WS_HF) + (size_t)m * D, (bf16*)(F.ws + WS_HB) + (size_t)m * D, F.lane, (unsigned char*)(F.ws + WS_HQ + (size_t)m * D));
            if (!more) break;
            m = mn;
        }
#undef P0_SRC
      } }
}

__device__ __forceinline__ f32x16 mma_tile(const LAS bf16* A, int pa, const LAS bf16* B, int pb, int K, f32x16 acc, int lane) {
    const int r = lane & 31, h8 = (lane >> 5) * 8;
    for (int ks = 0; ks < K; ks += 16) {
        const bf16x8 a = *(const LAS bf16x8*)(A + r * pa + ks + h8), b = *(const LAS bf16x8*)(B + r * pb + ks + h8);
        acc = __builtin_amdgcn_mfma_f32_32x32x16_bf16(a, b, acc, 0, 0, 0);
    }
    return acc;
}
__device__ __forceinline__ int crow16(int r, int hi) { return (r & 3) + 8 * (r >> 2) + 4 * hi; }

__device__ __forceinline__ void p2a_cumsum(Frame& F, KArgs A, int l, int h) {
    const float* Zs = (const float*)(F.ws + WS_ZS); float* C2 = (float*)(F.ws + WS_C2) + (size_t)h * MP;
    const float fb = A->in[I_FOXB][l * 4 + h];
    LAS float* wsum = (LAS float*)(F.lds);
    const int t0 = F.tid * 17; float loc[17]; float run = 0.f;
#pragma unroll
    for (int i = 0; i < 17; ++i) { const int t = t0 + i; const float x = (t < NTOK) ? log_sigmoidf(Zs[(size_t)t * 32 + h] + fb) : 0.f; run += x; loc[i] = run; }
    float incl = run;
#pragma unroll
    for (int o = 1; o < 64; o <<= 1) { const float y = __shfl_up(incl, o); if (F.lane >= o) incl += y; }
    if (F.lane == 63) wsum[F.wave] = incl;
    __syncthreads();
    float off = incl - run;
    for (int w = 0; w < F.wave; ++w) off += wsum[w];
#pragma unroll
    for (int i = 0; i < 17; ++i) { const int t = t0 + i; if (t < MP) C2[t] = -(off + loc[i]) * LOG2E; }
    __syncthreads();
}

constexpr int GL_GA = 0, GL_WA = 4096, GL_PART = 8192, GL_BC = 10240, GL_A0 = 27136;
constexpr int GP = 72;
__device__ __forceinline__ void gla_bc(Frame& F, KArgs A, int l, int c, int h, float (&bcv)[8], float& last_k) {
    const float* Zs = (const float*)(F.ws + WS_ZS);
    LAS float* ga_s = (LAS float*)(F.lds + GL_GA); LAS float* wa_s = (LAS float*)(F.lds + GL_WA); LAS float* part = (LAS float*)(F.lds + GL_PART); LAS float* bc_s = (LAS float*)(F.lds + GL_BC);
    if (F.tid < 256) { const int i = F.tid >> 2, q = F.tid & 3, r = 64 * c + i - GLA_FRONT;
        const f32x4 v = (r >= 0 && r < NTOK) ? *(const f32x4*)(Zs + (size_t)r * 32 + 4 + 4 * q) : (f32x4){0.f, 0.f, 0.f, 0.f};
        *(LAS f32x4*)(ga_s + i * 16 + 4 * q) = v; }
    { float wv[2];
#pragma unroll
      for (int q = 0; q < 2; ++q) { const int idx = F.tid + 512 * q, j = idx >> 6, k = idx & 63; wv[q] = A->in[I_WA2][((size_t)l * 16 + j) * 256 + h * 64 + k]; }
#pragma unroll
      for (int q = 0; q < 2; ++q) wa_s[F.tid + 512 * q] = wv[q]; }
    __syncthreads();
    const int k = F.tid & 63, ig = F.tid >> 6; const float ba = A->in[I_BA][l * 256 + h * 64 + k];
    float run = 0.f;
#pragma unroll
    for (int ii = 0; ii < 8; ++ii) { const int i = 8 * ig + ii, r = 64 * c + i - GLA_FRONT; float x = ba;
#pragma unroll
        for (int j = 0; j < 16; ++j) x = fmaf(ga_s[i * 16 + j], wa_s[j * 64 + k], x);
        const float g = (r >= 0 && r < NTOK) ? log_sigmoidf(x) * (1.f / 16.f) : 0.f; run += g; bcv[ii] = run; }
    part[ig * 64 + k] = run;
    __syncthreads();
    float off = 0.f, tot = 0.f;
#pragma unroll
    for (int g2 = 0; g2 < 8; ++g2) { const float p = part[g2 * 64 + k]; tot += p; if (g2 < ig) off += p; }
#pragma unroll
    for (int ii = 0; ii < 8; ++ii) { bcv[ii] += off; bc_s[(8 * ig + ii) * 65 + k] = bcv[ii]; }
    last_k = tot;
}
__device__ __forceinline__ void gla_load_vt(Frame& F, int c, int h, LAS bf16* VT) {
    const bf16* Z = (const bf16*)(F.ws + WS_Z);
    const int v = F.tid & 127, sg = F.tid >> 7; unsigned w[8];
#pragma unroll
    for (int jj = 0; jj < 8; ++jj) { unsigned lo = 0, hi = 0; const int s0 = 16 * sg + 2 * jj, r0 = 64 * c + s0 - GLA_FRONT;
        if (r0 >= 0 && r0 < NTOK) lo = Z[(size_t)r0 * ZP + ZC_GV + h * 128 + v];
        if (r0 + 1 >= 0 && r0 + 1 < NTOK) hi = Z[(size_t)(r0 + 1) * ZP + ZC_GV + h * 128 + v];
        w[jj] = lo | (hi << 16); }
    *(LAS u32x4*)(VT + v * GP + 16 * sg) = (u32x4){w[0], w[1], w[2], w[3]};
    *(LAS u32x4*)(VT + v * GP + 16 * sg + 8) = (u32x4){w[4], w[5], w[6], w[7]};
}
__device__ __forceinline__ void gla_stage1(Frame& F, KArgs A, int l, int c, int h) {
    const bf16* Z = (const bf16*)(F.ws + WS_Z);
    LAS bf16* KhT = (LAS bf16*)(F.lds + GL_A0); LAS bf16* VT = (LAS bf16*)(F.lds + GL_A0 + 64 * GP * 2);
    float bcv[8], last_k; gla_bc(F, A, l, c, h, bcv, last_k);
    const int k = F.tid & 63, ig = F.tid >> 6; unsigned w[4];
#pragma unroll
    for (int jj = 0; jj < 4; ++jj) { float x[2];
#pragma unroll
        for (int q = 0; q < 2; ++q) { const int ii = 2 * jj + q, r = 64 * c + 8 * ig + ii - GLA_FRONT;
            const float kc = (r >= 0 && r < NTOK) ? bf2f(Z[(size_t)r * ZP + ZC_GK + h * 64 + k]) : 0.f; x[q] = kc * __expf(last_k - bcv[ii]); }
        w[jj] = pk2(x[0], x[1]); }
    *(LAS u32x4*)(KhT + k * GP + 8 * ig) = (u32x4){w[0], w[1], w[2], w[3]};
    gla_load_vt(F, c, h, VT);
    if (ig == 0) ((float*)(F.ws + WS_DEC))[((size_t)c * 4 + h) * 64 + k] = __expf(last_k);
    __syncthreads();
    { const int mt = F.wave >> 1, nt = F.wave & 1, r = F.lane & 31, hi = F.lane >> 5; f32x16 acc = {};
      acc = mma_tile(VT + mt * 32 * GP, GP, KhT + nt * 32 * GP, GP, 64, acc, F.lane);
      float* U = (float*)(F.ws + WS_UT) + (((size_t)c * 4 + h) * 128) * 64;
#pragma unroll
      for (int rg = 0; rg < 16; ++rg) U[(size_t)(mt * 32 + crow16(rg, hi)) * 64 + nt * 32 + r] = acc[rg]; }
    __syncthreads();
}
__device__ __forceinline__ void gla_scan_item(Frame& F, int it) {
    const int e = it * 512 + F.tid, h = e >> 13, v = (e >> 6) & 127, k = e & 63;
    const float* U = (const float*)(F.ws + WS_UT); const float* DEC = (const float*)(F.ws + WS_DEC); bf16* St = (bf16*)(F.ws + WS_ST);
    float S = 0.f; float u[8], d[8];
#define SCAN_LOAD(c0_) do { _Pragma("unroll") for (int j = 0; j < 8; ++j) { const int c_ = (c0_) + j; const int cc_ = c_ < NCHUNK ? c_ : NCHUNK - 1; \
        u[j] = U[(((size_t)cc_ * 4 + h) * 128 + v) * 64 + k]; d[j] = DEC[((size_t)cc_ * 4 + h) * 64 + k]; } } while (0)
    SCAN_LOAD(0);
    for (int c0 = 0; c0 < NCHUNK; c0 += 8) { float uc[8], dc[8];
#pragma unroll
        for (int j = 0; j < 8; ++j) { uc[j] = u[j]; dc[j] = d[j]; }
        SCAN_LOAD(c0 + 8 < NCHUNK ? c0 + 8 : c0);
#pragma unroll
        for (int j = 0; j < 8; ++j) { const int c = c0 + j; if (c < NCHUNK) { St[(((size_t)c * 4 + h) * 128 + v) * 64 + k] = (bf16)f2bf(S); S = fmaf(dc[j], S, uc[j]); } }
    }
#undef SCAN_LOAD
}
__device__ __forceinline__ void gla_stage3(Frame& F, KArgs A, int l, int c, int h) {
    const bf16* Z = (const bf16*)(F.ws + WS_Z);
    LAS bf16* QT = (LAS bf16*)(F.lds + GL_A0); LAS bf16* KT = QT + 64 * GP; LAS bf16* ATT = KT + 64 * GP; LAS bf16* VT = ATT + 64 * GP; LAS bf16* ST = VT + 128 * GP;
    LAS float* O_s = (LAS float*)(F.lds + GL_A0 + (3 * 64 + 2 * 128) * GP * 2);
    float bcv[8], last_k; gla_bc(F, A, l, c, h, bcv, last_k);
    const int k = F.tid & 63, ig = F.tid >> 6;
#pragma unroll
    for (int ii = 0; ii < 8; ++ii) { const int i = 8 * ig + ii, r = 64 * c + i - GLA_FRONT; float qv = 0.f, kv = 0.f;
        if (r >= 0 && r < NTOK) { qv = bf2f(Z[(size_t)r * ZP + ZC_GQ + h * 64 + k]) * 0.125f; kv = bf2f(Z[(size_t)r * ZP + ZC_GK + h * 64 + k]); }
        QT[i * GP + k] = (bf16)f2bf(qv * __expf(bcv[ii])); KT[i * GP + k] = (bf16)f2bf(kv * __expf(-bcv[ii])); }
    gla_load_vt(F, c, h, VT);
    { const bf16* Sp = (const bf16*)(F.ws + WS_ST) + (((size_t)c * 4 + h) * 128) * 64;
#pragma unroll
      for (int j = 0; j < 2; ++j) { const int q = F.tid + 512 * j, v = q >> 3, kk = (q & 7) * 8; *(LAS u32x4*)(ST + v * GP + kk) = *(const u32x4*)(Sp + (size_t)v * 64 + kk); } }
    __syncthreads();
    if (F.wave < 4) { const int mt = F.wave >> 1, nt = F.wave & 1, r = F.lane & 31, hi = F.lane >> 5; f32x16 acc = {};
        acc = mma_tile(QT + mt * 32 * GP, GP, KT + nt * 32 * GP, GP, 64, acc, F.lane);
#pragma unroll
        for (int rg = 0; rg < 16; ++rg) { const int t = mt * 32 + crow16(rg, hi), s = nt * 32 + r; ATT[t * GP + s] = (bf16)f2bf(s <= t ? acc[rg] : 0.f); } }
    __syncthreads();
    { const int mt = F.wave >> 2, nt = F.wave & 3, r = F.lane & 31, hi = F.lane >> 5; f32x16 acc = {};
      acc = mma_tile(ATT + mt * 32 * GP, GP, VT + nt * 32 * GP, GP, 64, acc, F.lane);
      acc = mma_tile(QT + mt * 32 * GP, GP, ST + nt * 32 * GP, GP, 64, acc, F.lane);
#pragma unroll
      for (int rg = 0; rg < 16; ++rg) O_s[(mt * 32 + crow16(rg, hi)) * 132 + nt * 32 + r] = acc[rg]; }
    __syncthreads();
    { bf16* OM = (bf16*)(F.ws + WS_OM); const float* gn = A->in[I_GNORM] + l * 512 + h * 128;
      const float g0 = gn[F.lane], g1 = gn[F.lane + 64];
      float gr0[8], gr1[8];
#pragma unroll
      for (int ii = 0; ii < 8; ++ii) { const int r = 64 * c + 8 * F.wave + ii - GLA_FRONT; const int rc = r < 0 ? 0 : (r < NTOK ? r : NTOK - 1);
          gr0[ii] = bf2f(Z[(size_t)rc * ZP + ZC_GR + h * 128 + F.lane]); gr1[ii] = bf2f(Z[(size_t)rc * ZP + ZC_GR + h * 128 + F.lane + 64]); }
#pragma unroll
      for (int ii = 0; ii < 8; ++ii) { const int t = 8 * F.wave + ii, r = 64 * c + t - GLA_FRONT;
          const float x0 = O_s[t * 132 + F.lane], x1 = O_s[t * 132 + F.lane + 64];
          const float ss = wave_sum(x0 * x0 + x1 * x1); const float rstd = 1.f / sqrtf(ss * (1.f / 128.f) + LN_EPS);
          if (r >= 0 && r < NTOK) { const float r0 = gr0[ii], r1 = gr1[ii];
              OM[(size_t)r * D + 512 + h * 128 + F.lane] = (bf16)f2bf(x0 * rstd * g0 * (r0 * sigmoidf_fast(r0)));
              OM[(size_t)r * D + 512 + h * 128 + F.lane + 64] = (bf16)f2bf(x1 * rstd * g1 * (r1 * sigmoidf_fast(r1))); } } }
    __syncthreads();
}
__device__ __forceinline__ void conv_item(Frame& F, KArgs A, int l, int rt) {
    const bf16* Z = (const bf16*)(F.ws + WS_Z); bf16* OM = (bf16*)(F.ws + WS_OM);
    const int c4 = 4 * (F.tid & 127), rb = 64 * rt + 16 * __builtin_amdgcn_readfirstlane(F.tid >> 7);
    const float* cw = A->in[I_CONVW] + (size_t)l * 3 * 512;
    const f32x4 w0 = *(const f32x4*)(cw + c4), w1 = *(const f32x4*)(cw + 512 + c4), w2 = *(const f32x4*)(cw + 1024 + c4);
    u32x2 cc[18], cv[18], cb[16];
#pragma unroll
    for (int i = 0; i < 18; ++i) { const int r = rb + i - 2; const int rc = r < 0 ? 0 : (r < NTOK ? r : NTOK - 1);
        cc[i] = *(const u32x2*)(Z + (size_t)rc * ZP + ZC_CC + c4); cv[i] = *(const u32x2*)(Z + (size_t)rc * ZP + ZC_CV + c4);
        if (i >= 2) cb[i - 2] = *(const u32x2*)(Z + (size_t)rc * ZP + ZC_CB + c4); }
#define CV_U(i) ((rb + (i) - 2 >= 0) ? (f32x4){bflo(cc[i].x) * bflo(cv[i].x), bfhi(cc[i].x) * bfhi(cv[i].x), bflo(cc[i].y) * bflo(cv[i].y), bfhi(cc[i].y) * bfhi(cv[i].y)} : (f32x4){0.f, 0.f, 0.f, 0.f})
    f32x4 u2 = CV_U(0), u1 = CV_U(1);
#pragma unroll
    for (int i = 0; i < 16; ++i) { const int r = rb + i; const f32x4 u0 = CV_U(i + 2);
        const f32x4 b = (f32x4){bflo(cb[i].x), bfhi(cb[i].x), bflo(cb[i].y), bfhi(cb[i].y)}, o = b * (w0 * u2 + w1 * u1 + w2 * u0);
        if (r < NTOK) { u32x2 w; w.x = pk2(o[0], o[1]); w.y = pk2(o[2], o[3]); *(u32x2*)(OM + (size_t)r * D + 1024 + c4) = w; }
        u2 = u1; u1 = u0; }
#undef CV_U
}
__device__ __forceinline__ void pool_item(Frame& F, KArgs A, int l, int rt, int g) {
    const bf16* Z = (const bf16*)(F.ws + WS_Z); bf16* OM = (bf16*)(F.ws + WS_OM);
    constexpr int PP = 136;
    LAS float* X_s = (LAS float*)(F.lds); LAS bf16* P_s = (LAS bf16*)(F.lds + 40448); LAS bf16* PW_s = (LAS bf16*)(F.lds + 40448 + 64 * PP * 2);
    const int r0 = 64 * rt, w = 2 << g;
    { float xv[20];
#pragma unroll
      for (int q = 0; q < 20; ++q) { const int idx = F.tid + 512 * q, rr = idx >> 7, c = idx & 127, r = r0 - 15 + rr;
          xv[q] = (idx < 79 * 128 && r >= 0 && r < NTOK) ? bf2f(Z[(size_t)r * ZP + ZC_PZ + g * 128 + c]) : 0.f; }
#pragma unroll
      for (int q = 0; q < 20; ++q) { const int idx = F.tid + 512 * q; if (idx < 79 * 128) X_s[idx] = xv[q]; } }
    { const bf16* pw = (const bf16*)(F.ws + WS_PW) + ((size_t)l * 4 + g) * 128 * 128;
#pragma unroll
      for (int j = 0; j < 4; ++j) { const int q = F.tid + 512 * j, d = q >> 4, cc = (q & 15) * 8; *(LAS u32x4*)(PW_s + d * PP + cc) = *(const u32x4*)(pw + (size_t)d * 128 + cc); } }
    __syncthreads();
    { const int c = F.tid & 127, ib = (F.tid >> 7) * 16;
      float xs[32];
#pragma unroll
      for (int q = 0; q < 32; ++q) xs[q] = (ib + q - 1 >= 0) ? X_s[(ib + q - 1) * 128 + c] : 0.f;
      float sw = 0.f;
#pragma unroll
      for (int j = 0; j < 16; ++j) if (j < w) sw += xs[16 - j];
#pragma unroll
      for (int ii = 0; ii < 16; ++ii) { const int i = ib + ii, t = r0 + i;
          if (ii > 0) { float leave = 0.f;
#pragma unroll
              for (int g2 = 0; g2 < 4; ++g2) if (g2 == g) leave = xs[16 + ii - (2 << g2)];
              sw += xs[16 + ii] - leave; }
          const int cnt = (t + 1 < w) ? (t + 1) : w;
          P_s[i * PP + c] = (bf16)f2bf(sw / (float)cnt - xs[16 + ii]); } }
    __syncthreads();
    { const int mt = F.wave >> 2, nt = F.wave & 3, r = F.lane & 31, hi = F.lane >> 5; f32x16 acc = {};
      acc = mma_tile(P_s + mt * 32 * PP, PP, PW_s + nt * 32 * PP, PP, 128, acc, F.lane);
      const float sc = A->in[I_POOLS][l * 512 + g * 128 + nt * 32 + r];
#pragma unroll
      for (int rg = 0; rg < 16; ++rg) { const int t = r0 + mt * 32 + crow16(rg, hi); if (t < NTOK) OM[(size_t)t * D + 1536 + g * 128 + nt * 32 + r] = (bf16)f2bf(acc[rg] * sc); } }
    __syncthreads();
}
__device__ __forceinline__ void norm_item(Frame& F, int l, int rt) {
    const bf16* Z = (const bf16*)(F.ws + WS_Z);
    const int hq = F.wave, r = 64 * rt + F.lane; float ss = 0.f;
    if (r < NTOK) { const bf16* p = Z + (size_t)r * ZP + ((hq & 1) ? ZC_FK : ZC_FQ) + (hq >> 1) * 128;
#pragma unroll
        for (int j = 0; j < 16; ++j) { const u32x4 w = *(const u32x4*)(p + 8 * j);
            ss += (bflo(w.x) * bflo(w.x) + bfhi(w.x) * bfhi(w.x)) + (bflo(w.y) * bflo(w.y) + bfhi(w.y) * bfhi(w.y)) + (bflo(w.z) * bflo(w.z) + bfhi(w.z) * bfhi(w.z)) + (bflo(w.w) * bflo(w.w) + bfhi(w.w) * bfhi(w.w)); } }
#pragma unroll
    for (int o = 1; o < 64; o <<= 1) ss = fmaxf(ss, __shfl_xor(ss, o));
    if (F.lane == 0) atomicMax((unsigned*)(F.ctl + CW_NRM + 64 * l + hq), __builtin_bit_cast(unsigned, ss));
}
__device__ __forceinline__ void att_decode(int u, int& qb, int& s, int& h) {
    s = 0;
#pragma nounroll
    while (s + 1 < ATT_MAXNS && u >= att_sbase(s + 1)) ++s;
    const int r = u - att_sbase(s); qb = 32 - (r >> 2); h = r & 3;
}
__device__ __forceinline__ int att_unit(int qb, int s, int h) { return att_sbase(s) + 4 * (32 - qb) + h; }
__device__ __forceinline__ void att_combine(Frame& F, int qb, int h) {
    const float* OP = (const float*)(F.ws + WS_OPART); const float* ML = (const float*)(F.ws + WS_ML); bf16* OM = (bf16*)(F.ws + WS_OM);
    const int ns = att_ns(qb), d4 = (F.lane & 31) * 4, rsub = F.lane >> 5;
    f32x2 mln[4]; f32x4 opn[4];
#pragma unroll
    for (int s2 = 0; s2 < 4; ++s2) { mln[s2] = (f32x2){-3.0e38f, 0.f}; opn[s2] = (f32x4){0.f, 0.f, 0.f, 0.f}; }
#define AC_LOAD(st_) do { const int row_ = 32 * F.wave + 2 * (st_) + rsub; _Pragma("unroll") for (int s2 = 0; s2 < 4; ++s2) if (s2 < ns) { const size_t ub = (size_t)att_unit(qb, s2, h) * 256 + row_; \
        mln[s2] = *(const f32x2*)(ML + ub * 2); opn[s2] = *(const f32x4*)(OP + ub * 128 + d4); } } while (0)
    AC_LOAD(0);
#pragma nounroll
    for (int st = 0; st < 16; ++st) { const int row = 32 * F.wave + 2 * st + rsub;
        f32x2 ml[4]; f32x4 op[4];
#pragma unroll
        for (int s2 = 0; s2 < 4; ++s2) { ml[s2] = mln[s2]; op[s2] = opn[s2]; }
        AC_LOAD(st < 15 ? st + 1 : 15);
        float M = -3.0e38f;
#pragma unroll
        for (int s2 = 0; s2 < 4; ++s2) if (s2 < ns) M = fmaxf(M, ml[s2].x);
        bool more = ns > 4 && ml[3].x > -1.0e29f;
        for (int s2 = 4; more && s2 < ns; ++s2) { const float m2 = ML[((size_t)att_unit(qb, s2, h) * 256 + row) * 2]; more = m2 > -1.0e29f; M = fmaxf(M, m2); }
        float wsum = 0.f; f32x4 o = {0.f, 0.f, 0.f, 0.f};
#pragma unroll
        for (int s2 = 0; s2 < 4; ++s2) if (s2 < ns && ml[s2].x > -1.0e29f) { const float e = __builtin_amdgcn_exp2f(ml[s2].x - M); wsum += e * ml[s2].y; o += op[s2] * e; }
        more = ns > 4 && ml[3].x > -1.0e29f;
        for (int s2 = 4; more && s2 < ns; ++s2) { const size_t ub = (size_t)att_unit(qb, s2, h) * 256 + row; const f32x2 m2 = *(const f32x2*)(ML + ub * 2); more = m2.x > -1.0e29f;
            if (more) { const float e = __builtin_amdgcn_exp2f(m2.x - M); wsum += e * m2.y; o += *(const f32x4*)(OP + ub * 128 + d4) * e; } }
        const float inv = 1.f / wsum; const size_t r = (size_t)qb * 256 + row;
        u32x2 w; w.x = pk2(o[0] * inv, o[1] * inv); w.y = pk2(o[2] * inv, o[3] * inv);
        *(u32x2*)(OM + r * D + h * 128 + d4) = w; }
#undef AC_LOAD
}

__device__ __forceinline__ void p3_meta(Frame& F, KArgs A, int l) {
    if (F.vcu >= 128) return;
    const bf16* OM = (const bf16*)(F.ws + WS_OM); const bf16* W = (const bf16*)(F.ws + WS_WBR) + (size_t)l * D * D; const bf16* Z = (const bf16*)(F.ws + WS_Z); bf16* MX = (bf16*)(F.ws + WS_MX);
    const int n0 = 16 * F.vcu, r = F.lane & 15, g = F.lane >> 4, b = F.wave >> 1, kh = F.wave & 1;
    f32x4 acc = {0.f, 0.f, 0.f, 0.f};
    const bf16* ap = OM + (size_t)r * D + b * MIXW + kh * 256 + 8 * g; const bf16* bp = W + (size_t)(n0 + r) * D + b * MIXW + kh * 256 + 8 * g;
#pragma unroll
    for (int ks = 0; ks < 8; ++ks) acc = __builtin_amdgcn_mfma_f32_16x16x32_bf16(*(const bf16x8*)(ap + 32 * ks), *(const bf16x8*)(bp + 32 * ks), acc, 0, 0, 0);
    LAS float* Ps = (LAS float*)(F.lds);
#pragma unroll
    for (int rg = 0; rg < 4; ++rg) Ps[(F.wave * 16 + g * 4 + rg) * 16 + r] = acc[rg];
    __syncthreads();
    if (F.tid < 256) { const int row = F.tid >> 4, col = F.tid & 15; float sum = 0.f;
#pragma unroll
        for (int bb = 0; bb < 4; ++bb) { const float p = Ps[((2 * bb) * 16 + row) * 16 + col] + Ps[((2 * bb + 1) * 16 + row) * 16 + col];
            const float tz = bf2f(Z[(size_t)row * ZP + ZC_GZ + bb * D + n0 + col]);
            sum += __builtin_amdgcn_rcpf(tz) * p; }
        MX[(size_t)row * D + n0 + col] = (bf16)f2bf(sum); }
    __syncthreads();
}
__device__ __forceinline__ void p4_meta(Frame& F, int l) {
    if (F.vcu >= 128) return;
    const bf16* MX = (const bf16*)(F.ws + WS_MX); const bf16* W = (const bf16*)(F.ws + WS_WOUT) + (size_t)l * D * D; bf16* MO = (bf16*)(F.ws + WS_MO);
    const int n0 = 16 * F.vcu, r = F.lane & 15, g = F.lane >> 4;
    f32x4 acc = {0.f, 0.f, 0.f, 0.f};
    const bf16* ap = MX + (size_t)r * D + 256 * F.wave + 8 * g; const bf16* bp = W + (size_t)(n0 + r) * D + 256 * F.wave + 8 * g;
#pragma unroll
    for (int ks = 0; ks < 8; ++ks) acc = __builtin_amdgcn_mfma_f32_16x16x32_bf16(*(const bf16x8*)(ap + 32 * ks), *(const bf16x8*)(bp + 32 * ks), acc, 0, 0, 0);
    LAS float* Ps = (LAS float*)(F.lds);
#pragma unroll
    for (int rg = 0; rg < 4; ++rg) Ps[(F.wave * 16 + g * 4 + rg) * 16 + r] = acc[rg];
    __syncthreads();
    if (F.tid < 256) { const int row = F.tid >> 4, col = F.tid & 15; float sum = 0.f;
#pragma unroll
        for (int w = 0; w < 8; ++w) sum += Ps[(w * 16 + row) * 16 + col];
        MO[(size_t)row * D + n0 + col] = (bf16)f2bf(sum); }
    __syncthreads();
}
typedef __attribute__((address_space(1))) const float gcf32;
#define P5A_LBAR() do { asm volatile("s_waitcnt lgkmcnt(0)" ::: "memory"); __builtin_amdgcn_s_barrier(); } while (0)
__device__ __forceinline__ void p5a_ln_router(Frame& F, KArgs A, int l, bool dummy) {
    const float* Hf = (const float*)(F.ws + WS_HF); const bf16* MO = (const bf16*)(F.ws + WS_MO);
    float* Hfo = (float*)(F.ws + (dummy ? WS_MXF : WS_HF)); bf16* Hb = (bf16*)(F.ws + (dummy ? WS_OPART : WS_HB));
    int* EID = (int*)(F.ws + (dummy ? WS_ML : WS_EID)); float* WTS = (float*)(F.ws + (dummy ? WS_ML + 70000 : WS_WTS)); int* DST = (int*)(F.ws + (dummy ? WS_ML + 140000 : WS_DST)); const int cw = CW_ECNT + 64 * l + (dummy ? 32 : 0);
    constexpr int HP = 2052;
    LAS float* Hs = (LAS float*)(F.lds); LAS float* Ps = Hs; LAS float* sel_s = Hs + 16 * HP; LAS float* aff_s = sel_s + 512;
    static_assert((16 * HP + 1024 + 32) * 4 <= LDSCTL_OFF, "P5a LDS");
    const int c = F.lane & 15, g = F.lane >> 4;
    f32x4 hv[2][8]; u32x2 mv[2][8];
#define P5A_LOAD(item) do { _Pragma("unroll") for (int rr = 0; rr < 2; ++rr) { const size_t m_ = (size_t)(16 * (item) + 2 * F.wave + rr); \
        _Pragma("unroll") for (int j = 0; j < 8; ++j) { mv[rr][j] = *(const u32x2*)(MO + m_ * D + 4 * F.lane + 256 * j); hv[rr][j] = *(const f32x4*)(Hf + m_ * D + 4 * F.lane + 256 * j); } } } while (0)
    int it = F.vcu + ((l == DEPTH - 1 && F.vcu == 0) ? F.G : 0);
    if (it < NTOK / 16) P5A_LOAD(it);
    for (; it < NTOK / 16; it += F.G) {
        const int m0 = 16 * it;
#pragma unroll
        for (int rr = 0; rr < 2; ++rr) { const int r = 2 * F.wave + rr; const size_t m = (size_t)(m0 + r);
            f32x4 v[8];
#pragma unroll
            for (int j = 0; j < 8; ++j) { const u32x2 mo = mv[rr][j]; v[j] = hv[rr][j] * ALPHA + (f32x4){bflo(mo.x), bfhi(mo.x), bflo(mo.y), bfhi(mo.y)}; }
            { const GAS float* g1_ = (const GAS float*)(A->in[I_LN1G] + l * D); const GAS float* b1_ = (const GAS float*)(A->in[I_LN1B] + l * D); asm volatile("" : "+s"(g1_), "+s"(b1_));
              ln_row_regs(v, (const float*)g1_, (const float*)b1_, F.lane); }
#pragma unroll
            for (int j = 0; j < 8; ++j) *(LAS f32x4*)(Hs + r * HP + 4 * F.lane + 256 * j) = v[j];
            __builtin_amdgcn_sched_barrier(0); }
        __builtin_amdgcn_sched_barrier(0);
        float q0[32], q1[32], q2[32];
        unsigned lo_ = (unsigned)(g * 32 + c) * 4u; asm volatile("" : "+v"(lo_));
        const char* rw_ = (const char*)(A->in[I_RW]) + (size_t)F.wave * 32768; asm volatile("" : "+s"(rw_));
#define P5A_LOADQ(q, qi) do { _Pragma("unroll") for (int h_ = 0; h_ < 2; ++h_) { const gcf32* ub_ = (const gcf32*)(rw_ + ((qi) * 2 + h_) * 4096 + lo_); \
            _Pragma("unroll") for (int k8 = 0; k8 < 8; ++k8) { q[(h_ * 8 + k8) * 2] = ub_[k8 * 128]; q[(h_ * 8 + k8) * 2 + 1] = ub_[k8 * 128 + 16]; } } } while (0)
#define P5A_MFMAQ(q, qi) do { _Pragma("unroll") for (int k_ = 0; k_ < 16; ++k_) { const float a_ = ap[4 * ((qi) * 16 + k_)]; \
            acc0 = __builtin_amdgcn_mfma_f32_16x16x4f32(a_, q[2 * k_], acc0, 0, 0, 0); acc1 = __builtin_amdgcn_mfma_f32_16x16x4f32(a_, q[2 * k_ + 1], acc1, 0, 0, 0); } } while (0)
        P5A_LOADQ(q0, 0); P5A_LOADQ(q1, 1); P5A_LOADQ(q2, 2);
        __builtin_amdgcn_sched_barrier(0);
#pragma unroll
        for (int rr = 0; rr < 2; ++rr) { const int r = 2 * F.wave + rr; const size_t m = (size_t)(m0 + r);
#pragma unroll
            for (int j = 0; j < 8; ++j) { const f32x4 u = *(const LAS f32x4*)(Hs + r * HP + 4 * F.lane + 256 * j);
                *(f32x4*)(Hfo + m * D + 4 * F.lane + 256 * j) = u; u32x2 w; w.x = pk2(u.x, u.y); w.y = pk2(u.z, u.w); *(u32x2*)(Hb + m * D + 4 * F.lane + 256 * j) = w;
                if ((j & 1) == 1) __builtin_amdgcn_sched_barrier(0); } }
        P5A_LBAR();
        f32x4 acc0 = {0.f, 0.f, 0.f, 0.f}, acc1 = {0.f, 0.f, 0.f, 0.f};
        { const LAS float* ap = Hs + c * HP + 256 * F.wave + g;
          P5A_MFMAQ(q0, 0); __builtin_amdgcn_sched_barrier(0);
          P5A_LOADQ(q0, 3); __builtin_amdgcn_sched_barrier(0);
          P5A_MFMAQ(q1, 1); __builtin_amdgcn_sched_barrier(0);
          P5A_MFMAQ(q2, 2); __builtin_amdgcn_sched_barrier(0);
          P5A_MFMAQ(q0, 3); }
#undef P5A_LOADQ
#undef P5A_MFMAQ
        P5A_LBAR();
#pragma unroll
        for (int rg = 0; rg < 4; ++rg) { Ps[(F.wave * 16 + g * 4 + rg) * 32 + c] = acc0[rg]; Ps[(F.wave * 16 + g * 4 + rg) * 32 + 16 + c] = acc1[rg]; }
        P5A_LBAR();
        { const int row = F.tid >> 5, e = F.tid & 31; float logit = 0.f;
#pragma unroll
          for (int w = 0; w < 8; ++w) logit += Ps[(w * 16 + row) * 32 + e];
          const float aff = 1.f / (1.f + __expf(-logit)); sel_s[row * 32 + e] = aff + A->in[I_RB][e]; aff_s[row * 32 + e] = aff; }
        P5A_LBAR();
        __builtin_amdgcn_sched_barrier(0);
        if (it + F.G < NTOK / 16) P5A_LOAD(it + F.G);
        if (F.tid < 16) { const int row = F.tid, m = m0 + row; const LAS float* ss = sel_s + row * 32;
            int bg = 0; float bs = -3.0e38f;
#pragma unroll
            for (int gi = 0; gi < 8; ++gi) { const f32x4 s4 = *(const LAS f32x4*)(ss + 4 * gi);
                const float h1 = fmaxf(s4.x, s4.y), l1 = fminf(s4.x, s4.y), h2 = fmaxf(s4.z, s4.w), l2 = fminf(s4.z, s4.w);
                const float sc = fmaxf(h1, h2) + fmaxf(fminf(h1, h2), fmaxf(l1, l2)); if (sc > bs) { bs = sc; bg = gi; } }
            float sv[4]; { const f32x4 s4 = *(const LAS f32x4*)(ss + 4 * bg); sv[0] = s4.x; sv[1] = s4.y; sv[2] = s4.z; sv[3] = s4.w; }
            int i0 = 0; float b0 = sv[0];
#pragma unroll
            for (int i = 1; i < 4; ++i) if (sv[i] > b0) { b0 = sv[i]; i0 = i; }
            int i1 = -1; float b1 = -3.0e38f;
#pragma unroll
            for (int i = 0; i < 4; ++i) if (i != i0 && sv[i] > b1) { b1 = sv[i]; i1 = i; }
            const int e0 = 4 * bg + i0, e1 = 4 * bg + i1; const float w0 = aff_s[row * 32 + e0], w1 = aff_s[row * 32 + e1], ws = w0 + w1;
            LAS int* pk = (LAS int*)(aff_s + 512); pk[2 * row] = e0; pk[2 * row + 1] = e1;
            asm volatile("s_waitcnt lgkmcnt(0)" ::: "memory");
            int r0 = 0, r1 = 0;
#pragma unroll
            for (int q = 0; q < 16; ++q) { const int a = pk[2 * q], b = pk[2 * q + 1]; if (q < row) { r0 += (a == e0) + (b == e0); r1 += (a == e1) + (b == e1); } }
            EID[2 * m] = e0; EID[2 * m + 1] = e1; WTS[2 * m] = w0 / ws; WTS[2 * m + 1] = w1 / ws; DST[2 * m] = r0; DST[2 * m + 1] = r1; }
        if (F.tid < 32) { const LAS int* pk = (const LAS int*)(aff_s + 512); int cn = 0;
            asm volatile("s_waitcnt lgkmcnt(0)" ::: "memory");
#pragma unroll
            for (int q = 0; q < 32; ++q) cn += (pk[q] == F.tid);
            ((int*)(F.ws + WS_CNT))[((size_t)(l * 2 + (dummy ? 1 : 0)) * (NTOK / 16) + it) * NEXP + F.tid] = cn; }
    }
#undef P5A_LOAD
    __syncthreads();
}
#undef P5A_LBAR
__device__ __forceinline__ int moe_tables(Frame& F, int l, LAS int* tt, LAS int* pstart, const LAS int* lcnt = nullptr) {
    if (F.tid < 64) {
        const int e = F.lane & 31;
        const int cnt = lcnt ? lcnt[e] : (int)__hip_atomic_load((unsigned*)(F.ctl + CW_ECNT + 64 * l + e), RLX_AGENT);
        const int nt = (cnt + 255) >> 8; int inc = nt;
#pragma unroll
        for (int d = 1; d < 32; d <<= 1) { const int t = __shfl_up(inc, d, 64); if (e >= d) inc += t; }
        const int excl = inc - nt;
        if (F.lane < 32) { pstart[e] = excl << 8;
#pragma nounroll
            for (int q = 0; q < nt; ++q) tt[excl + q] = e;
            if (e == NEXP - 1) pstart[NEXP] = inc; }
    }
    __syncthreads();
    return __builtin_amdgcn_readfirstlane(pstart[NEXP]);
}
__device__ __forceinline__ void p5b_scatter(Frame& F, int l, bool dummy) {
    LAS int* tt = (LAS int*)(F.lds); LAS int* pstart = tt + 128;
    constexpr int NIT = NTOK / 16, SEGI = (NIT + 15) / 16;
    LAS int* T = (LAS int*)(F.lds + 1024); LAS int* segs = T + NIT * NEXP; LAS int* tot = segs + 16 * NEXP;
    { const int* CNT = (const int*)(F.ws + WS_CNT) + (size_t)(l * 2) * NIT * NEXP;
      { constexpr int NV = NIT * NEXP / 4; typedef int i32x4c __attribute__((ext_vector_type(4))); i32x4c cv[(NV + NWAVES * 64 - 1) / (NWAVES * 64)];
#pragma unroll
        for (int q = 0; q < (NV + NWAVES * 64 - 1) / (NWAVES * 64); ++q) { const int i4 = F.tid + NWAVES * 64 * q; cv[q] = (i4 < NV) ? ((const i32x4c*)CNT)[i4] : (i32x4c){0, 0, 0, 0}; }
#pragma unroll
        for (int q = 0; q < (NV + NWAVES * 64 - 1) / (NWAVES * 64); ++q) { const int i4 = F.tid + NWAVES * 64 * q;
            if (i4 < NV) *(LAS i32x4c*)(T + 4 * i4) = (l == DEPTH - 1 && i4 < NEXP / 4) ? (i32x4c){0, 0, 0, 0} : cv[q]; } }
      __syncthreads();
      const int e = F.tid & 31, sg = F.tid >> 5, lo = sg * SEGI, hi = (lo + SEGI < NIT) ? lo + SEGI : NIT; int sum = 0;
      for (int i = lo; i < hi; ++i) sum += T[i * NEXP + e];
      segs[sg * NEXP + e] = sum;
      __syncthreads();
      int run = 0;
      for (int q = 0; q < sg; ++q) run += segs[q * NEXP + e];
      for (int i = lo; i < hi; ++i) { const int c = T[i * NEXP + e]; T[i * NEXP + e] = run; run += c; }
      if (sg == 15) { tot[e] = run; if (F.vcu == 0 && !dummy) __hip_atomic_store((unsigned*)(F.ctl + CW_ECNT + 64 * l + e), (unsigned)run, RLX_AGENT); }
      __syncthreads(); }
    (void)moe_tables(F, l, tt, pstart, tot);
    const bf16* Hb = (const bf16*)(F.ws + WS_HB); bf16* XR = (bf16*)(F.ws + (dummy ? WS_Y : WS_XR)); const int* EID = (const int*)(F.ws + WS_EID); const int* DST = (const int*)(F.ws + WS_DST); int* DSTo = (int*)(F.ws + (dummy ? WS_OPART : WS_DST));
    const int gw = F.vcu * NWAVES + F.wave, NGW = F.G * NWAVES;
    { int m = (l == DEPTH - 1 && gw < NMETA) ? gw + NGW : gw;
      if (m < NTOK) {
        u32x4 v[4]; int e0 = EID[2 * m], e1 = EID[2 * m + 1], s0 = DST[2 * m], s1 = DST[2 * m + 1];
#pragma unroll
        for (int j = 0; j < 4; ++j) v[j] = *(const u32x4*)(Hb + (size_t)m * D + 8 * F.lane + 512 * j);
        for (;;) {
            const int mn = m + NGW; const bool more = mn < NTOK; const int mc = more ? mn : m;
            u32x4 vn[4]; const int ne0 = EID[2 * mc], ne1 = EID[2 * mc + 1], ns0 = DST[2 * mc], ns1 = DST[2 * mc + 1];
#pragma unroll
            for (int j = 0; j < 4; ++j) vn[j] = *(const u32x4*)(Hb + (size_t)mc * D + 8 * F.lane + 512 * j);
            const int d0 = pstart[e0] + T[(m >> 4) * NEXP + e0] + s0, d1 = pstart[e1] + T[(m >> 4) * NEXP + e1] + s1;
#pragma unroll
            for (int j = 0; j < 4; ++j) { *(u32x4*)(XR + (size_t)d0 * D + 8 * F.lane + 512 * j) = v[j]; *(u32x4*)(XR + (size_t)d1 * D + 8 * F.lane + 512 * j) = v[j]; }
            if (F.lane == 0) { DSTo[2 * m] = d0; DSTo[2 * m + 1] = d1; }
            if (!more) break;
            m = mn; e0 = ne0; e1 = ne1; s0 = ns0; s1 = ns1;
#pragma unroll
            for (int j = 0; j < 4; ++j) v[j] = vn[j];
        } } }
    __syncthreads();
}
__device__ __forceinline__ void p8_ln2(Frame& F, KArgs A, int l, bool dummy) {
    const float* Hf = (const float*)(F.ws + WS_HF); float* Hfo = (float*)(F.ws + (dummy ? WS_MXF : WS_HF)); bf16* Hb = (bf16*)(F.ws + (dummy ? WS_OPART : WS_HB)); const bf16* Y = (const bf16*)(F.ws + WS_Y);
    const float* WTS = (const float*)(F.ws + WS_WTS); const int* DST = (const int*)(F.ws + WS_DST);
    const int gw = F.vcu * NWAVES + F.wave, NGW = F.G * NWAVES;
    f32x4 gg[8], bb[8];
    { const float* g = A->in[I_LN2G] + l * D; const float* b = A->in[I_LN2B] + l * D;
#pragma unroll
      for (int j = 0; j < 8; ++j) { gg[j] = *(const f32x4*)(g + 4 * F.lane + 256 * j); bb[j] = *(const f32x4*)(b + 4 * F.lane + 256 * j); } }
    int m = (l == DEPTH - 1 && gw < NMETA) ? gw + NGW : gw;
    if (m >= NTOK) return;
    u32x2 y0[8], y1[8]; f32x4 hf[8];
    int d0 = DST[2 * m], d1 = DST[2 * m + 1]; float w0 = WTS[2 * m], w1 = WTS[2 * m + 1];
#define P8_LOAD(mm, da, db) do { _Pragma("unroll") for (int j = 0; j < 8; ++j) { y0[j] = *(const u32x2*)(Y + (size_t)(da) * D + 4 * F.lane + 256 * j); y1[j] = *(const u32x2*)(Y + (size_t)(db) * D + 4 * F.lane + 256 * j); \
        hf[j] = *(const f32x4*)(Hf + (size_t)(mm) * D + 4 * F.lane + 256 * j); } } while (0)
    P8_LOAD(m, d0, d1);
    int mn = m + NGW; int nd0 = 0, nd1 = 0; float nw0 = 0.f, nw1 = 0.f;
    if (mn < NTOK) { nd0 = DST[2 * mn]; nd1 = DST[2 * mn + 1]; nw0 = WTS[2 * mn]; nw1 = WTS[2 * mn + 1]; }
    for (;;) {
        f32x4 v[8];
#pragma unroll
        for (int j = 0; j < 8; ++j) { const f32x4 a = (f32x4){bflo(y0[j].x), bfhi(y0[j].x), bflo(y0[j].y), bfhi(y0[j].y)}, b = (f32x4){bflo(y1[j].x), bfhi(y1[j].x), bflo(y1[j].y), bfhi(y1[j].y)};
            v[j] = hf[j] * ALPHA + (a * w0 + b * w1); }
        const bool more = mn < NTOK;
        const int mc = more ? mn : m;
        { const int da = more ? nd0 : d0, db = more ? nd1 : d1; P8_LOAD(mc, da, db); }
        const int mnn = mn + NGW; const int mi = (mnn < NTOK) ? mnn : m;
        const int xd0 = DST[2 * mi], xd1 = DST[2 * mi + 1]; const float xw0 = WTS[2 * mi], xw1 = WTS[2 * mi + 1];
        ln_row_pre(v, gg, bb);
        if (l == DEPTH - 1) store_row(v, (dummy ? Hfo : F.out) + (size_t)(m - NMETA) * D, nullptr, F.lane);
        else store_row(v, Hfo + (size_t)m * D, Hb + (size_t)m * D, F.lane, dummy ? nullptr : (unsigned char*)(F.ws + WS_HQ + (size_t)m * D));
        if (!more) break;
        m = mn; d0 = nd0; d1 = nd1; w0 = nw0; w1 = nw1; mn = mnn; nd0 = xd0; nd1 = xd1; nw0 = xw0; nw1 = xw1;
    }
#undef P8_LOAD
}

constexpr int PH_PER_LAYER = 10, N_PHASES = 1 + DEPTH * PH_PER_LAYER;
__global__ void __launch_bounds__(NWAVES * 64, 2) mk_fwd(Args args) {
    extern __shared__ __attribute__((aligned(16))) unsigned char lds[];
    Frame F;
    F.lds = (LAS unsigned char*)lds; F.MISC = (volatile LAS unsigned*)(F.lds + MISC_OFF);
    F.tid = threadIdx.x; F.lane = F.tid & 63; F.wave = __builtin_amdgcn_readfirstlane(F.tid >> 6);
    F.G = gridDim.x; { const int bx = blockIdx.x; F.vcu = (F.G % 8 == 0) ? (bx % 8) * (F.G / 8) + bx / 8 : bx; }
    F.ws = (GAS unsigned char*)args.ws; F.ctl = (gu32*)(args.ws + WS_CTL); F.out = args.out;
    for (int u = F.tid; u < (LDS_BYTES - LDSCTL_OFF) / 4; u += NWAVES * 64) ((LAS unsigned*)(F.lds + LDSCTL_OFF))[u] = 0u;
    __syncthreads();
    XcdBarrier bar; bar.bar = (unsigned*)(F.ctl + CW_BAR); bar.x = 0; bar.st = nullptr;
    if (!MK_PER_PHASE) bar = xcd_barrier_post((unsigned*)(F.ctl + CW_BAR), F.MISC + 8);
    const int lo = args.ph_lo, hi = args.ph_hi; KArgs KA = kargs();
#define IN(k) (lo <= (k) && (k) < hi)
#define SEAM(k) do { if (IN(k) && IN((k) + 1)) { if (MK_PER_PHASE) { if (F.tid == 0) __hip_atomic_store(F.ctl + CW_TMO, 0xBADBA0u, RLX_AGENT); } else xcd_barrier(bar); } } while (0)

    if ((MK_MASK & 1u) && IN(0)) { p0_prologue(F, KA); if (MK_REPEAT & 1u) p0_prologue(F, KA); } SEAM(0);

#define REFRESH() do { const int t_ = opaque_tid(); F.tid = t_; F.lane = t_ & 63; F.wave = __builtin_amdgcn_readfirstlane(t_ >> 6); \
        KA = kargs(); GAS unsigned char* w_ = (GAS unsigned char*)KA->ws; asm volatile("" : "+s"(w_)); F.ws = w_; F.ctl = (gu32*)(w_ + WS_CTL); } while (0)
#define LAYER_BODY(l) do { \
        const int pb = 1 + l * PH_PER_LAYER; \
        if ((MK_MASK & 2u) && IN(pb + 0)) for (int rep = 0; rep < ((MK_REPEAT & 2u) ? 2 : 1); ++rep) { REFRESH(); \
            { pg8::OrderDenseR S{(const char*)(F.ws + WS_HB), (const char*)(F.ws + WS_WIN) + (size_t)l * NIN_T * D * 2, (size_t)256 * D * 2, (size_t)256 * D * 2, MP / 256, ZC_GZ / 256 + 1, F.G, (int)blockIdx.x, 52}; \
              pg8::EpiZ E{(bf16*)(F.ws + WS_Z), (float*)(F.ws + WS_ZS), 1.f}; \
              pg8::gemm_phase<pg8::EpiZ, pg8::OrderDenseR>(F.lds, pg8::Gemm{D, D, D}, S, E); } \
            REFRESH(); \
            { pg8::OrderDenseQ S{(const char*)(F.ws + WS_HQ), (const char*)(F.ws + WS_WQ) + (size_t)l * 4 * D * D, (size_t)256 * D, (size_t)256 * D, MP / 256, ZC_GZ / 256, \
                                 (unsigned*)(F.ctl + CW_QG1 + 256 * l + 128 * rep), (int)(blockIdx.x & 7), F.MISC + 2}; \
              pg8::EpiZG E{(bf16*)(F.ws + WS_Z), KA->in[I_GATEB] + (size_t)l * 4 * D, 1.f / WQ_SCALE}; \
              pg8::gemm_phase<pg8::EpiZG, pg8::OrderDenseQ, true, true>(F.lds, pg8::Gemm{D / 2, D / 2, D / 2}, S, E); } \
            if (rep == ((MK_REPEAT & 2u) ? 1 : 0)) SEAM(pb + 0); else if (MK_REPBAR) xcd_barrier(bar); \
        } \
        if ((MK_MASK & 4u) && IN(pb + 1)) for (int rep = 0; rep < ((MK_REPEAT & 4u) ? 2 : 1); ++rep) { REFRESH(); \
            constexpr int N0 = 4, N1 = N0 + NCHUNK * 4, N2 = N1 + NCHUNK; \
            for (int it = F.vcu; it < N2; it += F.G) { \
                if (it < N0) p2a_cumsum(F, KA, l, it); \
                else if (it < N1) { const int q = it - N0; gla_stage1(F, KA, l, q >> 2, q & 3); } \
                else norm_item(F, l, it - N1); \
            } \
            if (rep == ((MK_REPEAT & 4u) ? 1 : 0)) SEAM(pb + 1); else if (MK_REPBAR) xcd_barrier(bar); \
        } \
        if ((MK_MASK & 8u) && IN(pb + 2)) for (int rep = 0; rep < ((MK_REPEAT & 8u) ? 2 : 1); ++rep) { REFRESH(); \
            const bf16* Z = (const bf16*)(F.ws + WS_Z); \
            for (bool first_ = true;; first_ = false) { \
                int it = F.vcu;     \
                if (!first_) { if (F.tid == 0) F.MISC[0] = __hip_atomic_fetch_add((unsigned*)(F.ctl + CW_QATT + 64 * l + 16 * rep), 1u, RLX_AGENT); \
                    __syncthreads(); \
                    it = (int)F.MISC[0] + F.G; \
                    __syncthreads(); } \
                constexpr int QA = att_sbase(2); \
                if (it >= SCAN_ITEMS + ATT_NU) break; \
                if (it >= QA && it < QA + SCAN_ITEMS) { gla_scan_item(F, it - QA); continue; } \
                const int u = it < QA ? it : it - SCAN_ITEMS; \
                int qb, s, h; att_decode(u, qb, s, h); \
                const int T = 4 * (qb + 1), jb = T - s * ATT_SEG; int ja = jb - ATT_SEG > 0 ? jb - ATT_SEG : 0; \
                const float* nck = (const float*)(F.ws + WS_C2) + (size_t)h * MP; float* MLp = (float*)(F.ws + WS_ML) + (size_t)u * 256 * 2; \
                { const float q2 = __builtin_bit_cast(float, __hip_atomic_load((unsigned*)(F.ctl + CW_NRM + 64 * l + 2 * h), RLX_AGENT)), k2 = __builtin_bit_cast(float, __hip_atomic_load((unsigned*)(F.ctl + CW_NRM + 64 * l + 2 * h + 1), RLX_AGENT)); \
                  const float thr = nck[qb * 256] - 2.f * LOG2E * 0.08838834764831845f * sqrtf(q2 * k2) - 150.f; \
                  const int jj = ja + F.lane; const bool keep = (jj < jb) && (nck[64 * (jj < jb ? jj : ja) + 63] >= thr); \
                  const unsigned long long bm = __ballot(keep); ja = bm ? ja + (int)__builtin_ctzll(bm) : jb; } \
                if (ja >= jb) { if (F.tid < 256) *(f32x2*)(MLp + 2 * F.tid) = (f32x2){-1e30f, 0.f}; continue; } \
                att::attn_unit(Z + ZC_FQ + h * 128, Z + ZC_FK + h * 128, Z + ZC_FV + h * 128, nck, qb * 256, ja, jb, \
                               (float*)(F.ws + WS_OPART) + (size_t)u * 256 * 128, MLp, F.lds); \
            } \
            REFRESH(); \
            for (bool first_ = true;; first_ = false) { \
                int it = F.vcu; \
                if (!first_) { if (F.tid == 0) F.MISC[0] = __hip_atomic_fetch_add((unsigned*)(F.ctl + CW_QATT + 64 * l + 48 + 8 * rep), 1u, RLX_AGENT); \
                    __syncthreads(); \
                    it = (int)F.MISC[0] + F.G; \
                    __syncthreads(); } \
                if (it >= NCHUNK * 5) break; \
                if (it < NCHUNK) conv_item(F, KA, l, it); else { const int q_ = it - NCHUNK; pool_item(F, KA, l, q_ >> 2, q_ & 3); } \
            } \
            if (rep == ((MK_REPEAT & 8u) ? 1 : 0)) SEAM(pb + 2); else if (MK_REPBAR) xcd_barrier(bar); \
        } \
        if ((MK_MASK & 16u) && IN(pb + 3)) for (int rep = 0; rep < ((MK_REPEAT & 16u) ? 2 : 1); ++rep) { REFRESH(); \
            constexpr int N0 = NCHUNK * 4, N1 = N0 + ATT_NQB * 4; \
            for (bool first_ = true;; first_ = false) { \
                int it = F.vcu; \
                if (!first_) { if (F.tid == 0) F.MISC[0] = __hip_atomic_fetch_add((unsigned*)(F.ctl + CW_QATT + 64 * l + 32 + 8 * rep), 1u, RLX_AGENT); \
                    __syncthreads(); \
                    it = (int)F.MISC[0] + F.G; \
                    __syncthreads(); } \
                if (it >= N1) break; \
                if (it < N0) gla_stage3(F, KA, l, it >> 2, it & 3); \
                else { const int q = it - N0; att_combine(F, q >> 2, q & 3); } \
            } \
            if (rep == ((MK_REPEAT & 16u) ? 1 : 0)) SEAM(pb + 3); else if (MK_REPBAR) xcd_barrier(bar); \
        } \
        if ((MK_MASK & 32u) && IN(pb + 4)) for (int rep = 0; rep < ((MK_REPEAT & 32u) ? 2 : 1); ++rep) { REFRESH(); \
            pg8::OrderDense S{(const char*)(F.ws + WS_OM) + (size_t)NMETA * D * 2, (const char*)(F.ws + WS_WBR) + (size_t)l * D * D * 2, (size_t)256 * D * 2, (size_t)256 * D * 2, SEQ / 256, D / 256, F.G, (int)blockIdx.x}; \
            pg8::EpiMergeSeg E{(const bf16*)(F.ws + WS_Z), KA->in[I_GATEB] + (size_t)l * 4 * D, (bf16*)(F.ws + WS_MX), NMETA}; \
            if (l != DEPTH - 1) p3_meta(F, KA, l);     \
            pg8::gemm_phase<pg8::EpiMergeSeg, pg8::OrderDense>(F.lds, pg8::Gemm{D, D, D}, S, E); \
            if (rep == ((MK_REPEAT & 32u) ? 1 : 0)) SEAM(pb + 4); else if (MK_REPBAR) xcd_barrier(bar); \
        } \
        if ((MK_MASK & 64u) && IN(pb + 5)) for (int rep = 0; rep < ((MK_REPEAT & 64u) ? 2 : 1); ++rep) { REFRESH(); \
            pg8::OrderDense S{(const char*)(F.ws + WS_MX) + (size_t)NMETA * D * 2, (const char*)(F.ws + WS_WOUT) + (size_t)l * D * D * 2, (size_t)256 * D * 2, (size_t)256 * D * 2, SEQ / 256, D / 256, F.G, (int)blockIdx.x}; \
            pg8::EpiBf16 E{(bf16*)(F.ws + WS_MO), D, NMETA}; \
            if (l != DEPTH - 1) p4_meta(F, l); \
            pg8::gemm_phase<pg8::EpiBf16, pg8::OrderDense>(F.lds, pg8::Gemm{D, D, D}, S, E); \
            if (rep == ((MK_REPEAT & 64u) ? 1 : 0)) SEAM(pb + 5); else if (MK_REPBAR) xcd_barrier(bar); \
        } \
        if ((MK_MASK & 128u) && IN(pb + 6)) for (int rep = 0; rep < ((MK_REPEAT & 128u) ? 2 : 1); ++rep) { REFRESH(); p5a_ln_router(F, KA, l, (MK_REPEAT & 128u) && rep == 0); if (rep == ((MK_REPEAT & 128u) ? 1 : 0)) SEAM(pb + 6); else if (MK_REPBAR) xcd_barrier(bar); } \
        if ((MK_MASK & 256u) && IN(pb + 7)) for (int rep = 0; rep < ((MK_REPEAT & 256u) ? 2 : 1); ++rep) { REFRESH(); p5b_scatter(F, l, (MK_REPEAT & 256u) && rep == 0); if (rep == ((MK_REPEAT & 256u) ? 1 : 0)) SEAM(pb + 7); else if (MK_REPBAR) xcd_barrier(bar); } \
        if ((MK_MASK & 512u) && IN(pb + 8)) { REFRESH(); \
            const int ntiles = moe_tables(F, l, (LAS int*)(F.lds + MISC_OFF + 128), (LAS int*)(F.lds + MISC_OFF + 128 + 512)); \
            { pg8::OrderMoeF S{(const char*)(F.ws + WS_XR), KA->in[I_WG] + (size_t)l * NEXP * D * DEXP, KA->in[I_WU] + (size_t)l * NEXP * D * DEXP, 256u * D * 2u, \
                             (const LAS int*)(F.lds + MISC_OFF + 128), ntiles, F.G, F.vcu, true}; \
              pg8::EpiSwiGLU E{(bf16*)(F.ws + WS_HM), (unsigned*)(F.ctl + CW_RDY + 256 * l)}; \
              pg8::gemm_phase_breg<pg8::EpiSwiGLU, pg8::OrderMoeF>(F.lds, pg8::Gemm{D, DEXP, D}, S, E); } \
            REFRESH(); \
            { pg8::OrderMoeDyn S{(const char*)(F.ws + WS_HM), KA->in[I_WD] + (size_t)l * NEXP * D * DEXP, 256u * DEXP * 2u, (const LAS int*)(F.lds + MISC_OFF + 128), ntiles * 8, \
                             (unsigned*)(F.ctl + CW_QMOE + 64 * l), (unsigned*)(F.ctl + CW_RDY + 256 * l), (unsigned*)(F.ctl + CW_BAR) + XB_TMO, F.MISC + 2}; \
              pg8::EpiBf16 E{(bf16*)(F.ws + WS_Y), D, 0}; \
              pg8::gemm_phase_breg<pg8::EpiBf16, pg8::OrderMoeDyn>(F.lds, pg8::Gemm{DEXP, D, DEXP}, S, E); } \
            SEAM(pb + 8); \
        } \
        if ((MK_MASK & 2048u) && IN(pb + 9)) for (int rep = 0; rep < ((MK_REPEAT & 2048u) ? 2 : 1); ++rep) { REFRESH(); p8_ln2(F, KA, l, (MK_REPEAT & 2048u) && rep == 0); if (rep == ((MK_REPEAT & 2048u) ? 1 : 0)) SEAM(pb + 9); else if (MK_REPBAR) xcd_barrier(bar); } \
    } while (0)
    LAYER_BODY(0);
    LAYER_BODY(1);
#undef LAYER_BODY
#undef IN
#undef SEAM
#undef REFRESH
}

extern "C" void kernel_launch(void* const* d_in, const int* in_sizes, int n_in, void* d_out, int out_size, void* d_ws, size_t ws_size, hipStream_t stream) {
    static int grid = 0;
    if (grid == 0) {
        if (n_in != 24 || out_size != SEQ * D || ws_size < WS_END) { fprintf(stderr, "kernel_launch: unexpected shapes (n_in %d, out %d, ws %zu < %zu)\n", n_in, out_size, ws_size, (size_t)WS_END); grid = -1; return; }
        int dev = 0, cus = 0, per_cu = 0;
        if (hipGetDevice(&dev) != hipSuccess || hipDeviceGetAttribute(&cus, hipDeviceAttributeMultiprocessorCount, dev) != hipSuccess) { grid = -1; return; }
        if (hipFuncSetAttribute((const void*)mk_fwd, hipFuncAttributeMaxDynamicSharedMemorySize, LDS_BYTES) != hipSuccess) { fprintf(stderr, "kernel_launch: hipFuncSetAttribute failed\n"); grid = -1; return; }
        if (hipOccupancyMaxActiveBlocksPerMultiprocessor(&per_cu, (const void*)mk_fwd, NWAVES * 64, LDS_BYTES) != hipSuccess || per_cu < 1) { fprintf(stderr, "kernel_launch: occupancy query says %d blocks per CU\n", per_cu); }
        (void)hipGetLastError();
        grid = cus;
    }
    if (grid < 0) return;
    if (hipMemsetAsync((char*)d_ws + WS_CTL, 0, CTL_BYTES, stream) != hipSuccess) return;
    Args a{};
    for (int i = 0; i < 24; ++i) a.in[i] = (const float*)d_in[i];
    a.out = (float*)d_out; a.ws = (unsigned char*)d_ws;
#if MK_PER_PHASE
    for (int p = 0; p < N_PHASES; ++p) { a.ph_lo = p; a.ph_hi = p + 1; hipLaunchKernelGGL(mk_fwd, dim3(grid), dim3(NWAVES * 64), LDS_BYTES, stream, a); }
#else
    a.ph_lo = 0; a.ph_hi = N_PHASES;
    hipLaunchKernelGGL(mk_fwd, dim3(grid), dim3(NWAVES * 64), LDS_BYTES, stream, a);
#endif
}
```

```cpp
#include <hip/hip_runtime.h>
#include <cstdio>
#include <cstdint>

#ifndef MK_PER_PHASE
#define MK_PER_PHASE 0
#endif
#ifndef MK_REPEAT
#define MK_REPEAT 0u
#endif
#ifndef MK_REPBAR
#define MK_REPBAR 0
#endif
#ifndef MK_MASK
#define MK_MASK 0xFFFu
#endif

#define GAS __attribute__((address_space(1)))
#define LAS __attribute__((address_space(3)))
typedef unsigned short bf16;
typedef unsigned short bf16_t;
typedef short bf16x8 __attribute__((ext_vector_type(8)));
typedef short s16x4 __attribute__((ext_vector_type(4)));
typedef float f32x4 __attribute__((ext_vector_type(4)));
typedef float f32x2 __attribute__((ext_vector_type(2)));
typedef float f32x16 __attribute__((ext_vector_type(16)));
typedef unsigned u32x4 __attribute__((ext_vector_type(4)));
typedef unsigned u32x2 __attribute__((ext_vector_type(2)));
typedef GAS unsigned gu32;
#define RLX_AGENT __ATOMIC_RELAXED, __HIP_MEMORY_SCOPE_AGENT
#define LDS_WAIT() asm volatile("s_waitcnt lgkmcnt(0)" ::: "memory")
#define VM_WAIT() asm volatile("s_waitcnt vmcnt(0)" ::: "memory")
#define SBAR() __builtin_amdgcn_sched_barrier(0)

constexpr int D = 2048, SEQ = 8192, NMETA = 16, NTOK = SEQ + NMETA  , MP = 8448  , DEPTH = 2;
constexpr int MIXW = 512, P_IN = 13332, NIN_T = 13568  , ZP = 13312  ;
constexpr int NEXP = 32, DEXP = 1024, NROWS_MAX = 24576;
constexpr float LN_EPS = 1e-5f, ALPHA = 1.41421356237309515f, LOG2E = 1.4426950408889634f, LN2 = 0.6931471805599453f;
constexpr int ZC_FQ = 0, ZC_FK = 512, ZC_FV = 1024, ZC_GQ = 1536, ZC_GK = 1792, ZC_GV = 2048, ZC_GR = 2560, ZC_CB = 3072, ZC_CC = 3584, ZC_CV = 4096, ZC_PZ = 4608, ZC_GZ = 5120;
constexpr int NCHUNK = 129, GLA_FRONT = 48;
constexpr int ATT_SEG = 20, ATT_NQB = 33, ATT_MAXNS = 7;
__host__ __device__ constexpr int att_ns(int qb) { return (qb + 5) / 5; }
__host__ __device__ constexpr int att_sbase(int s) { return 4 * (33 * s - 5 * s * (s - 1) / 2); }
constexpr int ATT_NU = att_sbase(ATT_MAXNS);
static_assert(att_ns(32) == ATT_MAXNS && ATT_NU == 504, "attention unit table");
constexpr int SCAN_ITEMS = 64;

constexpr size_t al256(size_t x) { return (x + 255) & ~(size_t)255; }
constexpr size_t WS_CTL = 0, CTL_BYTES = 1u << 20;
constexpr size_t WS_HF = WS_CTL + CTL_BYTES;
constexpr size_t WS_HB = WS_HF + al256((size_t)MP * D * 4);
constexpr size_t WS_Z = WS_HB + al256((size_t)MP * D * 2);
constexpr size_t WS_ZS = WS_Z + al256((size_t)MP * ZP * 2);
constexpr size_t WS_C2 = WS_ZS + al256((size_t)MP * 32 * 4);
constexpr size_t WS_OM = WS_C2 + al256((size_t)4 * MP * 4);
constexpr size_t WS_OPART = WS_OM + al256((size_t)MP * D * 2);
constexpr size_t WS_ML = WS_OPART + al256((size_t)ATT_NU * 256 * 128 * 4);
constexpr size_t WS_UT = WS_ML + al256((size_t)ATT_NU * 256 * 2 * 4);
constexpr size_t WS_DEC = WS_UT + al256((size_t)NCHUNK * 4 * 128 * 64 * 4);
constexpr size_t WS_ST = WS_DEC + al256((size_t)NCHUNK * 4 * 64 * 4);
constexpr size_t WS_MXF = WS_ST + al256((size_t)NCHUNK * 4 * 128 * 64 * 2);
constexpr size_t WS_MX = WS_MXF + al256((size_t)MP * D * 4);
constexpr size_t WS_MO = WS_MX + al256((size_t)MP * D * 2);
constexpr size_t WS_EID = WS_MO + al256((size_t)MP * D * 4);
constexpr size_t WS_WTS = WS_EID + al256((size_t)MP * 2 * 4);
constexpr size_t WS_DST = WS_WTS + al256((size_t)MP * 2 * 4);
constexpr size_t WS_XR = WS_DST + al256((size_t)MP * 2 * 4);
constexpr size_t WS_HM = WS_XR + al256((size_t)NROWS_MAX * D * 2);
constexpr size_t WS_Y = WS_HM + al256((size_t)NROWS_MAX * DEXP * 2);
constexpr size_t WS_WIN = WS_Y + al256((size_t)NROWS_MAX * D * 2);
constexpr size_t WS_WBR = WS_WIN + al256((size_t)DEPTH * NIN_T * D * 2);
constexpr size_t WS_WOUT = WS_WBR + al256((size_t)DEPTH * D * D * 2);
constexpr size_t WS_PW = WS_WOUT + al256((size_t)DEPTH * D * D * 2);
constexpr size_t WS_HQ = WS_PW + al256((size_t)DEPTH * 4 * 128 * 128 * 2);
constexpr size_t WS_WQ = WS_HQ + al256((size_t)MP * D);
constexpr size_t WS_CNT = WS_WQ + al256((size_t)DEPTH * 4 * D * D);
constexpr size_t WS_END = WS_CNT + al256((size_t)DEPTH * 2 * (NTOK / 16) * NEXP * 4);
constexpr float WQ_SCALE = 32.f;
static_assert(WS_END <= 2147483648ull, "workspace map exceeds 4x the largest input tensor");

constexpr int CW_TMO = 0;
constexpr int CW_QATT = 64;
constexpr int CW_ECNT = 256;
constexpr int CW_NRM = 1024;
constexpr int CW_BAR = 4096;
constexpr int CW_RDY = 8192;
constexpr int CW_QG1 = 10240;
constexpr int CW_QMOE = 9216;

constexpr int LDS_BYTES = 147456, LDSCTL_OFF = LDS_BYTES - 1024, MISC_OFF = LDSCTL_OFF;
constexpr int NWAVES = 8;

__device__ __forceinline__ int opaque_tid() { int t = threadIdx.x; asm volatile("" : "+v"(t)); return t; }
__device__ __forceinline__ unsigned f2bf(float f) { unsigned u = __builtin_bit_cast(unsigned, f); return (u + 0x7fffu + ((u >> 16) & 1u)) >> 16; }
__device__ __forceinline__ unsigned pk2(float lo, float hi) { return f2bf(lo) | (f2bf(hi) << 16); }
__device__ __forceinline__ unsigned pk4_fp8(float a, float b, float c, float d) {
    a = fminf(fmaxf(a, -448.f), 448.f); b = fminf(fmaxf(b, -448.f), 448.f); c = fminf(fmaxf(c, -448.f), 448.f); d = fminf(fmaxf(d, -448.f), 448.f);
    int w = 0; w = __builtin_amdgcn_cvt_pk_fp8_f32(a, b, w, false); w = __builtin_amdgcn_cvt_pk_fp8_f32(c, d, w, true); return (unsigned)w; }
__device__ __forceinline__ float bf2f(unsigned short b) { return __builtin_bit_cast(float, ((unsigned)b) << 16); }
__device__ __forceinline__ float bflo(unsigned w) { return __builtin_bit_cast(float, w << 16); }
__device__ __forceinline__ float bfhi(unsigned w) { return __builtin_bit_cast(float, w & 0xffff0000u); }
__device__ __forceinline__ unsigned cvt_pk_bf16(float lo, float hi) { unsigned r; asm volatile("v_cvt_pk_bf16_f32 %0, %1, %2" : "=v"(r) : "v"(lo), "v"(hi)); return r; }
__device__ __forceinline__ float wave_sum(float v) {
#pragma unroll
    for (int o = 1; o < 64; o <<= 1) v += __shfl_xor(v, o);
    return v;
}
__device__ __forceinline__ float sigmoidf_fast(float x) { return __builtin_amdgcn_rcpf(1.0f + __builtin_amdgcn_exp2f(-x * LOG2E)); }
__device__ __forceinline__ float log_sigmoidf(float x) { return fminf(x, 0.f) - LN2 * __builtin_amdgcn_logf(1.f + __builtin_amdgcn_exp2f(-LOG2E * fabsf(x))); }

namespace pg8 {
constexpr int BM = 256, BK = 64, HALF = 128, HTB = HALF * BK * 2, STAGE_BYTES = 8 * HTB, NXCD = 8, WGM = 8;
__host__ __device__ __forceinline__ int lds_byte(int r, int c) { const int st = (r >> 4) * 2 + (c >> 5), rr = r & 15, cc = c & 31, ob = rr * 64 + cc * 2; return st * 1024 + (ob ^ (((ob >> 9) & 1) << 5)); }
__host__ __device__ __forceinline__ void stage_rc(int b, int& R, int& C) { const int st = b / 1024, sb = b % 1024, swz = sb ^ (((sb >> 9) & 1) << 5); R = (st >> 1) * 16 + swz / 64; C = (st & 1) * 32 + (swz % 64) / 2; }
__host__ __device__ __forceinline__ int perm32(int rho) { const int n = rho >> 4, i = rho & 15; return 8 * (i >> 2) + 4 * n + (i & 3); }

struct Unit { const char* A; const char* B; int pm, pn, aux, aux2; };
struct Gemm { int lda, ldb, K; };

__device__ __forceinline__ void tile_of(int L, int nM, int nN, int& pm, int& pn) {
    const int nwg = nM * nN; int wgid = L; { const int q = nwg / NXCD, r = nwg % NXCD, xcd = wgid % NXCD, off = wgid / NXCD; wgid = (xcd < r ? xcd * (q + 1) : r * (q + 1) + (xcd - r) * q) + off; }
    const int nig = WGM * nN, gid = wgid / nig, fm = gid * WGM, gsz = (nM - fm) < WGM ? (nM - fm) : WGM;
    pm = fm + ((wgid % nig) % gsz); pn = (wgid % nig) / gsz;
}

__device__ __forceinline__ void ho_arrive(unsigned* cnt);
typedef int i32x8 __attribute__((ext_vector_type(8))); typedef int i32x4v __attribute__((ext_vector_type(4)));
__device__ __forceinline__ i32x8 cat8(bf16x8 a, bf16x8 b) { const i32x4v x = __builtin_bit_cast(i32x4v, a), y = __builtin_bit_cast(i32x4v, b); return __builtin_shufflevector(x, y, 0, 1, 2, 3, 4, 5, 6, 7); }
template <bool F8> struct FragSel { typedef bf16x8 T; };
template <> struct FragSel<true> { typedef i32x8 T; };
template <class T> __device__ __forceinline__ T frag_one(bf16x8 a);
template <> __device__ __forceinline__ bf16x8 frag_one<bf16x8>(bf16x8 a) { return a; }
template <> __device__ __forceinline__ i32x8 frag_one<i32x8>(bf16x8 a) { return cat8(a, a); }
template <class T> __device__ __forceinline__ T frag_cat(bf16x8 a, bf16x8 b);
template <> __device__ __forceinline__ bf16x8 frag_cat<bf16x8>(bf16x8 a, bf16x8) { return a; }
template <> __device__ __forceinline__ i32x8 frag_cat<i32x8>(bf16x8 a, bf16x8 b) { return cat8(a, b); }
__device__ __forceinline__ f32x4 frag_mma(bf16x8 b, bf16x8 a, f32x4 c) { return __builtin_amdgcn_mfma_f32_16x16x32_bf16(b, a, c, 0, 0, 0); }
__device__ __forceinline__ f32x4 frag_mma(i32x8 b, i32x8 a, f32x4 c) {
    asm volatile("v_mfma_f32_16x16x128_f8f6f4 %0, %1, %2, %0" : "+v"(c) : "v"(b), "v"(a)); return c; }
template <class Epi, class Sched, bool ALIGN_EPI = true, bool F8 = false>
__device__ __forceinline__ void gemm_phase(LAS unsigned char* lds, const Gemm g, const Sched& S, const Epi& E) {
    const int tid = opaque_tid(), wid = __builtin_amdgcn_readfirstlane(tid >> 6), lane = tid & 63, wr = wid >> 2, wc = wid & 3, fr = lane & 15, fq = lane >> 4;
    using FragT = typename FragSel<F8>::T; constexpr int NKF = F8 ? 1 : 2;
    const int K = g.K, nt = K / BK;
    unsigned voffA[2], voffB[2];
#pragma unroll
    for (int i = 0; i < 2; ++i) { int R, C; stage_rc(tid * 16 + i * 8192, R, C); const int Rb = Epi::PERM ? ((R & ~31) + perm32(R & 31)) : R;
        voffA[i] = (unsigned)(R * g.lda + C) * 2u; voffB[i] = (unsigned)(Rb * g.ldb + C) * 2u; }
    const size_t kstep = (size_t)(BK * 2);
    const size_t hstepA = (size_t)HALF * g.lda * 2, hstepB = (size_t)HALF * g.ldb * 2;
    const unsigned ldsw = (unsigned)wid * 1024u;
    const int aoff = F8 ? lds_byte(wr * 64 + fr, (fq >> 1) * 32 + (fq & 1) * 16) : lds_byte(wr * 64 + fr, fq * 8), boff = F8 ? lds_byte(wc * 32 + fr, (fq >> 1) * 32 + (fq & 1) * 16) : lds_byte(wc * 32 + fr, fq * 8);
#define PG8_SA(b, h) (((b) * 2 + (h)) * HTB)
#define PG8_SB(b, h) ((4 + (b) * 2 + (h)) * HTB)
#define PG8_STAGE(bufoff, gbase, voff) do { _Pragma("unroll") for (int _i = 0; _i < 2; ++_i) \
        __builtin_amdgcn_global_load_lds((const unsigned*)((const char*)(gbase) + (voff)[_i]), (LAS unsigned*)(lds + (bufoff) + ldsw + _i * 8192), 16, 0, 0); } while (0)
#define PG8_LD1(dst, base) do { _Pragma("unroll") for (int k = 0; k < NKF; ++k) dst[k] = *(const LAS FragT*)(lds + (base) + k * 1024); } while (0)
#define PG8_LDA(dst, b, h) do { _Pragma("unroll") for (int m = 0; m < 4; ++m) PG8_LD1(dst[m], PG8_SA(b, h) + aoff + m * 2048); } while (0)
#define PG8_LDB(dst, b, h) do { _Pragma("unroll") for (int n = 0; n < 2; ++n) PG8_LD1(dst[n], PG8_SB(b, h) + boff + n * 2048); } while (0)
#define PG8_MMA(ai, bj, At, Bt) do { __builtin_amdgcn_s_setprio(1); _Pragma("unroll") for (int m = 0; m < 4; ++m) _Pragma("unroll") for (int n = 0; n < 2; ++n) { \
        _Pragma("unroll") for (int k = 0; k < NKF; ++k) acc[ai][bj][m][n] = frag_mma(Bt[n][k], At[m][k], acc[ai][bj][m][n]); } \
        __builtin_amdgcn_s_setprio(0); } while (0)
#define PG8_WAIT_V(n) asm volatile("s_waitcnt vmcnt(" #n ")" ::: "memory")
#define PG8_WAIT_L(n) asm volatile("s_waitcnt lgkmcnt(" #n ")" ::: "memory")
#define PG8_BAR __builtin_amdgcn_s_barrier()
#define PG8_SCHED __builtin_amdgcn_sched_barrier(0)
    Unit cur, nxt; int ui = 0;
    if (!S.next(0, cur)) return;
    f32x4 acc[2][2][4][2];
#pragma unroll
    for (int a = 0; a < 2; ++a)
#pragma unroll
        for (int b = 0; b < 2; ++b)
#pragma unroll
            for (int m = 0; m < 4; ++m)
#pragma unroll
                for (int n = 0; n < 2; ++n) acc[a][b][m][n] = (f32x4){0.f, 0.f, 0.f, 0.f};
    FragT At[4][NKF], B0[2][NKF], B1[2][NKF];
    const char* cA = cur.A; const char* cB = cur.B;
    PG8_STAGE(PG8_SB(0, 0), cB, voffB); PG8_STAGE(PG8_SB(0, 1), cB + hstepB, voffB); PG8_STAGE(PG8_SA(0, 0), cA, voffA); PG8_STAGE(PG8_SA(0, 1), cA + hstepA, voffA);
    if (wr == 1) PG8_BAR;
    PG8_WAIT_V(2); PG8_BAR;
    PG8_STAGE(PG8_SB(1, 0), cB + kstep, voffB); PG8_STAGE(PG8_SA(1, 0), cA + kstep, voffA); PG8_STAGE(PG8_SB(1, 1), cB + hstepB + kstep, voffB);
    PG8_WAIT_V(6); PG8_BAR;
    for (;;) {
        const bool has_next = S.next(ui + 1, nxt);
        const char* nA = has_next ? nxt.A : cA; const char* nB = has_next ? nxt.B : cB;
        for (int t = 0; t < nt; t += 2) {
            if constexpr (Epi::SEG) { if (t != 0 && (t & 7) == 0) { PG8_SCHED; E.seg(acc, cur, t >> 3, wr, wc, fr, fq); PG8_SCHED; } }
            const bool last = (t == nt - 2);
            const char* a1 = cA + (size_t)(t + 1) * kstep;
            const char* a2 = last ? nA : cA + (size_t)(t + 2) * kstep; const char* b2 = last ? nB : cB + (size_t)(t + 2) * kstep;
            const char* a3 = a2 + kstep; const char* b3 = b2 + kstep;
            PG8_LDB(B0, 0, 0); PG8_LDB(B1, 0, 1); PG8_SCHED; PG8_LDA(At, 0, 0); PG8_STAGE(PG8_SA(1, 1), a1 + hstepA, voffA);
            PG8_WAIT_V(8); PG8_WAIT_L(0); PG8_BAR; PG8_MMA(0, 0, At, B0); PG8_MMA(0, 1, At, B1); PG8_BAR; PG8_SCHED;
            PG8_LDA(At, 0, 1); PG8_STAGE(PG8_SB(0, 0), b2, voffB); PG8_STAGE(PG8_SB(0, 1), b2 + hstepB, voffB); PG8_STAGE(PG8_SA(0, 0), a2, voffA);
            PG8_WAIT_V(8); PG8_WAIT_L(0); PG8_BAR; PG8_MMA(1, 0, At, B0); PG8_MMA(1, 1, At, B1); PG8_BAR; PG8_SCHED;
            PG8_LDB(B0, 1, 0); PG8_LDB(B1, 1, 1); PG8_SCHED; PG8_LDA(At, 1, 0); PG8_STAGE(PG8_SA(0, 1), a2 + hstepA, voffA);
            PG8_WAIT_V(8); PG8_WAIT_L(0); PG8_BAR; PG8_MMA(0, 0, At, B0); PG8_MMA(0, 1, At, B1); PG8_BAR; PG8_SCHED;
            PG8_LDA(At, 1, 1); PG8_STAGE(PG8_SB(1, 0), b3, voffB); PG8_STAGE(PG8_SB(1, 1), b3 + hstepB, voffB); PG8_STAGE(PG8_SA(1, 0), a3, voffA);
            PG8_WAIT_V(8); PG8_WAIT_L(0); PG8_BAR; PG8_MMA(1, 0, At, B0); PG8_MMA(1, 1, At, B1); PG8_BAR; PG8_SCHED;
        }
        if constexpr (ALIGN_EPI) { if (wr == 0) PG8_BAR; }
        if constexpr (F8) asm volatile("s_nop 15\n\ts_nop 15" ::: "memory");
        E(acc, cur, wr, wc, fr, fq);
        if (!has_next) break;
#pragma unroll
        for (int a = 0; a < 2; ++a)
#pragma unroll
            for (int b = 0; b < 2; ++b)
#pragma unroll
                for (int m = 0; m < 4; ++m)
#pragma unroll
                    for (int n = 0; n < 2; ++n) acc[a][b][m][n] = (f32x4){0.f, 0.f, 0.f, 0.f};
        cur = nxt; cA = nA; cB = nB; ++ui;
        if constexpr (ALIGN_EPI) { if (wr == 1) PG8_BAR; }
    }
    PG8_WAIT_V(0);
    if constexpr (!ALIGN_EPI) { if (wr == 0) PG8_BAR; }
    PG8_BAR;
#undef PG8_SA
#undef PG8_SB
#undef PG8_STAGE
#undef PG8_LDA
#undef PG8_LD1
#undef PG8_LDB
#undef PG8_MMA
#undef PG8_WAIT_V
#undef PG8_WAIT_L
#undef PG8_BAR
#undef PG8_SCHED
}

struct UnitF { const char* A; const char* B; const char* B2; int pm, pn, aux, aux2; };
template <class Epi, class Sched>
__device__ __forceinline__ void gemm_phase_breg(LAS unsigned char* lds, const Gemm g, const Sched& S, const Epi& E) {
    static_assert(Epi::PERM, "gemm_phase_breg stages B rows in perm32 order");
    const int tid = opaque_tid(), wid = __builtin_amdgcn_readfirstlane(tid >> 6), lane = tid & 63, wr = wid >> 2, wc = wid & 3, fr = lane & 15, fq = lane >> 4;
    const int K = g.K, nt = K / BK;
    unsigned voffA[2];
#pragma unroll
    for (int i = 0; i < 2; ++i) { int R, C; stage_rc(tid * 16 + i * 8192, R, C); voffA[i] = (unsigned)(R * g.lda + C) * 2u; }
    const size_t kstep = (size_t)(BK * 2);
    const size_t hstepA = (size_t)HALF * g.lda * 2;
    const unsigned ldsw = (unsigned)wid * 1024u;
    const int aoff = lds_byte(wr * 64 + fr, fq * 8), boff = lds_byte(wc * 32 + fr, fq * 8);
    const int bh = wid & 1, kg = (wid >> 1) * 2 + (lane >> 5), nn = 4 * (lane & 31);
    const int rho0 = (nn & ~31) + (((nn & 31) >> 2) & 1) * 16 + (((nn & 31) >> 3) << 2);
    const unsigned bdst = (unsigned)(4 * HTB + bh * HTB + lds_byte(rho0, 8 * kg));
    const unsigned browB = (unsigned)g.ldb * 4u;
    const unsigned bthr = (unsigned)(8 * kg) * browB + (unsigned)nn * 4u;
#define PG8_SA(b, h) (((b) * 2 + (h)) * HTB)
#define PG8_SB(b, h) ((4 + (b) * 2 + (h)) * HTB)
#define PG8_STAGE(bufoff, gbase, voff) do { _Pragma("unroll") for (int _i = 0; _i < 2; ++_i) \
        __builtin_amdgcn_global_load_lds((const unsigned*)((const char*)(gbase) + (voff)[_i]), (LAS unsigned*)(lds + (bufoff) + ldsw + _i * 8192), 16, 0, 0); } while (0)
#define PG8_LDA(dst, b, h) do { _Pragma("unroll") for (int m = 0; m < 4; ++m) _Pragma("unroll") for (int k = 0; k < 2; ++k) dst[m][k] = *(const LAS bf16x8*)(lds + PG8_SA(b, h) + aoff + m * 2048 + k * 1024); } while (0)
#define PG8_LDB(dst, b, h) do { _Pragma("unroll") for (int n = 0; n < 2; ++n) _Pragma("unroll") for (int k = 0; k < 2; ++k) dst[n][k] = *(const LAS bf16x8*)(lds + PG8_SB(b, h) + boff + n * 2048 + k * 1024); } while (0)
#define PG8_MMA(ai, bj, At, Bt) do { __builtin_amdgcn_s_setprio(1); _Pragma("unroll") for (int m = 0; m < 4; ++m) _Pragma("unroll") for (int n = 0; n < 2; ++n) _Pragma("unroll") for (int k = 0; k < 2; ++k) \
        acc[ai][bj][m][n] = __builtin_amdgcn_mfma_f32_16x16x32_bf16(Bt[n][k], At[m][k], acc[ai][bj][m][n], 0, 0, 0); __builtin_amdgcn_s_setprio(0); } while (0)
#define PG8_WAIT_V(n) asm volatile("s_waitcnt vmcnt(" #n ")" ::: "memory")
#define PG8_WAIT_L(n) asm volatile("s_waitcnt lgkmcnt(" #n ")" ::: "memory")
#define PG8_BAR __builtin_amdgcn_s_barrier()
#define PG8_SCHED __builtin_amdgcn_sched_barrier(0)
#define PG8_LOADB(tau) do { const int t_ = (tau); const char* p_ = (t_ < nt ? cBt : nBt); const unsigned o_ = bthr + (unsigned)(t_ < nt ? t_ : t_ - nt) * (64u * browB); \
        asm volatile("s_nop 4\n\tglobal_load_dwordx4 %0, %1, %2" : "=v"(breg[0]) : "v"(o_), "s"(p_) : "memory");     \
        _Pragma("unroll") for (int j_ = 1; j_ < 8; ++j_) asm volatile("global_load_dwordx4 %0, %1, %2" : "=v"(breg[j_]) : "v"(o_ + (unsigned)j_ * browB), "s"(p_) : "memory"); } while (0)
#define PG8_WAITB(n) asm volatile("s_waitcnt vmcnt(" #n ")" : "+v"(breg[0]), "+v"(breg[1]), "+v"(breg[2]), "+v"(breg[3]), "+v"(breg[4]), "+v"(breg[5]), "+v"(breg[6]), "+v"(breg[7]) :: "memory")
#define PG8_WRITEB(buf) do { _Pragma("unroll") for (int i_ = 0; i_ < 4; ++i_) { u32x4 w_; \
            w_.x = cvt_pk_bf16(breg[0][i_], breg[1][i_]); w_.y = cvt_pk_bf16(breg[2][i_], breg[3][i_]); w_.z = cvt_pk_bf16(breg[4][i_], breg[5][i_]); w_.w = cvt_pk_bf16(breg[6][i_], breg[7][i_]); \
            *(LAS u32x4*)(lds + bdst + (buf) * (2 * HTB) + 64 * i_) = w_; } } while (0)
    UnitF cur, nxt; int ui = 0;
    if (!S.next(0, cur)) return;
    f32x4 acc[2][2][4][2];
#pragma unroll
    for (int a = 0; a < 2; ++a)
#pragma unroll
        for (int b = 0; b < 2; ++b)
#pragma unroll
            for (int m = 0; m < 4; ++m)
#pragma unroll
                for (int n = 0; n < 2; ++n) acc[a][b][m][n] = (f32x4){0.f, 0.f, 0.f, 0.f};
    bf16x8 At[4][2], B0[2][2], B1[2][2]; f32x4 breg[8];
    const char* cA = cur.A; const char* cBt = bh ? cur.B2 : cur.B; const char* nBt = cBt;
    PG8_LOADB(0); PG8_STAGE(PG8_SA(0, 0), cA, voffA); PG8_STAGE(PG8_SA(0, 1), cA + hstepA, voffA);
    PG8_WAITB(4); PG8_WRITEB(0);
    PG8_LOADB(1);
    PG8_WAITB(0); PG8_WRITEB(1);
    PG8_LOADB(2); PG8_STAGE(PG8_SA(1, 0), cA + kstep, voffA);
    PG8_WAIT_V(10); PG8_WAIT_L(0);
    if (wr == 1) PG8_BAR;
    PG8_BAR;
    for (;;) {
        const bool has_next = S.next(ui + 1, nxt);
        const char* nA = has_next ? nxt.A : cA; nBt = has_next ? (bh ? nxt.B2 : nxt.B) : cBt;
        for (int t = 0; t < nt; t += 2) {
            const bool last = (t == nt - 2);
            const char* a1 = cA + (size_t)(t + 1) * kstep;
            const char* a2 = last ? nA : cA + (size_t)(t + 2) * kstep;
            const char* a3 = a2 + kstep;
            PG8_LDB(B0, 0, 0); PG8_LDB(B1, 0, 1); PG8_SCHED; PG8_LDA(At, 0, 0); PG8_STAGE(PG8_SA(1, 1), a1 + hstepA, voffA);
            PG8_WAIT_V(12); PG8_WAIT_L(0); PG8_BAR; PG8_MMA(0, 0, At, B0); PG8_MMA(0, 1, At, B1); PG8_BAR; PG8_SCHED;
            PG8_LDA(At, 0, 1); PG8_SCHED; PG8_WAITB(4); PG8_WRITEB(0); PG8_SCHED; PG8_LOADB(t + 3); PG8_STAGE(PG8_SA(0, 0), a2, voffA);
            PG8_WAIT_V(12); PG8_WAIT_L(0); PG8_BAR; PG8_MMA(1, 0, At, B0); PG8_MMA(1, 1, At, B1); PG8_BAR; PG8_SCHED;
            PG8_LDB(B0, 1, 0); PG8_LDB(B1, 1, 1); PG8_SCHED; PG8_LDA(At, 1, 0); PG8_STAGE(PG8_SA(0, 1), a2 + hstepA, voffA);
            PG8_WAIT_V(12); PG8_WAIT_L(0); PG8_BAR; PG8_MMA(0, 0, At, B0); PG8_MMA(0, 1, At, B1); PG8_BAR; PG8_SCHED;
            PG8_LDA(At, 1, 1); PG8_SCHED; PG8_WAITB(4); PG8_WRITEB(1); PG8_SCHED; PG8_LOADB(t + 4); PG8_STAGE(PG8_SA(1, 0), a3, voffA);
            PG8_WAIT_V(12); PG8_WAIT_L(0); PG8_BAR; PG8_MMA(1, 0, At, B0); PG8_MMA(1, 1, At, B1); PG8_BAR; PG8_SCHED;
        }
        if (wr == 0) PG8_BAR;
        E(acc, cur, wr, wc, fr, fq);
        if constexpr (Epi::ARRIVE) ho_arrive(E.ready + cur.pm);
        if (!has_next) break;
#pragma unroll
        for (int a = 0; a < 2; ++a)
#pragma unroll
            for (int b = 0; b < 2; ++b)
#pragma unroll
                for (int m = 0; m < 4; ++m)
#pragma unroll
                    for (int n = 0; n < 2; ++n) acc[a][b][m][n] = (f32x4){0.f, 0.f, 0.f, 0.f};
        cur = nxt; cA = nA; cBt = nBt; ++ui;
        if (wr == 1) PG8_BAR;
    }
    PG8_WAITB(0);
    PG8_BAR;
#undef PG8_SA
#undef PG8_SB
#undef PG8_STAGE
#undef PG8_LDA
#undef PG8_LDB
#undef PG8_MMA
#undef PG8_WAIT_V
#undef PG8_WAIT_L
#undef PG8_BAR
#undef PG8_SCHED
#undef PG8_LOADB
#undef PG8_WAITB
#undef PG8_WRITEB
}
}

namespace pg8 {
struct EpiZ {
    static constexpr bool SEG = false; static constexpr bool PERM = true;
    bf16_t* Z; float* Zs; float sc;
    __device__ __forceinline__ void operator()(const f32x4 (&acc)[2][2][4][2], const Unit& u, int wr, int wc, int fr, int fq) const {
        const int row0 = u.pm * BM + wr * 64 + fr;
        if (u.pn == 52) {
            if (wc == 0 && fq < 3) {
#pragma unroll
                for (int ai = 0; ai < 2; ++ai)
#pragma unroll
                    for (int m = 0; m < 4; ++m) { float* rowp = Zs + (size_t)(row0 + ai * HALF + m * 16) * 32 + 8 * fq;
                        *(GAS f32x4*)(rowp) = acc[ai][0][m][0]; if (fq < 2) *(GAS f32x4*)(rowp + 4) = acc[ai][0][m][1]; }
            }
            return;
        }
        const int col0 = u.pn * BM + wc * 32 + 8 * fq;
#pragma unroll
        for (int ai = 0; ai < 2; ++ai)
#pragma unroll
            for (int m = 0; m < 4; ++m) { bf16_t* rowp = Z + (size_t)(row0 + ai * HALF + m * 16) * ZP + col0;
#pragma unroll
                for (int bj = 0; bj < 2; ++bj) { const f32x4 v0 = acc[ai][bj][m][0], v1 = acc[ai][bj][m][1];
                    u32x4 w; w.x = cvt_pk_bf16(v0[0], v0[1]); w.y = cvt_pk_bf16(v0[2], v0[3]); w.z = cvt_pk_bf16(v1[0], v1[1]); w.w = cvt_pk_bf16(v1[2], v1[3]);
                    *(GAS u32x4*)(rowp + bj * HALF) = w; } }
    }
};
struct EpiZG {
    static constexpr bool SEG = false; static constexpr bool PERM = true;
    bf16_t* Z; const float* gb; float sc;
    __device__ __forceinline__ void operator()(const f32x4 (&acc)[2][2][4][2], const Unit& u, int wr, int wc, int fr, int fq) const {
        const int row0 = u.pm * BM + wr * 64 + fr, col0 = u.pn * BM + wc * 32 + 8 * fq; const float* gq = gb + (col0 - ZC_GZ);
        const float k = -sc * LOG2E, TL = 60.f * LOG2E;
        const f32x4 b00 = *(const GAS f32x4*)(gq) * (-LOG2E), b01 = *(const GAS f32x4*)(gq + 4) * (-LOG2E), b10 = *(const GAS f32x4*)(gq + HALF) * (-LOG2E), b11 = *(const GAS f32x4*)(gq + HALF + 4) * (-LOG2E);
#define ZG_E(t) (1.f + __builtin_amdgcn_exp2f(fminf(fmaxf((t), -TL), TL)))
#pragma unroll
        for (int ai = 0; ai < 2; ++ai)
#pragma unroll
            for (int m = 0; m < 4; ++m) { bf16_t* rowp = Z + (size_t)(row0 + ai * HALF + m * 16) * ZP + col0;
#pragma unroll
                for (int bj = 0; bj < 2; ++bj) { const f32x4 t0 = acc[ai][bj][m][0] * k + (bj ? b10 : b00), t1 = acc[ai][bj][m][1] * k + (bj ? b11 : b01);
                    u32x4 w; w.x = cvt_pk_bf16(ZG_E(t0[0]), ZG_E(t0[1])); w.y = cvt_pk_bf16(ZG_E(t0[2]), ZG_E(t0[3]));
                    w.z = cvt_pk_bf16(ZG_E(t1[0]), ZG_E(t1[1])); w.w = cvt_pk_bf16(ZG_E(t1[2]), ZG_E(t1[3]));
                    *(GAS u32x4*)(rowp + bj * HALF) = w; } }
#undef ZG_E
    }
};
struct EpiMerge {
    static constexpr bool SEG = false; static constexpr bool PERM = true;
    const bf16_t* Z; const float* gate_b; float* MXF; bf16_t* MX; int r0;
    __device__ __forceinline__ void operator()(const f32x4 (&acc)[2][2][4][2], const Unit& u, int wr, int wc, int fr, int fq) const {
        const int row0 = r0 + u.pm * BM + wr * 64 + fr, col0 = u.pn * BM + wc * 32 + 8 * fq, b = u.aux;
        const float* gb = gate_b + b * D + col0;
        f32x4 g0[2], g1[2];
#pragma unroll
        for (int bj = 0; bj < 2; ++bj) { g0[bj] = *(const GAS f32x4*)(gb + bj * HALF); g1[bj] = *(const GAS f32x4*)(gb + bj * HALF + 4); }
        u32x4 zw[2][2]; f32x4 old[2][2][2];
#define EM_LOAD(slot, grp) do { const size_t row_ = (size_t)(row0 + ((grp) >> 2) * HALF + ((grp) & 3) * 16); const bf16_t* zp_ = Z + row_ * ZP + ZC_GZ + b * D + col0; const float* fp_ = MXF + row_ * D + col0; \
        _Pragma("unroll") for (int bj = 0; bj < 2; ++bj) { zw[slot][bj] = *(const GAS u32x4*)(zp_ + bj * HALF); \
            if (b != 0) { old[slot][bj][0] = *(const GAS f32x4*)(fp_ + bj * HALF); old[slot][bj][1] = *(const GAS f32x4*)(fp_ + bj * HALF + 4); } } } while (0)
#define EM_DO(slot, grp) do { const int ai = (grp) >> 2, m = (grp) & 3; const size_t row_ = (size_t)(row0 + ai * HALF + m * 16); float* fp_ = MXF + row_ * D + col0; bf16_t* op_ = MX + row_ * D + col0; \
        _Pragma("unroll") for (int bj = 0; bj < 2; ++bj) { const u32x4 z_ = zw[slot][bj]; f32x4 v0, v1; \
            v0[0] = sigmoidf_fast(bflo(z_.x) + g0[bj][0]) * acc[ai][bj][m][0][0]; v0[1] = sigmoidf_fast(bfhi(z_.x) + g0[bj][1]) * acc[ai][bj][m][0][1]; \
            v0[2] = sigmoidf_fast(bflo(z_.y) + g0[bj][2]) * acc[ai][bj][m][0][2]; v0[3] = sigmoidf_fast(bfhi(z_.y) + g0[bj][3]) * acc[ai][bj][m][0][3]; \
            v1[0] = sigmoidf_fast(bflo(z_.z) + g1[bj][0]) * acc[ai][bj][m][1][0]; v1[1] = sigmoidf_fast(bfhi(z_.z) + g1[bj][1]) * acc[ai][bj][m][1][1]; \
            v1[2] = sigmoidf_fast(bflo(z_.w) + g1[bj][2]) * acc[ai][bj][m][1][2]; v1[3] = sigmoidf_fast(bfhi(z_.w) + g1[bj][3]) * acc[ai][bj][m][1][3]; \
            if (b != 0) { v0 += old[slot][bj][0]; v1 += old[slot][bj][1]; } \
            if (b != 3) { *(GAS f32x4*)(fp_ + bj * HALF) = v0; *(GAS f32x4*)(fp_ + bj * HALF + 4) = v1; } \
            else { u32x4 w_; w_.x = cvt_pk_bf16(v0[0], v0[1]); w_.y = cvt_pk_bf16(v0[2], v0[3]); w_.z = cvt_pk_bf16(v1[0], v1[1]); w_.w = cvt_pk_bf16(v1[2], v1[3]); *(GAS u32x4*)(op_ + bj * HALF) = w_; } } } while (0)
        EM_LOAD(0, 0);
        EM_LOAD(1, 1); EM_DO(0, 0);
        EM_LOAD(0, 2); EM_DO(1, 1);
        EM_LOAD(1, 3); EM_DO(0, 2);
        EM_LOAD(0, 4); EM_DO(1, 3);
        EM_LOAD(1, 5); EM_DO(0, 4);
        EM_LOAD(0, 6); EM_DO(1, 5);
        EM_LOAD(1, 7); EM_DO(0, 6);
        EM_DO(1, 7);
#undef EM_LOAD
#undef EM_DO
    }
};
struct EpiMergeSeg {
    static constexpr bool SEG = true; static constexpr bool PERM = true;
    const bf16_t* Z; const float* gate_b; bf16_t* MX; int r0;
    __device__ __forceinline__ void seg(f32x4 (&acc)[2][2][4][2], const Unit& u, int j, int wr, int wc, int fr, int fq) const {
        const int row0 = r0 + u.pm * BM + wr * 64 + fr, col0 = u.pn * BM + wc * 32 + 8 * fq;
        u32x4 zaA[4], zbA[4], zaB[4], zbB[4];
#define SG_R(zA, zB) ((zB) * __builtin_amdgcn_rcpf(zA))
#define SG_LZ(za, zb, bj, ai) do { const unsigned zoff = (unsigned)((row0 * ZP + ZC_GZ + (j - 1) * D + col0 + (bj) * HALF) * 2); _Pragma("unroll") for (int m = 0; m < 4; ++m) { const unsigned zo_ = zoff + (unsigned)(((ai) * HALF + m * 16) * ZP * 2); \
            za[m] = *(const GAS u32x4*)((const char*)Z + zo_); zb[m] = *(const GAS u32x4*)((const char*)Z + zo_ + D * 2); } } while (0)
#define SG_C(za, zb, bj, ai) do { _Pragma("unroll") for (int m = 0; m < 4; ++m) { const u32x4 a_ = za[m], b_ = zb[m]; \
            const f32x4 r0_ = {__builtin_amdgcn_rcpf(bflo(a_.x)), __builtin_amdgcn_rcpf(bfhi(a_.x)), __builtin_amdgcn_rcpf(bflo(a_.y)), __builtin_amdgcn_rcpf(bfhi(a_.y))}, \
                        r1_ = {__builtin_amdgcn_rcpf(bflo(a_.z)), __builtin_amdgcn_rcpf(bfhi(a_.z)), __builtin_amdgcn_rcpf(bflo(a_.w)), __builtin_amdgcn_rcpf(bfhi(a_.w))}, \
                        e0_ = {bflo(b_.x), bfhi(b_.x), bflo(b_.y), bfhi(b_.y)}, e1_ = {bflo(b_.z), bfhi(b_.z), bflo(b_.w), bfhi(b_.w)}; \
            acc[ai][bj][m][0] *= e0_ * r0_; acc[ai][bj][m][1] *= e1_ * r1_; } } while (0)
        SG_LZ(zaA, zbA, 0, 0); SG_LZ(zaB, zbB, 0, 1);
        __builtin_amdgcn_sched_barrier(0);
        SG_C(zaA, zbA, 0, 0);
        __builtin_amdgcn_sched_barrier(0);
        SG_LZ(zaA, zbA, 1, 0);
        __builtin_amdgcn_sched_barrier(0);
        SG_C(zaB, zbB, 0, 1);
        __builtin_amdgcn_sched_barrier(0);
        SG_LZ(zaB, zbB, 1, 1);
        __builtin_amdgcn_sched_barrier(0);
        SG_C(zaA, zbA, 1, 0);
        __builtin_amdgcn_sched_barrier(0);
        SG_C(zaB, zbB, 1, 1);
#undef SG_R
#undef SG_LZ
#undef SG_C
    }
    __device__ __forceinline__ void operator()(const f32x4 (&acc)[2][2][4][2], const Unit& u, int wr, int wc, int fr, int fq) const {
        const int row0 = r0 + u.pm * BM + wr * 64 + fr, col0 = u.pn * BM + wc * 32 + 8 * fq;
#define FG_G(z, k, n) __builtin_amdgcn_rcpf(z)
#pragma unroll
        for (int bj = 0; bj < 2; ++bj) { u32x4 zz[8]; const unsigned zoff = (unsigned)((row0 * ZP + ZC_GZ + 3 * D + col0 + bj * HALF) * 2);
#pragma unroll
            for (int grp = 0; grp < 8; ++grp) zz[grp] = *(const GAS u32x4*)((const char*)Z + zoff + (unsigned)(((grp >> 2) * HALF + (grp & 3) * 16) * ZP * 2));
#pragma unroll
            for (int grp = 0; grp < 8; ++grp) { const int ai = grp >> 2, m = grp & 3; bf16_t* op_ = MX + (size_t)(row0 + ai * HALF + m * 16) * D + col0; const u32x4 z_ = zz[grp]; u32x4 w_;
                w_.x = cvt_pk_bf16(acc[ai][bj][m][0][0] * FG_G(bflo(z_.x), 0, 0), acc[ai][bj][m][0][1] * FG_G(bfhi(z_.x), 1, 0));
                w_.y = cvt_pk_bf16(acc[ai][bj][m][0][2] * FG_G(bflo(z_.y), 2, 0), acc[ai][bj][m][0][3] * FG_G(bfhi(z_.y), 3, 0));
                w_.z = cvt_pk_bf16(acc[ai][bj][m][1][0] * FG_G(bflo(z_.z), 0, 1), acc[ai][bj][m][1][1] * FG_G(bfhi(z_.z), 1, 1));
                w_.w = cvt_pk_bf16(acc[ai][bj][m][1][2] * FG_G(bflo(z_.w), 2, 1), acc[ai][bj][m][1][3] * FG_G(bfhi(z_.w), 3, 1));
                *(GAS u32x4*)(op_ + bj * HALF) = w_; } }
#undef FG_G
#define FG_LOAD(a, b)
#undef FG_LOAD
    }
};
struct EpiF32 {
    static constexpr bool SEG = false; static constexpr bool PERM = false;
    float* C; int ldc; int r0;
    __device__ __forceinline__ void operator()(const f32x4 (&acc)[2][2][4][2], const Unit& u, int wr, int wc, int fr, int fq) const {
        const int row0 = r0 + u.pm * BM + wr * 64 + fr, col0 = u.pn * BM + wc * 32 + 4 * fq;
#pragma unroll
        for (int ai = 0; ai < 2; ++ai)
#pragma unroll
            for (int m = 0; m < 4; ++m) { float* rowp = C + (size_t)(row0 + ai * HALF + m * 16) * ldc + col0;
#pragma unroll
                for (int bj = 0; bj < 2; ++bj)
#pragma unroll
                    for (int n = 0; n < 2; ++n) *(GAS f32x4*)(rowp + bj * HALF + n * 16) = acc[ai][bj][m][n]; }
    }
};
struct EpiSwiGLU {
    static constexpr bool SEG = false; static constexpr bool PERM = true; static constexpr bool ARRIVE = true;
    bf16_t* HM; unsigned* ready;
    template <class U> __device__ __forceinline__ void operator()(const f32x4 (&acc)[2][2][4][2], const U& u, int wr, int wc, int fr, int fq) const {
        const int row0 = u.pm * BM + wr * 64 + fr, col0 = u.pn * HALF + wc * 32 + 8 * fq;
#pragma unroll
        for (int ai = 0; ai < 2; ++ai)
#pragma unroll
            for (int m = 0; m < 4; ++m) { bf16_t* rowp = HM + (size_t)(row0 + ai * HALF + m * 16) * DEXP + col0;
                float h[8];
#pragma unroll
                for (int n = 0; n < 2; ++n)
#pragma unroll
                    for (int j = 0; j < 4; ++j) { const float g = acc[ai][0][m][n][j], up = acc[ai][1][m][n][j]; h[n * 4 + j] = g * sigmoidf_fast(g) * up; }
                u32x4 w; w.x = cvt_pk_bf16(h[0], h[1]); w.y = cvt_pk_bf16(h[2], h[3]); w.z = cvt_pk_bf16(h[4], h[5]); w.w = cvt_pk_bf16(h[6], h[7]);
                *(GAS u32x4*)(rowp) = w; }
    }
};
struct EpiBf16 {
    static constexpr bool SEG = false; static constexpr bool PERM = true; static constexpr bool ARRIVE = false;
    bf16_t* O; int ldc; int r0;
    template <class U> __device__ __forceinline__ void operator()(const f32x4 (&acc)[2][2][4][2], const U& u, int wr, int wc, int fr, int fq) const {
        const int row0 = r0 + u.pm * BM + wr * 64 + fr, col0 = u.pn * BM + wc * 32 + 8 * fq;
#pragma unroll
        for (int ai = 0; ai < 2; ++ai)
#pragma unroll
            for (int m = 0; m < 4; ++m) { bf16_t* rowp = O + (size_t)(row0 + ai * HALF + m * 16) * ldc + col0;
#pragma unroll
                for (int bj = 0; bj < 2; ++bj) { const f32x4 v0 = acc[ai][bj][m][0], v1 = acc[ai][bj][m][1];
                    u32x4 w; w.x = cvt_pk_bf16(v0[0], v0[1]); w.y = cvt_pk_bf16(v0[2], v0[3]); w.z = cvt_pk_bf16(v1[0], v1[1]); w.w = cvt_pk_bf16(v1[2], v1[3]);
                    *(GAS u32x4*)(rowp + bj * HALF) = w; } }
    }
};

struct OrderDense {
    const char* A0; const char* B0; size_t tA, tB; int nM, nN, G, c;
    __device__ __forceinline__ bool next(int i, Unit& u) const {
        const long L = (long)i * G + c; if (L >= (long)nM * nN) return false;
        tile_of((int)L, nM, nN, u.pm, u.pn); u.A = A0 + (size_t)u.pm * tA; u.B = B0 + (size_t)u.pn * tB; u.aux = 0; u.aux2 = 0; return true;
    }
};
struct OrderDenseR {
    const char* A0; const char* B0; size_t tA, tB; int nM, nN, G, c, last_pn;
    __device__ __forceinline__ bool next(int i, Unit& u) const {
        const long L = (long)i * G + c; if (L >= (long)nM * nN) return false;
        tile_of((int)L, nM, nN, u.pm, u.pn); if (u.pn == nN - 1) u.pn = last_pn; u.A = A0 + (size_t)u.pm * tA; u.B = B0 + (size_t)u.pn * tB; u.aux = 0; u.aux2 = 0; return true;
    }
};
struct OrderMerge {
    const char* A0; const char* B0; size_t tA, tB; int nM, nN, G, c;
    __device__ __forceinline__ bool next(int i, Unit& u) const {
        const long L = (long)(i >> 2) * G + c; if (L >= (long)nM * nN) return false;
        const int b = i & 3; tile_of((int)L, nM, nN, u.pm, u.pn);
        u.A = A0 + (size_t)u.pm * tA + (size_t)b * MIXW * 2; u.B = B0 + (size_t)u.pn * tB + (size_t)b * MIXW * 2; u.aux = b; u.aux2 = 0; return true;
    }
};
struct OrderMoe {
    const char* A0; const char* B0; unsigned tA, tB, eB; const LAS int* tt; int ntiles, nN, G, c;
    __device__ __forceinline__ bool next(int i, Unit& u) const {
        const int L = i * G + c; if (L >= ntiles * 8) return false;
        const int j = L >> 3; u.pn = L & 7; u.pm = j; const int e = __builtin_amdgcn_readfirstlane(tt[j]);
        u.A = A0 + (size_t)((unsigned)j * tA); u.B = B0 + ((size_t)e * eB + (size_t)((unsigned)u.pn * tB)); u.aux = e; u.aux2 = 0; return true;
    }
};
struct OrderMoeF {
    const char* A0; const float* W0; const float* W1; unsigned tA; const LAS int* tt; int ntiles, G, c; bool up;
    __device__ __forceinline__ bool next(int i, UnitF& u) const {
        const int L = i * G + c; if (L >= ntiles * 8) return false;
        const int j = L >> 3; u.pn = L & 7; u.pm = j; const int e = __builtin_amdgcn_readfirstlane(tt[j]);
        u.A = A0 + (size_t)((unsigned)j * tA);
        const size_t eo = (size_t)e * D * DEXP;
        if (up) { u.B = (const char*)(W0 + eo + u.pn * 128); u.B2 = (const char*)(W1 + eo + u.pn * 128); } else { u.B = (const char*)(W0 + eo + u.pn * 256); u.B2 = u.B + 512; }
        u.aux = e; u.aux2 = 0; return true;
    }
};
}

namespace att {
constexpr int DH = 128, NW = 8, QBLK = 32, KVBLK = 64, QB = 256;
constexpr int SHM_V = KVBLK * DH * 2, SHM_K = KVBLK * DH * 2;
constexpr int OFF_WS = 2 * SHM_V + 2 * SHM_K, OFF_CK = OFF_WS + NW * 64 * 4, OFF_Q = OFF_CK + 2 * 64 * 4, LDS_ATT = OFF_Q + NW * 8 * 1024;
static_assert(LDS_ATT <= LDSCTL_OFF, "attention LDS");
constexpr float SCALE = 0.08838834764831845f, C2 = 1.4426950408889634f * SCALE, THR2 = 8.f * 1.4426950408889634f;
#define KSWZ(row, colB) ((row) * 256 + ((colB) ^ (((row) & 7) << 4)))
__device__ __forceinline__ int v_st(int k, int c) { const int kk = (k & ~0xC) | ((k & 4) << 1) | ((k & 8) >> 1); return ((kk >> 3) * 4 + (c >> 5)) * 512 + ((kk & 7) * 32 + (c & 31)) * 2; }
__device__ __forceinline__ int v_rd_base(int lane) { return ((lane & 3) << 3) | (((lane >> 2) & 3) << 6) | (((lane >> 4) & 1) << 5) | (((lane >> 5) & 1) << 8); }
constexpr int v_rd_off(int d0, int ks, int half) { return d0 * 512 + ks * 4096 + half * 2048; }
__device__ __forceinline__ int crow(int r, int hi) { return (r & 3) + 8 * (r >> 2) + 4 * hi; }
__device__ __forceinline__ bf16x8 load8(const bf16* p) { return *reinterpret_cast<const bf16x8*>(p); }
__device__ __forceinline__ void mask_tile(f32x16& p0, f32x16& p1, int dq) {
    const float NEG = -__builtin_inff();
#pragma unroll
    for (int r = 0; r < 16; ++r) {
        const int c = (r & 3) + 8 * (r >> 2);
        if (dq - c < 0) p0[r] = NEG;
        if (dq - c - 32 < 0) p1[r] = NEG;
    }
}
__device__ __forceinline__ void bias_tile(f32x16& p0, f32x16& p1, const float* ck, int hi) {
#pragma unroll
    for (int g = 0; g < 4; ++g) { const f32x4 c0 = *(const f32x4*)(ck + 8 * g + 4 * hi), c1 = *(const f32x4*)(ck + 32 + 8 * g + 4 * hi);
#pragma unroll
        for (int j = 0; j < 4; ++j) { p0[4 * g + j] = fmaf(p0[4 * g + j], C2, c0[j]); p1[4 * g + j] = fmaf(p1[4 * g + j], C2, c1[j]); } }
}
__device__ __forceinline__ void partialSM(f32x16& p0, f32x16& p1, float& m_reg, float& mn, float& alpha) {
    float pmax = p0[0]; for (int r = 1; r < 16; ++r) pmax = fmaxf(pmax, p0[r]); for (int r = 0; r < 16; ++r) pmax = fmaxf(pmax, p1[r]);
    { auto rr = __builtin_amdgcn_permlane32_swap(__float_as_uint(pmax), __float_as_uint(pmax), false, false);
      pmax = fmaxf(__uint_as_float(rr[0]), __uint_as_float(rr[1])); }
    if (__builtin_expect(__all((pmax - m_reg) <= THR2), 1)) { mn = m_reg; alpha = 1.f; }
    else { mn = fmaxf(m_reg, pmax); alpha = __builtin_amdgcn_exp2f(m_reg - mn); m_reg = mn; }
    for (int r = 0; r < 16; ++r) p0[r] = p0[r] - mn; for (int r = 0; r < 16; ++r) p1[r] = p1[r] - mn;
    for (int r = 0; r < 16; ++r) p0[r] = __builtin_amdgcn_exp2f(p0[r]);
}
__device__ __forceinline__ void finishSM(f32x16& p0, f32x16& p1, float alpha, float& l_reg, bf16x8& pa0, bf16x8& pa1, bf16x8& pa2, bf16x8& pa3) {
    for (int r = 0; r < 16; ++r) p1[r] = __builtin_amdgcn_exp2f(p1[r]);
    float ps = 0; for (int r = 0; r < 16; ++r) ps += p0[r]; for (int r = 0; r < 16; ++r) ps += p1[r];
    { auto rr = __builtin_amdgcn_permlane32_swap(__float_as_uint(ps), __float_as_uint(ps), false, false);
      ps = __uint_as_float(rr[0]) + __uint_as_float(rr[1]); }
    l_reg = l_reg * alpha + ps;
#define PK4(P, B_, OUT) do { unsigned a0 = cvt_pk_bf16(P[B_+0], P[B_+1]), a1 = cvt_pk_bf16(P[B_+2], P[B_+3]);                          \
        unsigned b0 = cvt_pk_bf16(P[B_+4], P[B_+5]), b1 = cvt_pk_bf16(P[B_+6], P[B_+7]);                                             \
        auto r0 = __builtin_amdgcn_permlane32_swap(a0, b0, false, false); auto r1 = __builtin_amdgcn_permlane32_swap(a1, b1, false, false); \
        u32x4 w = {r0[0], r1[0], r0[1], r1[1]}; OUT = *reinterpret_cast<bf16x8*>(&w); } while (0)
    PK4(p0, 0, pa0); PK4(p0, 8, pa1); PK4(p1, 0, pa2); PK4(p1, 8, pa3);
#undef PK4
}
template <int KB>
__device__ __forceinline__ void qkt(f32x16& p0, f32x16& p1, const char* K_lds, int r32, int hi, const char* qs) {
    p0 = f32x16{}; p1 = f32x16{};
    const char* kb[4];
#pragma unroll
    for (int dd = 0; dd < 4; ++dd) kb[dd] = K_lds + KB * SHM_K + KSWZ(r32, (dd * 16 + hi * 8) * 2);
#pragma unroll
    for (int d0 = 0; d0 < 8; ++d0) { const char* a = kb[d0 & 3] + (d0 >> 2) * 128;
        const bf16x8 q = *reinterpret_cast<const bf16x8*>(qs + d0 * 1024);
        bf16x8 b0 = *reinterpret_cast<const bf16x8*>(a);
        bf16x8 b1 = *reinterpret_cast<const bf16x8*>(a + 32 * 256);
        p0 = __builtin_amdgcn_mfma_f32_32x32x16_bf16(b0, q, p0, 0, 0, 0);
        p1 = __builtin_amdgcn_mfma_f32_32x32x16_bf16(b1, q, p1, 0, 0, 0); }
}
template <int VB>
__device__ __forceinline__ void pv_tile(f32x16* o, int vb0, bf16x8 pa0, bf16x8 pa1, bf16x8 pa2, bf16x8 pa3) {
#define TRRD(dst, off) asm volatile("ds_read_b64_tr_b16 %0, %1 offset:%2" : "=&v"(dst) : "v"(vb0), "i"(off) : "memory")
#define PV_D0(d0) do { s16x4 l0, l1, l2, l3, h0, h1, h2, h3; constexpr int b_ = VB * SHM_V + v_rd_off(d0, 0, 0); \
        TRRD(l0, b_); TRRD(h0, b_ + 2048); TRRD(l1, b_ + 4096); TRRD(h1, b_ + 6144); TRRD(l2, b_ + 8192); TRRD(h2, b_ + 10240); TRRD(l3, b_ + 12288); TRRD(h3, b_ + 14336); \
        asm volatile("s_waitcnt lgkmcnt(0)" ::: "memory"); SBAR();   \
        o[d0] = __builtin_amdgcn_mfma_f32_32x32x16_bf16(pa0, (bf16x8){l0[0], l0[1], l0[2], l0[3], h0[0], h0[1], h0[2], h0[3]}, o[d0], 0, 0, 0);   \
        o[d0] = __builtin_amdgcn_mfma_f32_32x32x16_bf16(pa1, (bf16x8){l1[0], l1[1], l1[2], l1[3], h1[0], h1[1], h1[2], h1[3]}, o[d0], 0, 0, 0);   \
        o[d0] = __builtin_amdgcn_mfma_f32_32x32x16_bf16(pa2, (bf16x8){l2[0], l2[1], l2[2], l2[3], h2[0], h2[1], h2[2], h2[3]}, o[d0], 0, 0, 0);   \
        o[d0] = __builtin_amdgcn_mfma_f32_32x32x16_bf16(pa3, (bf16x8){l3[0], l3[1], l3[2], l3[3], h3[0], h3[1], h3[2], h3[3]}, o[d0], 0, 0, 0); } while (0)
    PV_D0(0); PV_D0(1); PV_D0(2); PV_D0(3);
#undef PV_D0
#undef TRRD
}

__device__ __forceinline__ void attn_unit(const bf16* Qp, const bf16* Kp, const bf16* Vp, const float* nck, int P0, int ja, int jb, float* Op, float* MLp, LAS unsigned char* ldsl) {
    char* lds = (char*)ldsl;
    const int tid = opaque_tid(), wid = __builtin_amdgcn_readfirstlane(tid >> 6), lane = tid & 63, r32 = lane & 31, hi = lane >> 5;
    const int NT = jb - ja;
    const int qlo = P0 + wid * QBLK, qm = qlo + r32 - 4 * hi;
    char* V_lds = lds; char* K_lds = lds + 2 * SHM_V;
    float* ws = (float*)(lds + OFF_WS) + wid * 64; float* al_l = ws + 32;
    float* CK = (float*)(lds + OFF_CK);
    float m_reg = -1e30f, l_reg = 0; f32x16 o[4] = {};
    const int sr = tid >> 4, sc = (tid & 15) * 8, vst0 = v_st(sr, sc), vst1 = v_st(32 + sr, sc), kws = KSWZ(sr, sc * 2);
    const int vb0 = (int)(uintptr_t)V_lds + v_rd_base(lane);
    bf16x8 st_v0, st_v1, st_k0, st_k1; const char* qs = lds + OFF_Q + wid * 8192 + lane * 16;
    const unsigned ro0 = (unsigned)(sr * ZP + sc), ro1 = (unsigned)((32 + sr) * ZP + sc);
#define SLOAD_H(k0) do { const unsigned kz_ = (unsigned)(k0) * (unsigned)ZP; st_v0 = load8(Vp + (kz_ + ro0)); st_v1 = load8(Vp + (kz_ + ro1)); st_k0 = load8(Kp + (kz_ + ro0)); st_k1 = load8(Kp + (kz_ + ro1)); } while (0)
#define SWRITE_HK(bf) do { *(bf16x8*)(K_lds + (bf) * SHM_K + kws) = st_k0; *(bf16x8*)(K_lds + (bf) * SHM_K + kws + 32 * 256) = st_k1; } while (0)
#define CK_DMA(k0, bf) do { if (wid == 0) __builtin_amdgcn_global_load_lds((const unsigned*)(nck + (unsigned)(k0) + (unsigned)lane), (LAS unsigned*)(ldsl + OFF_CK + (bf) * 256), 4, 0, 0); } while (0)
#define SWRITE_HV(bf) do { *(bf16x8*)(V_lds + (bf) * SHM_V + vst0) = st_v0; *(bf16x8*)(V_lds + (bf) * SHM_V + vst1) = st_v1; } while (0)
#define SWRITE_H(bf) do { SWRITE_HV(bf); SWRITE_HK(bf); } while (0)
#define RESC(a) do { if (__any((a) < 1.f)) { if (hi == 0) al_l[r32] = (a); asm volatile("s_waitcnt lgkmcnt(0)" ::: "memory");              \
                     for (int d_ = 0; d_ < 4; ++d_) for (int r = 0; r < 16; ++r) o[d_][r] *= al_l[crow(r, hi)]; } } while (0)
#define KBASE(t) ((ja + (t)) * KVBLK)
#define MASKT(P0_, P1_, t) do { const int kb_ = KBASE(t); if (kb_ + KVBLK - 1 > qlo) mask_tile(P0_, P1_, qm - kb_); } while (0)
#pragma unroll
    for (int d0 = 0; d0 < 8; ++d0) *(bf16x8*)(qs + d0 * 1024) = load8(Qp + (unsigned)((qlo + r32) * ZP + d0 * 16 + hi * 8));
    SLOAD_H(KBASE(0)); CK_DMA(KBASE(0), 0); VM_WAIT(); SWRITE_H(0);
    if (NT > 1) { SLOAD_H(KBASE(1)); CK_DMA(KBASE(1), 1); }
    __syncthreads();
    f32x16 pA0, pA1, pB0, pB1; float mnA, mnB, alA, alB; bf16x8 pa0, pa1, pa2, pa3;
    SBAR(); qkt<0>(pA0, pA1, K_lds, r32, hi, qs);
    MASKT(pA0, pA1, 0); bias_tile(pA0, pA1, CK, hi); partialSM(pA0, pA1, m_reg, mnA, alA);
    if (NT > 1) { VM_WAIT(); SWRITE_H(1); }
    __syncthreads();
#define HALF_STEP(PX0, PX1, mnX, alX, PY0, PY1, alY, t, KB, VB, SB) do {                                                      \
        SBAR(); qkt<KB>(PX0, PX1, K_lds, r32, hi, qs);                                                                        \
        finishSM(PY0, PY1, alY, l_reg, pa0, pa1, pa2, pa3); SBAR();                                                           \
        if ((t) + 1 < NT) { SLOAD_H(KBASE((t) + 1)); CK_DMA(KBASE((t) + 1), SB); SBAR(); }                                                                \
        pv_tile<VB>(o, vb0, pa0, pa1, pa2, pa3); MASKT(PX0, PX1, (t)); bias_tile(PX0, PX1, CK + (KB) * 64, hi); partialSM(PX0, PX1, m_reg, mnX, alX);   \
        __syncthreads();                                                                                                      \
        if ((t) + 1 < NT) { VM_WAIT(); SWRITE_H(SB); }                                                                        \
        RESC(alX); __syncthreads(); } while (0)
    for (int t = 1; t + 1 < NT; t += 2) {
        HALF_STEP(pB0, pB1, mnB, alB, pA0, pA1, alA, t, 1, 0, 0);
        HALF_STEP(pA0, pA1, mnA, alA, pB0, pB1, alB, t + 1, 0, 1, 1);
    }
    const bool even = (NT & 1) == 0;
    if (even) { SBAR(); qkt<1>(pB0, pB1, K_lds, r32, hi, qs); SBAR(); }
    finishSM(pA0, pA1, alA, l_reg, pa0, pa1, pa2, pa3); SBAR();
    pv_tile<0>(o, vb0, pa0, pa1, pa2, pa3);
    if (even) { MASKT(pB0, pB1, NT - 1); bias_tile(pB0, pB1, CK + 64, hi); partialSM(pB0, pB1, m_reg, mnB, alB); __syncthreads(); RESC(alB);
        finishSM(pB0, pB1, alB, l_reg, pa0, pa1, pa2, pa3); SBAR(); pv_tile<1>(o, vb0, pa0, pa1, pa2, pa3); }
    float* Ow = Op + (size_t)(wid * QBLK) * DH;
#pragma unroll
    for (int r = 0; r < 16; ++r) { const int orow = crow(r, hi);
#pragma unroll
        for (int d0 = 0; d0 < 4; ++d0) Ow[(size_t)orow * DH + d0 * 32 + r32] = o[d0][r]; }
    if (hi == 0) { *(f32x2*)(MLp + (size_t)(wid * QBLK + r32) * 2) = (f32x2){m_reg, l_reg}; }
    __syncthreads();
#undef SLOAD_H
#undef SWRITE_HK
#undef CK_DMA
#undef SWRITE_HV
#undef SWRITE_H
#undef RESC
#undef KBASE
#undef MASKT
#undef HALF_STEP
}
}

#define XB_TMO      128
#define XB_XCNT(j)  (256  + 64 * (j))
#define XB_XSUB(j)  (1280 + 64 * (j))
#define XB_XGEN(j)  (2304 + 64 * (j))
#define XB_TOP      3328
#define XB_TOPGEN   3392
#define XCD_BAR_WORDS 3456
#define XB_SPIN_CAP (1u << 18)
__device__ __forceinline__ unsigned xb_ld(unsigned* p)              { return __hip_atomic_load(p, __ATOMIC_RELAXED, __HIP_MEMORY_SCOPE_AGENT); }
__device__ __forceinline__ unsigned xb_add(unsigned* p, unsigned v) { return __hip_atomic_fetch_add(p, v, __ATOMIC_RELAXED, __HIP_MEMORY_SCOPE_AGENT); }
__device__ __forceinline__ unsigned xb_xcc_id() { return (unsigned)__builtin_amdgcn_s_getreg((3 << 11) | 20) & 0xFu; }
#define XB_SPIN(cond, bar) do { unsigned _sp = 0; while (cond) { __builtin_amdgcn_s_sleep(1); \
    if ((++_sp & 255u) == 0u) { if (xb_ld(&(bar)[XB_TMO])) break; if (_sp > XB_SPIN_CAP) { atomicAdd(&(bar)[XB_TMO], 1u); break; } } } } while (0)
struct XcdBarrier { unsigned* bar; unsigned x; volatile LAS unsigned* st; };
__device__ __forceinline__ XcdBarrier xcd_barrier_post(unsigned* bar, volatile LAS unsigned* st) {
    XcdBarrier b; b.bar = bar; b.x = xb_xcc_id(); b.st = st;
    if (threadIdx.x == 0) (void)xb_add(&bar[XB_XCNT(b.x)], 1u);
    return b;
}
__device__ __forceinline__ void xcd_barrier_complete(unsigned* bar, unsigned x, unsigned& nloc, unsigned& nx) {
    const unsigned G = gridDim.x * gridDim.y * gridDim.z;
    unsigned sum, cnt, mine, sp = 0u;
    for (;;) {
        sum = 0u; cnt = 0u; mine = 0u;
#pragma nounroll
        for (unsigned j = 0; j < 16; ++j) { const unsigned c = xb_ld(&bar[XB_XCNT(j)]); sum += c; cnt += (c > 0u) ? 1u : 0u; mine = (j == x) ? c : mine; }
        if (sum == G) break;
        __builtin_amdgcn_s_sleep(1);
        if ((++sp & 255u) == 0u) { if (xb_ld(&bar[XB_TMO])) break; if (sp > XB_SPIN_CAP) { atomicAdd(&bar[XB_TMO], 1u); break; } }
    }
    nloc = mine > 0u ? mine : 1u; nx = cnt > 0u ? cnt : 1u;
}
__device__ __forceinline__ void xcd_barrier(const XcdBarrier& b) {
    asm volatile("s_waitcnt vmcnt(0)" ::: "memory");
    __syncthreads();
    if (threadIdx.x == 0) {
        unsigned* bar = b.bar; asm volatile("" : "+s"(bar));
        __builtin_amdgcn_s_waitcnt(0);
        unsigned nloc = b.st[0], nx = b.st[1];
        if (nloc == 0u) { xcd_barrier_complete(bar, b.x, nloc, nx); b.st[0] = nloc; b.st[1] = nx; }
        const unsigned old = xb_add(&bar[XB_XSUB(b.x)], 1u);
        const unsigned gen = old / nloc;
        if (old + 1u == (gen + 1u) * nloc) {
            __builtin_amdgcn_fence(__ATOMIC_RELEASE, "agent");
            asm volatile("s_waitcnt vmcnt(0)" ::: "memory");
            const unsigned og = xb_add(&bar[XB_TOP], 1u);
            const unsigned tg = og / nx;
            if (og + 1u == (tg + 1u) * nx) xb_add(&bar[XB_TOPGEN], 1u);
            else XB_SPIN(xb_ld(&bar[XB_TOPGEN]) == tg, bar);
            __builtin_amdgcn_fence(__ATOMIC_ACQUIRE, "agent");
            xb_add(&bar[XB_XGEN(b.x)], 1u);
            asm volatile("s_waitcnt vmcnt(0)" ::: "memory");
        } else {
            XB_SPIN(xb_ld(&bar[XB_XGEN(b.x)]) == gen, bar);
            __builtin_amdgcn_fence(__ATOMIC_ACQUIRE, "agent");
            asm volatile("s_waitcnt vmcnt(0)" ::: "memory");
        }
    }
    __syncthreads();
}

namespace pg8 {
__device__ __forceinline__ void ho_arrive(unsigned* cnt) {
    asm volatile("s_waitcnt vmcnt(0) lgkmcnt(0)" ::: "memory");
    __syncthreads();
    if (threadIdx.x == 0) { unsigned* c = cnt; asm volatile("" : "+s"(c));
        __builtin_amdgcn_fence(__ATOMIC_RELEASE, "agent"); asm volatile("s_waitcnt vmcnt(0)" ::: "memory");
        (void)xb_add(c, 1u); }
}
struct OrderDenseQ {
    const char* A0; const char* B0; size_t tA, tB; int nM, pn0; unsigned* q; int x; volatile LAS unsigned* slot;
    __device__ __forceinline__ bool next(int i, Unit& u) const {
        if (threadIdx.x == 0) {
            unsigned* qq = q; asm volatile("" : "+s"(qq));
            unsigned L = 0xFFFFFFFFu;
            if (i == 0) L = (unsigned)x * (unsigned)(4 * nM) + (blockIdx.x >> 3);
            else {
#pragma nounroll
            for (int s_ = 0; s_ < 8; ++s_) { const unsigned xx = (unsigned)(x + s_) & 7u; const unsigned v = xb_add(qq + 16 * xx, 1u) + (gridDim.x + 7u - xx) / 8u; if (v < (unsigned)(4 * nM)) { L = xx * (unsigned)(4 * nM) + v; break; } } }
            slot[i & 1] = L;
            asm volatile("s_waitcnt lgkmcnt(0)" ::: "memory");
        }
        __builtin_amdgcn_s_barrier();
        const unsigned L = (unsigned)__builtin_amdgcn_readfirstlane((int)slot[i & 1]);
        if (L == 0xFFFFFFFFu) return false;
        const unsigned xx = L / (unsigned)(4 * nM), v = L % (unsigned)(4 * nM);
        u.pm = (int)(v >> 2); u.pn = pn0 + 4 * (int)xx + (int)(v & 3u); u.A = A0 + (size_t)u.pm * tA; u.B = B0 + (size_t)(u.pn - pn0) * tB; u.aux = 0; u.aux2 = 0; return true;
    }
};
struct OrderMoeDyn {
    const char* A0; const float* W0; unsigned tA; const LAS int* tt; int nunits; unsigned* q; unsigned* ready; unsigned* tmo; volatile LAS unsigned* slot;
    __device__ __forceinline__ bool next(int i, UnitF& u) const {
        if (threadIdx.x == 0) {
            unsigned* qq = q; asm volatile("" : "+s"(qq));
            const unsigned v = xb_add(qq, 1u);
            if (v < (unsigned)nunits) { unsigned* c = ready + (v >> 3); unsigned sp = 0;
                while (xb_ld(c) < 8u) { __builtin_amdgcn_s_sleep(2); if ((++sp & 255u) == 0u) { if (xb_ld(tmo)) break; if (sp > XB_SPIN_CAP) { atomicAdd(tmo, 1u); break; } } }
                __builtin_amdgcn_fence(__ATOMIC_ACQUIRE, "agent"); }
            slot[i & 1] = v;
            asm volatile("s_waitcnt lgkmcnt(0)" ::: "memory");
        }
        __builtin_amdgcn_s_barrier();
        const int L = __builtin_amdgcn_readfirstlane((int)slot[i & 1]);
        if (L >= nunits) return false;
        const int j = L >> 3; u.pn = L & 7; u.pm = j; const int e = __builtin_amdgcn_readfirstlane(tt[j]);
        u.A = A0 + (size_t)((unsigned)j * tA);
        u.B = (const char*)(W0 + (size_t)e * D * DEXP + u.pn * 256); u.B2 = u.B + 512;
        u.aux = e; u.aux2 = 0; return true;
    }
};
}

struct Frame {
    LAS unsigned char* lds; volatile LAS unsigned* MISC; gu32* ctl;
    int tid, lane, wave, vcu, G;
    float* out; GAS unsigned char* ws;
};
struct Args { const float* in[24]; float* out; unsigned char* ws; int ph_lo, ph_hi; };
typedef const __attribute__((address_space(4))) Args* KArgs;
__device__ __forceinline__ KArgs kargs() { KArgs p = (KArgs)__builtin_amdgcn_kernarg_segment_ptr(); asm volatile("" : "+s"(p)); return p; }
enum { I_X = 0, I_META, I_LNIN_G, I_LNIN_B, I_WIN, I_FOXB, I_WA2, I_BA, I_GNORM, I_CONVW, I_POOLW, I_POOLS, I_GATEB, I_WBR, I_WOUT, I_LN1G, I_LN1B, I_RW, I_RB, I_WG, I_WU, I_WD, I_LN2G, I_LN2B };

struct RmId { __device__ __forceinline__ int operator()(int n) const { return n; } };
struct RmIn { __device__ __forceinline__ int operator()(int n) const {
    if (n < 1536) return n; if (n < 1540) return 13312 + (n - 1536); if (n < 2564) return n - 4; if (n < 2580) return 13316 + (n - 2564); return n - 20; } };
struct RmGU { int add; __device__ __forceinline__ int operator()(int n) const { return ((n >> 7) << 8) + add + (n & 127); } };
template <class RM>
__device__ __forceinline__ void tr_item(const float* W, int N, bf16* dst, int dpitch, int koff, const RM& rm, LAS float* scr, int kb, int nb, int lane, unsigned char* dq = nullptr) {
    const int k0 = 64 * kb, n0 = 32 * nb, nn = n0 + (lane & 31); const bool okn = nn < N;
    { const int nc = okn ? nn : N - 1; float v[32];
#pragma unroll
      for (int i = 0; i < 32; ++i) v[i] = W[(size_t)(k0 + 2 * i + (lane >> 5)) * N + nc];
#pragma unroll
      for (int i = 0; i < 32; ++i) scr[(2 * i + (lane >> 5)) * 33 + (lane & 31)] = okn ? v[i] : 0.f; }
    LDS_WAIT(); asm volatile("" ::: "memory");
    const int c = lane & 7;
#pragma unroll
    for (int j = 0; j < 4; ++j) { const int n = (lane >> 3) + 8 * j;
        if (n0 + n < N) { const LAS float* s = scr + (8 * c) * 33 + n;
            const int ro = rm(n0 + n);
            if (dq && ro >= ZC_GZ && ro < ZC_GZ + 4 * D) {
                u32x2 o; o.x = pk4_fp8(s[0 * 33] * WQ_SCALE, s[1 * 33] * WQ_SCALE, s[2 * 33] * WQ_SCALE, s[3 * 33] * WQ_SCALE); o.y = pk4_fp8(s[4 * 33] * WQ_SCALE, s[5 * 33] * WQ_SCALE, s[6 * 33] * WQ_SCALE, s[7 * 33] * WQ_SCALE);
                *(GAS u32x2*)(dq + (size_t)(ro - ZC_GZ) * D + k0 + 8 * c) = o; }
            else {
            u32x4 o; o.x = pk2(s[0 * 33], s[1 * 33]); o.y = pk2(s[2 * 33], s[3 * 33]); o.z = pk2(s[4 * 33], s[5 * 33]); o.w = pk2(s[6 * 33], s[7 * 33]);
            *(GAS u32x4*)(dst + (size_t)ro * dpitch + koff + k0 + 8 * c) = o; } } }
    LDS_WAIT(); asm volatile("" ::: "memory");
}
__device__ __forceinline__ void ln_row_regs(f32x4 (&v)[8], const float* g, const float* beta, int lane) {
    float s = 0.f;
#pragma unroll
    for (int j = 0; j < 8; ++j) s += (v[j].x + v[j].y) + (v[j].z + v[j].w);
    const float mean = wave_sum(s) * (1.f / D); float s2 = 0.f;
#pragma unroll
    for (int j = 0; j < 8; ++j) { v[j] = v[j] - mean; s2 += (v[j].x * v[j].x + v[j].y * v[j].y) + (v[j].z * v[j].z + v[j].w * v[j].w); }
    const float rstd = 1.f / sqrtf(wave_sum(s2) * (1.f / D) + LN_EPS);
#pragma unroll
    for (int j = 0; j < 8; ++j) { const f32x4 gg = *(const f32x4*)(g + 4 * lane + 256 * j), bb = *(const f32x4*)(beta + 4 * lane + 256 * j); v[j] = v[j] * rstd * gg + bb; }
}
struct TrDesc { const float* W; int N; bf16* dst; int dpitch, koff, kb, nb; unsigned char* dq; int rmin; };
__device__ __forceinline__ void tr_load(const TrDesc& t, float (&v)[32], int lane) {
    const int k0 = 64 * t.kb, nn = 32 * t.nb + (lane & 31); const int nc = nn < t.N ? nn : t.N - 1;
    const float* p = t.W + (size_t)(k0 + (lane >> 5)) * t.N + nc; const size_t st = (size_t)2 * t.N;
#pragma unroll
    for (int i = 0; i < 32; ++i) v[i] = p[i * st];
}
__device__ __forceinline__ void tr_finish(const TrDesc& t, const float (&v)[32], LAS float* scr, int lane) {
    const int k0 = 64 * t.kb, n0 = 32 * t.nb; const bool okn = n0 + (lane & 31) < t.N;
#pragma unroll
    for (int i = 0; i < 32; ++i) scr[(2 * i + (lane >> 5)) * 33 + (lane & 31)] = okn ? v[i] : 0.f;
    LDS_WAIT(); asm volatile("" ::: "memory");
    const int c = lane & 7;
#pragma unroll
    for (int j = 0; j < 4; ++j) { const int n = (lane >> 3) + 8 * j;
        if (n0 + n < t.N) { const LAS float* s = scr + (8 * c) * 33 + n;
            const int ro = t.rmin ? RmIn{}(n0 + n) : n0 + n;
            if (t.dq && ro >= ZC_GZ && ro < ZC_GZ + 4 * D) {
                u32x2 o; o.x = pk4_fp8(s[0 * 33] * WQ_SCALE, s[1 * 33] * WQ_SCALE, s[2 * 33] * WQ_SCALE, s[3 * 33] * WQ_SCALE); o.y = pk4_fp8(s[4 * 33] * WQ_SCALE, s[5 * 33] * WQ_SCALE, s[6 * 33] * WQ_SCALE, s[7 * 33] * WQ_SCALE);
                *(GAS u32x2*)(t.dq + (size_t)(ro - ZC_GZ) * D + k0 + 8 * c) = o; }
            else {
                u32x4 o; o.x = pk2(s[0 * 33], s[1 * 33]); o.y = pk2(s[2 * 33], s[3 * 33]); o.z = pk2(s[4 * 33], s[5 * 33]); o.w = pk2(s[6 * 33], s[7 * 33]);
                *(GAS u32x4*)(t.dst + (size_t)ro * t.dpitch + t.koff + k0 + 8 * c) = o; } } }
    LDS_WAIT(); asm volatile("" ::: "memory");
}
__device__ __forceinline__ void ln_row_pre(f32x4 (&v)[8], const f32x4 (&gg)[8], const f32x4 (&bb)[8]) {
    float s = 0.f;
#pragma unroll
    for (int j = 0; j < 8; ++j) s += (v[j].x + v[j].y) + (v[j].z + v[j].w);
    const float mean = wave_sum(s) * (1.f / D); float s2 = 0.f;
#pragma unroll
    for (int j = 0; j < 8; ++j) { v[j] = v[j] - mean; s2 += (v[j].x * v[j].x + v[j].y * v[j].y) + (v[j].z * v[j].z + v[j].w * v[j].w); }
    const float rstd = 1.f / sqrtf(wave_sum(s2) * (1.f / D) + LN_EPS);
#pragma unroll
    for (int j = 0; j < 8; ++j) v[j] = v[j] * rstd * gg[j] + bb[j];
}
__device__ __forceinline__ void store_row(const f32x4 (&v)[8], float* of, bf16* ob, int lane, unsigned char* oq = nullptr) {
#pragma unroll
    for (int j = 0; j < 8; ++j) {
        if (of) *(f32x4*)(of + 4 * lane + 256 * j) = v[j];
        if (oq) *(unsigned*)(oq + 4 * lane + 256 * j) = pk4_fp8(v[j].x, v[j].y, v[j].z, v[j].w);
        if (ob) { u32x2 w; w.x = pk2(v[j].x, v[j].y); w.y = pk2(v[j].z, v[j].w); *(u32x2*)(ob + 4 * lane + 256 * j) = w; } }
}

__device__ __forceinline__ void p0_prologue(Frame& F, KArgs A) {
    LAS float* scr = (LAS float*)(F.lds + F.wave * 16384);
    const int gw = F.vcu * NWAVES + F.wave, NGW = F.G * NWAVES;
    constexpr int I_IN = 32 * 417, I_BR = 4 * 8 * 64, I_OUT = 32 * 64, I_G = NEXP * 32 * 32, I_D = NEXP * 16 * 64, I_PW = 4 * 2 * 4;
    constexpr int PER_LAYER = I_IN + I_BR + I_OUT + I_PW; (void)I_G; (void)I_D;
    auto decode = [&](int it) -> TrDesc {
        const int l = it / PER_LAYER; const int r = it - l * PER_LAYER; const int r1 = r - I_IN, r2 = r1 - I_BR, r3 = r2 - I_OUT;
        const int ty = (r < I_IN) ? 0 : (r1 < I_BR) ? 1 : (r2 < I_OUT) ? 2 : 3;
        const int b = r1 / 512, q1 = r1 % 512, g = r3 / 8, q3 = r3 % 8;
        TrDesc t;
        t.W = ty == 0 ? A->in[I_WIN] + (size_t)l * D * P_IN : ty == 1 ? A->in[I_WBR] + ((size_t)l * 4 + b) * MIXW * D : ty == 2 ? A->in[I_WOUT] + (size_t)l * D * D : A->in[I_POOLW] + ((size_t)l * 4 + g) * 128 * 128;
        t.N = ty == 0 ? P_IN : ty == 3 ? 128 : D;
        t.dst = ty == 0 ? (bf16*)(F.ws + WS_WIN) + (size_t)l * NIN_T * D : ty == 1 ? (bf16*)(F.ws + WS_WBR) + (size_t)l * D * D : ty == 2 ? (bf16*)(F.ws + WS_WOUT) + (size_t)l * D * D : (bf16*)(F.ws + WS_PW) + ((size_t)l * 4 + g) * 128 * 128;
        t.dpitch = ty == 3 ? 128 : D; t.koff = ty == 1 ? b * MIXW : 0;
        t.kb = ty == 0 ? r / 417 : ty == 1 ? q1 / 64 : ty == 2 ? r2 / 64 : q3 / 4;
        t.nb = ty == 0 ? r % 417 : ty == 1 ? q1 % 64 : ty == 2 ? r2 % 64 : q3 % 4;
        t.dq = ty == 0 ? (unsigned char*)(F.ws + WS_WQ + (size_t)l * 4 * D * D) : nullptr; t.rmin = ty == 0;
        return t; };
    { constexpr int TOT = DEPTH * PER_LAYER; float va[32], vb[32]; int it = gw;
      if (it < TOT) { TrDesc ta = decode(it); tr_load(ta, va, F.lane);
        for (;;) {
            const int i1 = it + NGW; const bool h1 = i1 < TOT; const TrDesc tb = decode(h1 ? i1 : it); tr_load(tb, vb, F.lane); __builtin_amdgcn_sched_barrier(0);
            tr_finish(ta, va, scr, F.lane); __builtin_amdgcn_sched_barrier(0);
            if (!h1) break;
            const int i2 = i1 + NGW; const bool h2 = i2 < TOT; ta = decode(h2 ? i2 : i1); tr_load(ta, va, F.lane); __builtin_amdgcn_sched_barrier(0);
            tr_finish(tb, vb, scr, F.lane); __builtin_amdgcn_sched_barrier(0);
            if (!h2) break;
            it = i2; } } }
    for (int it = gw; it < DEPTH * 236; it += NGW) { const int l = it / 236, r = 13332 + it % 236; u32x4* p = (u32x4*)((bf16*)(F.ws + WS_WIN) + ((size_t)l * NIN_T + r) * D);
#pragma unroll
        for (int j = 0; j < 4; ++j) p[F.lane + 64 * j] = (u32x4){0u, 0u, 0u, 0u}; }
    { f32x4 gg[8], bb[8];
#pragma unroll
      for (int j = 0; j < 8; ++j) { gg[j] = *(const f32x4*)(A->in[I_LNIN_G] + 4 * F.lane + 256 * j); bb[j] = *(const f32x4*)(A->in[I_LNIN_B] + 4 * F.lane + 256 * j); }
      int m = gw;
      if (m < MP) {
        f32x4 x[8];
#define P0_SRC(mm) ((mm) < NMETA ? A->in[I_META] + (size_t)(mm) * D : A->in[I_X] + (size_t)(((mm) < NTOK ? (mm) : NTOK - 1) - NMETA) * D)
        { const float* src = P0_SRC(m);
#pragma unroll
          for (int j = 0; j < 8; ++j) x[j] = *(const f32x4*)(src + 4 * F.lane + 256 * j); }
        for (;;) {
            f32x4 v[8];
#pragma unroll
            for (int j = 0; j < 8; ++j) v[j] = x[j];
            const int mn = m + NGW; const bool more = mn < MP; const int mc = more ? mn : m;
            { const float* src = P0_SRC(mc);
#pragma unroll
              for (int j = 0; j < 8; ++j) x[j] = *(const f32x4*)(src + 4 * F.lane + 256 * j); }
            if (m < NTOK) ln_row_pre(v, gg, bb);
            else {
#pragma unroll
                for (int j = 0; j < 8; ++j) v[j] = (f32x4){0.f, 0.f, 0.f, 0.f}; }
            store_row(v, (float*)(F.ws + WS_HF) + (size_t)m * D, (bf16*)(F.ws + WS_HB) + (size_t)m * D, F.lane, (unsigned char*)(F.ws + WS_HQ + (size_t)m * D));
            if (!more) break;
            m = mn;
        }
#undef P0_SRC
      } }
}

__device__ __forceinline__ f32x16 mma_tile(const LAS bf16* A, int pa, const LAS bf16* B, int pb, int K, f32x16 acc, int lane) {
    const int r = lane & 31, h8 = (lane >> 5) * 8;
    for (int ks = 0; ks < K; ks += 16) {
        const bf16x8 a = *(const LAS bf16x8*)(A + r * pa + ks + h8), b = *(const LAS bf16x8*)(B + r * pb + ks + h8);
        acc = __builtin_amdgcn_mfma_f32_32x32x16_bf16(a, b, acc, 0, 0, 0);
    }
    return acc;
}
__device__ __forceinline__ int crow16(int r, int hi) { return (r & 3) + 8 * (r >> 2) + 4 * hi; }

__device__ __forceinline__ void p2a_cumsum(Frame& F, KArgs A, int l, int h) {
    const float* Zs = (const float*)(F.ws + WS_ZS); float* C2 = (float*)(F.ws + WS_C2) + (size_t)h * MP;
    const float fb = A->in[I_FOXB][l * 4 + h];
    LAS float* wsum = (LAS float*)(F.lds);
    const int t0 = F.tid * 17; float loc[17]; float run = 0.f;
#pragma unroll
    for (int i = 0; i < 17; ++i) { const int t = t0 + i; const float x = (t < NTOK) ? log_sigmoidf(Zs[(size_t)t * 32 + h] + fb) : 0.f; run += x; loc[i] = run; }
    float incl = run;
#pragma unroll
    for (int o = 1; o < 64; o <<= 1) { const float y = __shfl_up(incl, o); if (F.lane >= o) incl += y; }
    if (F.lane == 63) wsum[F.wave] = incl;
    __syncthreads();
    float off = incl - run;
    for (int w = 0; w < F.wave; ++w) off += wsum[w];
#pragma unroll
    for (int i = 0; i < 17; ++i) { const int t = t0 + i; if (t < MP) C2[t] = -(off + loc[i]) * LOG2E; }
    __syncthreads();
}

constexpr int GL_GA = 0, GL_WA = 4096, GL_PART = 8192, GL_BC = 10240, GL_A0 = 27136;
constexpr int GP = 72;
__device__ __forceinline__ void gla_bc(Frame& F, KArgs A, int l, int c, int h, float (&bcv)[8], float& last_k) {
    const float* Zs = (const float*)(F.ws + WS_ZS);
    LAS float* ga_s = (LAS float*)(F.lds + GL_GA); LAS float* wa_s = (LAS float*)(F.lds + GL_WA); LAS float* part = (LAS float*)(F.lds + GL_PART); LAS float* bc_s = (LAS float*)(F.lds + GL_BC);
    if (F.tid < 256) { const int i = F.tid >> 2, q = F.tid & 3, r = 64 * c + i - GLA_FRONT;
        const f32x4 v = (r >= 0 && r < NTOK) ? *(const f32x4*)(Zs + (size_t)r * 32 + 4 + 4 * q) : (f32x4){0.f, 0.f, 0.f, 0.f};
        *(LAS f32x4*)(ga_s + i * 16 + 4 * q) = v; }
    { float wv[2];
#pragma unroll
      for (int q = 0; q < 2; ++q) { const int idx = F.tid + 512 * q, j = idx >> 6, k = idx & 63; wv[q] = A->in[I_WA2][((size_t)l * 16 + j) * 256 + h * 64 + k]; }
#pragma unroll
      for (int q = 0; q < 2; ++q) wa_s[F.tid + 512 * q] = wv[q]; }
    __syncthreads();
    const int k = F.tid & 63, ig = F.tid >> 6; const float ba = A->in[I_BA][l * 256 + h * 64 + k];
    float run = 0.f;
#pragma unroll
    for (int ii = 0; ii < 8; ++ii) { const int i = 8 * ig + ii, r = 64 * c + i - GLA_FRONT; float x = ba;
#pragma unroll
        for (int j = 0; j < 16; ++j) x = fmaf(ga_s[i * 16 + j], wa_s[j * 64 + k], x);
        const float g = (r >= 0 && r < NTOK) ? log_sigmoidf(x) * (1.f / 16.f) : 0.f; run += g; bcv[ii] = run; }
    part[ig * 64 + k] = run;
    __syncthreads();
    float off = 0.f, tot = 0.f;
#pragma unroll
    for (int g2 = 0; g2 < 8; ++g2) { const float p = part[g2 * 64 + k]; tot += p; if (g2 < ig) off += p; }
#pragma unroll
    for (int ii = 0; ii < 8; ++ii) { bcv[ii] += off; bc_s[(8 * ig + ii) * 65 + k] = bcv[ii]; }
    last_k = tot;
}
__device__ __forceinline__ void gla_load_vt(Frame& F, int c, int h, LAS bf16* VT) {
    const bf16* Z = (const bf16*)(F.ws + WS_Z);
    const int v = F.tid & 127, sg = F.tid >> 7; unsigned w[8];
#pragma unroll
    for (int jj = 0; jj < 8; ++jj) { unsigned lo = 0, hi = 0; const int s0 = 16 * sg + 2 * jj, r0 = 64 * c + s0 - GLA_FRONT;
        if (r0 >= 0 && r0 < NTOK) lo = Z[(size_t)r0 * ZP + ZC_GV + h * 128 + v];
        if (r0 + 1 >= 0 && r0 + 1 < NTOK) hi = Z[(size_t)(r0 + 1) * ZP + ZC_GV + h * 128 + v];
        w[jj] = lo | (hi << 16); }
    *(LAS u32x4*)(VT + v * GP + 16 * sg) = (u32x4){w[0], w[1], w[2], w[3]};
    *(LAS u32x4*)(VT + v * GP + 16 * sg + 8) = (u32x4){w[4], w[5], w[6], w[7]};
}
__device__ __forceinline__ void gla_stage1(Frame& F, KArgs A, int l, int c, int h) {
    const bf16* Z = (const bf16*)(F.ws + WS_Z);
    LAS bf16* KhT = (LAS bf16*)(F.lds + GL_A0); LAS bf16* VT = (LAS bf16*)(F.lds + GL_A0 + 64 * GP * 2);
    float bcv[8], last_k; gla_bc(F, A, l, c, h, bcv, last_k);
    const int k = F.tid & 63, ig = F.tid >> 6; unsigned w[4];
#pragma unroll
    for (int jj = 0; jj < 4; ++jj) { float x[2];
#pragma unroll
        for (int q = 0; q < 2; ++q) { const int ii = 2 * jj + q, r = 64 * c + 8 * ig + ii - GLA_FRONT;
            const float kc = (r >= 0 && r < NTOK) ? bf2f(Z[(size_t)r * ZP + ZC_GK + h * 64 + k]) : 0.f; x[q] = kc * __expf(last_k - bcv[ii]); }
        w[jj] = pk2(x[0], x[1]); }
    *(LAS u32x4*)(KhT + k * GP + 8 * ig) = (u32x4){w[0], w[1], w[2], w[3]};
    gla_load_vt(F, c, h, VT);
    if (ig == 0) ((float*)(F.ws + WS_DEC))[((size_t)c * 4 + h) * 64 + k] = __expf(last_k);
    __syncthreads();
    { const int mt = F.wave >> 1, nt = F.wave & 1, r = F.lane & 31, hi = F.lane >> 5; f32x16 acc = {};
      acc = mma_tile(VT + mt * 32 * GP, GP, KhT + nt * 32 * GP, GP, 64, acc, F.lane);
      float* U = (float*)(F.ws + WS_UT) + (((size_t)c * 4 + h) * 128) * 64;
#pragma unroll
      for (int rg = 0; rg < 16; ++rg) U[(size_t)(mt * 32 + crow16(rg, hi)) * 64 + nt * 32 + r] = acc[rg]; }
    __syncthreads();
}
__device__ __forceinline__ void gla_scan_item(Frame& F, int it) {
    const int e = it * 512 + F.tid, h = e >> 13, v = (e >> 6) & 127, k = e & 63;
    const float* U = (const float*)(F.ws + WS_UT); const float* DEC = (const float*)(F.ws + WS_DEC); bf16* St = (bf16*)(F.ws + WS_ST);
    float S = 0.f; float u[8], d[8];
#define SCAN_LOAD(c0_) do { _Pragma("unroll") for (int j = 0; j < 8; ++j) { const int c_ = (c0_) + j; const int cc_ = c_ < NCHUNK ? c_ : NCHUNK - 1; \
        u[j] = U[(((size_t)cc_ * 4 + h) * 128 + v) * 64 + k]; d[j] = DEC[((size_t)cc_ * 4 + h) * 64 + k]; } } while (0)
    SCAN_LOAD(0);
    for (int c0 = 0; c0 < NCHUNK; c0 += 8) { float uc[8], dc[8];
#pragma unroll
        for (int j = 0; j < 8; ++j) { uc[j] = u[j]; dc[j] = d[j]; }
        SCAN_LOAD(c0 + 8 < NCHUNK ? c0 + 8 : c0);
#pragma unroll
        for (int j = 0; j < 8; ++j) { const int c = c0 + j; if (c < NCHUNK) { St[(((size_t)c * 4 + h) * 128 + v) * 64 + k] = (bf16)f2bf(S); S = fmaf(dc[j], S, uc[j]); } }
    }
#undef SCAN_LOAD
}
__device__ __forceinline__ void gla_stage3(Frame& F, KArgs A, int l, int c, int h) {
    const bf16* Z = (const bf16*)(F.ws + WS_Z);
    LAS bf16* QT = (LAS bf16*)(F.lds + GL_A0); LAS bf16* KT = QT + 64 * GP; LAS bf16* ATT = KT + 64 * GP; LAS bf16* VT = ATT + 64 * GP; LAS bf16* ST = VT + 128 * GP;
    LAS float* O_s = (LAS float*)(F.lds + GL_A0 + (3 * 64 + 2 * 128) * GP * 2);
    float bcv[8], last_k; gla_bc(F, A, l, c, h, bcv, last_k);
    const int k = F.tid & 63, ig = F.tid >> 6;
#pragma unroll
    for (int ii = 0; ii < 8; ++ii) { const int i = 8 * ig + ii, r = 64 * c + i - GLA_FRONT; float qv = 0.f, kv = 0.f;
        if (r >= 0 && r < NTOK) { qv = bf2f(Z[(size_t)r * ZP + ZC_GQ + h * 64 + k]) * 0.125f; kv = bf2f(Z[(size_t)r * ZP + ZC_GK + h * 64 + k]); }
        QT[i * GP + k] = (bf16)f2bf(qv * __expf(bcv[ii])); KT[i * GP + k] = (bf16)f2bf(kv * __expf(-bcv[ii])); }
    gla_load_vt(F, c, h, VT);
    { const bf16* Sp = (const bf16*)(F.ws + WS_ST) + (((size_t)c * 4 + h) * 128) * 64;
#pragma unroll
      for (int j = 0; j < 2; ++j) { const int q = F.tid + 512 * j, v = q >> 3, kk = (q & 7) * 8; *(LAS u32x4*)(ST + v * GP + kk) = *(const u32x4*)(Sp + (size_t)v * 64 + kk); } }
    __syncthreads();
    if (F.wave < 4) { const int mt = F.wave >> 1, nt = F.wave & 1, r = F.lane & 31, hi = F.lane >> 5; f32x16 acc = {};
        acc = mma_tile(QT + mt * 32 * GP, GP, KT + nt * 32 * GP, GP, 64, acc, F.lane);
#pragma unroll
        for (int rg = 0; rg < 16; ++rg) { const int t = mt * 32 + crow16(rg, hi), s = nt * 32 + r; ATT[t * GP + s] = (bf16)f2bf(s <= t ? acc[rg] : 0.f); } }
    __syncthreads();
    { const int mt = F.wave >> 2, nt = F.wave & 3, r = F.lane & 31, hi = F.lane >> 5; f32x16 acc = {};
      acc = mma_tile(ATT + mt * 32 * GP, GP, VT + nt * 32 * GP, GP, 64, acc, F.lane);
      acc = mma_tile(QT + mt * 32 * GP, GP, ST + nt * 32 * GP, GP, 64, acc, F.lane);
#pragma unroll
      for (int rg = 0; rg < 16; ++rg) O_s[(mt * 32 + crow16(rg, hi)) * 132 + nt * 32 + r] = acc[rg]; }
    __syncthreads();
    { bf16* OM = (bf16*)(F.ws + WS_OM); const float* gn = A->in[I_GNORM] + l * 512 + h * 128;
      const float g0 = gn[F.lane], g1 = gn[F.lane + 64];
      float gr0[8], gr1[8];
#pragma unroll
      for (int ii = 0; ii < 8; ++ii) { const int r = 64 * c + 8 * F.wave + ii - GLA_FRONT; const int rc = r < 0 ? 0 : (r < NTOK ? r : NTOK - 1);
          gr0[ii] = bf2f(Z[(size_t)rc * ZP + ZC_GR + h * 128 + F.lane]); gr1[ii] = bf2f(Z[(size_t)rc * ZP + ZC_GR + h * 128 + F.lane + 64]); }
#pragma unroll
      for (int ii = 0; ii < 8; ++ii) { const int t = 8 * F.wave + ii, r = 64 * c + t - GLA_FRONT;
          const float x0 = O_s[t * 132 + F.lane], x1 = O_s[t * 132 + F.lane + 64];
          const float ss = wave_sum(x0 * x0 + x1 * x1); const float rstd = 1.f / sqrtf(ss * (1.f / 128.f) + LN_EPS);
          if (r >= 0 && r < NTOK) { const float r0 = gr0[ii], r1 = gr1[ii];
              OM[(size_t)r * D + 512 + h * 128 + F.lane] = (bf16)f2bf(x0 * rstd * g0 * (r0 * sigmoidf_fast(r0)));
              OM[(size_t)r * D + 512 + h * 128 + F.lane + 64] = (bf16)f2bf(x1 * rstd * g1 * (r1 * sigmoidf_fast(r1))); } } }
    __syncthreads();
}
__device__ __forceinline__ void conv_item(Frame& F, KArgs A, int l, int rt) {
    const bf16* Z = (const bf16*)(F.ws + WS_Z); bf16* OM = (bf16*)(F.ws + WS_OM);
    const int c4 = 4 * (F.tid & 127), rb = 64 * rt + 16 * __builtin_amdgcn_readfirstlane(F.tid >> 7);
    const float* cw = A->in[I_CONVW] + (size_t)l * 3 * 512;
    const f32x4 w0 = *(const f32x4*)(cw + c4), w1 = *(const f32x4*)(cw + 512 + c4), w2 = *(const f32x4*)(cw + 1024 + c4);
    u32x2 cc[18], cv[18], cb[16];
#pragma unroll
    for (int i = 0; i < 18; ++i) { const int r = rb + i - 2; const int rc = r < 0 ? 0 : (r < NTOK ? r : NTOK - 1);
        cc[i] = *(const u32x2*)(Z + (size_t)rc * ZP + ZC_CC + c4); cv[i] = *(const u32x2*)(Z + (size_t)rc * ZP + ZC_CV + c4);
        if (i >= 2) cb[i - 2] = *(const u32x2*)(Z + (size_t)rc * ZP + ZC_CB + c4); }
#define CV_U(i) ((rb + (i) - 2 >= 0) ? (f32x4){bflo(cc[i].x) * bflo(cv[i].x), bfhi(cc[i].x) * bfhi(cv[i].x), bflo(cc[i].y) * bflo(cv[i].y), bfhi(cc[i].y) * bfhi(cv[i].y)} : (f32x4){0.f, 0.f, 0.f, 0.f})
    f32x4 u2 = CV_U(0), u1 = CV_U(1);
#pragma unroll
    for (int i = 0; i < 16; ++i) { const int r = rb + i; const f32x4 u0 = CV_U(i + 2);
        const f32x4 b = (f32x4){bflo(cb[i].x), bfhi(cb[i].x), bflo(cb[i].y), bfhi(cb[i].y)}, o = b * (w0 * u2 + w1 * u1 + w2 * u0);
        if (r < NTOK) { u32x2 w; w.x = pk2(o[0], o[1]); w.y = pk2(o[2], o[3]); *(u32x2*)(OM + (size_t)r * D + 1024 + c4) = w; }
        u2 = u1; u1 = u0; }
#undef CV_U
}
__device__ __forceinline__ void pool_item(Frame& F, KArgs A, int l, int rt, int g) {
    const bf16* Z = (const bf16*)(F.ws + WS_Z); bf16* OM = (bf16*)(F.ws + WS_OM);
    constexpr int PP = 136;
    LAS float* X_s = (LAS float*)(F.lds); LAS bf16* P_s = (LAS bf16*)(F.lds + 40448); LAS bf16* PW_s = (LAS bf16*)(F.lds + 40448 + 64 * PP * 2);
    const int r0 = 64 * rt, w = 2 << g;
    { float xv[20];
#pragma unroll
      for (int q = 0; q < 20; ++q) { const int idx = F.tid + 512 * q, rr = idx >> 7, c = idx & 127, r = r0 - 15 + rr;
          xv[q] = (idx < 79 * 128 && r >= 0 && r < NTOK) ? bf2f(Z[(size_t)r * ZP + ZC_PZ + g * 128 + c]) : 0.f; }
#pragma unroll
      for (int q = 0; q < 20; ++q) { const int idx = F.tid + 512 * q; if (idx < 79 * 128) X_s[idx] = xv[q]; } }
    { const bf16* pw = (const bf16*)(F.ws + WS_PW) + ((size_t)l * 4 + g) * 128 * 128;
#pragma unroll
      for (int j = 0; j < 4; ++j) { const int q = F.tid + 512 * j, d = q >> 4, cc = (q & 15) * 8; *(LAS u32x4*)(PW_s + d * PP + cc) = *(const u32x4*)(pw + (size_t)d * 128 + cc); } }
    __syncthreads();
    { const int c = F.tid & 127, ib = (F.tid >> 7) * 16;
      float xs[32];
#pragma unroll
      for (int q = 0; q < 32; ++q) xs[q] = (ib + q - 1 >= 0) ? X_s[(ib + q - 1) * 128 + c] : 0.f;
      float sw = 0.f;
#pragma unroll
      for (int j = 0; j < 16; ++j) if (j < w) sw += xs[16 - j];
#pragma unroll
      for (int ii = 0; ii < 16; ++ii) { const int i = ib + ii, t = r0 + i;
          if (ii > 0) { float leave = 0.f;
#pragma unroll
              for (int g2 = 0; g2 < 4; ++g2) if (g2 == g) leave = xs[16 + ii - (2 << g2)];
              sw += xs[16 + ii] - leave; }
          const int cnt = (t + 1 < w) ? (t + 1) : w;
          P_s[i * PP + c] = (bf16)f2bf(sw / (float)cnt - xs[16 + ii]); } }
    __syncthreads();
    { const int mt = F.wave >> 2, nt = F.wave & 3, r = F.lane & 31, hi = F.lane >> 5; f32x16 acc = {};
      acc = mma_tile(P_s + mt * 32 * PP, PP, PW_s + nt * 32 * PP, PP, 128, acc, F.lane);
      const float sc = A->in[I_POOLS][l * 512 + g * 128 + nt * 32 + r];
#pragma unroll
      for (int rg = 0; rg < 16; ++rg) { const int t = r0 + mt * 32 + crow16(rg, hi); if (t < NTOK) OM[(size_t)t * D + 1536 + g * 128 + nt * 32 + r] = (bf16)f2bf(acc[rg] * sc); } }
    __syncthreads();
}
__device__ __forceinline__ void norm_item(Frame& F, int l, int rt) {
    const bf16* Z = (const bf16*)(F.ws + WS_Z);
    const int hq = F.wave, r = 64 * rt + F.lane; float ss = 0.f;
    if (r < NTOK) { const bf16* p = Z + (size_t)r * ZP + ((hq & 1) ? ZC_FK : ZC_FQ) + (hq >> 1) * 128;
#pragma unroll
        for (int j = 0; j < 16; ++j) { const u32x4 w = *(const u32x4*)(p + 8 * j);
            ss += (bflo(w.x) * bflo(w.x) + bfhi(w.x) * bfhi(w.x)) + (bflo(w.y) * bflo(w.y) + bfhi(w.y) * bfhi(w.y)) + (bflo(w.z) * bflo(w.z) + bfhi(w.z) * bfhi(w.z)) + (bflo(w.w) * bflo(w.w) + bfhi(w.w) * bfhi(w.w)); } }
#pragma unroll
    for (int o = 1; o < 64; o <<= 1) ss = fmaxf(ss, __shfl_xor(ss, o));
    if (F.lane == 0) atomicMax((unsigned*)(F.ctl + CW_NRM + 64 * l + hq), __builtin_bit_cast(unsigned, ss));
}
__device__ __forceinline__ void att_decode(int u, int& qb, int& s, int& h) {
    s = 0;
#pragma nounroll
    while (s + 1 < ATT_MAXNS && u >= att_sbase(s + 1)) ++s;
    const int r = u - att_sbase(s); qb = 32 - (r >> 2); h = r & 3;
}
__device__ __forceinline__ int att_unit(int qb, int s, int h) { return att_sbase(s) + 4 * (32 - qb) + h; }
__device__ __forceinline__ void att_combine(Frame& F, int qb, int h) {
    const float* OP = (const float*)(F.ws + WS_OPART); const float* ML = (const float*)(F.ws + WS_ML); bf16* OM = (bf16*)(F.ws + WS_OM);
    const int ns = att_ns(qb), d4 = (F.lane & 31) * 4, rsub = F.lane >> 5;
    f32x2 mln[4]; f32x4 opn[4];
#pragma unroll
    for (int s2 = 0; s2 < 4; ++s2) { mln[s2] = (f32x2){-3.0e38f, 0.f}; opn[s2] = (f32x4){0.f, 0.f, 0.f, 0.f}; }
#define AC_LOAD(st_) do { const int row_ = 32 * F.wave + 2 * (st_) + rsub; _Pragma("unroll") for (int s2 = 0; s2 < 4; ++s2) if (s2 < ns) { const size_t ub = (size_t)att_unit(qb, s2, h) * 256 + row_; \
        mln[s2] = *(const f32x2*)(ML + ub * 2); opn[s2] = *(const f32x4*)(OP + ub * 128 + d4); } } while (0)
    AC_LOAD(0);
#pragma nounroll
    for (int st = 0; st < 16; ++st) { const int row = 32 * F.wave + 2 * st + rsub;
        f32x2 ml[4]; f32x4 op[4];
#pragma unroll
        for (int s2 = 0; s2 < 4; ++s2) { ml[s2] = mln[s2]; op[s2] = opn[s2]; }
        AC_LOAD(st < 15 ? st + 1 : 15);
        float M = -3.0e38f;
#pragma unroll
        for (int s2 = 0; s2 < 4; ++s2) if (s2 < ns) M = fmaxf(M, ml[s2].x);
        bool more = ns > 4 && ml[3].x > -1.0e29f;
        for (int s2 = 4; more && s2 < ns; ++s2) { const float m2 = ML[((size_t)att_unit(qb, s2, h) * 256 + row) * 2]; more = m2 > -1.0e29f; M = fmaxf(M, m2); }
        float wsum = 0.f; f32x4 o = {0.f, 0.f, 0.f, 0.f};
#pragma unroll
        for (int s2 = 0; s2 < 4; ++s2) if (s2 < ns && ml[s2].x > -1.0e29f) { const float e = __builtin_amdgcn_exp2f(ml[s2].x - M); wsum += e * ml[s2].y; o += op[s2] * e; }
        more = ns > 4 && ml[3].x > -1.0e29f;
        for (int s2 = 4; more && s2 < ns; ++s2) { const size_t ub = (size_t)att_unit(qb, s2, h) * 256 + row; const f32x2 m2 = *(const f32x2*)(ML + ub * 2); more = m2.x > -1.0e29f;
            if (more) { const float e = __builtin_amdgcn_exp2f(m2.x - M); wsum += e * m2.y; o += *(const f32x4*)(OP + ub * 128 + d4) * e; } }
        const float inv = 1.f / wsum; const size_t r = (size_t)qb * 256 + row;
        u32x2 w; w.x = pk2(o[0] * inv, o[1] * inv); w.y = pk2(o[2] * inv, o[3] * inv);
        *(u32x2*)(OM + r * D + h * 128 + d4) = w; }
#undef AC_LOAD
}

__device__ __forceinline__ void p3_meta(Frame& F, KArgs A, int l) {
    if (F.vcu >= 128) return;
    const bf16* OM = (const bf16*)(F.ws + WS_OM); const bf16* W = (const bf16*)(F.ws + WS_WBR) + (size_t)l * D * D; const bf16* Z = (const bf16*)(F.ws + WS_Z); bf16* MX = (bf16*)(F.ws + WS_MX);
    const int n0 = 16 * F.vcu, r = F.lane & 15, g = F.lane >> 4, b = F.wave >> 1, kh = F.wave & 1;
    f32x4 acc = {0.f, 0.f, 0.f, 0.f};
    const bf16* ap = OM + (size_t)r * D + b * MIXW + kh * 256 + 8 * g; const bf16* bp = W + (size_t)(n0 + r) * D + b * MIXW + kh * 256 + 8 * g;
#pragma unroll
    for (int ks = 0; ks < 8; ++ks) acc = __builtin_amdgcn_mfma_f32_16x16x32_bf16(*(const bf16x8*)(ap + 32 * ks), *(const bf16x8*)(bp + 32 * ks), acc, 0, 0, 0);
    LAS float* Ps = (LAS float*)(F.lds);
#pragma unroll
    for (int rg = 0; rg < 4; ++rg) Ps[(F.wave * 16 + g * 4 + rg) * 16 + r] = acc[rg];
    __syncthreads();
    if (F.tid < 256) { const int row = F.tid >> 4, col = F.tid & 15; float sum = 0.f;
#pragma unroll
        for (int bb = 0; bb < 4; ++bb) { const float p = Ps[((2 * bb) * 16 + row) * 16 + col] + Ps[((2 * bb + 1) * 16 + row) * 16 + col];
            const float tz = bf2f(Z[(size_t)row * ZP + ZC_GZ + bb * D + n0 + col]);
            sum += __builtin_amdgcn_rcpf(tz) * p; }
        MX[(size_t)row * D + n0 + col] = (bf16)f2bf(sum); }
    __syncthreads();
}
__device__ __forceinline__ void p4_meta(Frame& F, int l) {
    if (F.vcu >= 128) return;
    const bf16* MX = (const bf16*)(F.ws + WS_MX); const bf16* W = (const bf16*)(F.ws + WS_WOUT) + (size_t)l * D * D; bf16* MO = (bf16*)(F.ws + WS_MO);
    const int n0 = 16 * F.vcu, r = F.lane & 15, g = F.lane >> 4;
    f32x4 acc = {0.f, 0.f, 0.f, 0.f};
    const bf16* ap = MX + (size_t)r * D + 256 * F.wave + 8 * g; const bf16* bp = W + (size_t)(n0 + r) * D + 256 * F.wave + 8 * g;
#pragma unroll
    for (int ks = 0; ks < 8; ++ks) acc = __builtin_amdgcn_mfma_f32_16x16x32_bf16(*(const bf16x8*)(ap + 32 * ks), *(const bf16x8*)(bp + 32 * ks), acc, 0, 0, 0);
    LAS float* Ps = (LAS float*)(F.lds);
#pragma unroll
    for (int rg = 0; rg < 4; ++rg) Ps[(F.wave * 16 + g * 4 + rg) * 16 + r] = acc[rg];
    __syncthreads();
    if (F.tid < 256) { const int row = F.tid >> 4, col = F.tid & 15; float sum = 0.f;
#pragma unroll
        for (int w = 0; w < 8; ++w) sum += Ps[(w * 16 + row) * 16 + col];
        MO[(size_t)row * D + n0 + col] = (bf16)f2bf(sum); }
    __syncthreads();
}
typedef __attribute__((address_space(1))) const float gcf32;
#define P5A_LBAR() do { asm volatile("s_waitcnt lgkmcnt(0)" ::: "memory"); __builtin_amdgcn_s_barrier(); } while (0)
__device__ __forceinline__ void p5a_ln_router(Frame& F, KArgs A, int l, bool dummy) {
    const float* Hf = (const float*)(F.ws + WS_HF); const bf16* MO = (const bf16*)(F.ws + WS_MO);
    float* Hfo = (float*)(F.ws + (dummy ? WS_MXF : WS_HF)); bf16* Hb = (bf16*)(F.ws + (dummy ? WS_OPART : WS_HB));
    int* EID = (int*)(F.ws + (dummy ? WS_ML : WS_EID)); float* WTS = (float*)(F.ws + (dummy ? WS_ML + 70000 : WS_WTS)); int* DST = (int*)(F.ws + (dummy ? WS_ML + 140000 : WS_DST)); const int cw = CW_ECNT + 64 * l + (dummy ? 32 : 0);
    constexpr int HP = 2052;
    LAS float* Hs = (LAS float*)(F.lds); LAS float* Ps = Hs; LAS float* sel_s = Hs + 16 * HP; LAS float* aff_s = sel_s + 512;
    static_assert((16 * HP + 1024 + 32) * 4 <= LDSCTL_OFF, "P5a LDS");
    const int c = F.lane & 15, g = F.lane >> 4;
    f32x4 hv[2][8]; u32x2 mv[2][8];
#define P5A_LOAD(item) do { _Pragma("unroll") for (int rr = 0; rr < 2; ++rr) { const size_t m_ = (size_t)(16 * (item) + 2 * F.wave + rr); \
        _Pragma("unroll") for (int j = 0; j < 8; ++j) { mv[rr][j] = *(const u32x2*)(MO + m_ * D + 4 * F.lane + 256 * j); hv[rr][j] = *(const f32x4*)(Hf + m_ * D + 4 * F.lane + 256 * j); } } } while (0)
    int it = F.vcu + ((l == DEPTH - 1 && F.vcu == 0) ? F.G : 0);
    if (it < NTOK / 16) P5A_LOAD(it);
    for (; it < NTOK / 16; it += F.G) {
        const int m0 = 16 * it;
#pragma unroll
        for (int rr = 0; rr < 2; ++rr) { const int r = 2 * F.wave + rr; const size_t m = (size_t)(m0 + r);
            f32x4 v[8];
#pragma unroll
            for (int j = 0; j < 8; ++j) { const u32x2 mo = mv[rr][j]; v[j] = hv[rr][j] * ALPHA + (f32x4){bflo(mo.x), bfhi(mo.x), bflo(mo.y), bfhi(mo.y)}; }
            { const GAS float* g1_ = (const GAS float*)(A->in[I_LN1G] + l * D); const GAS float* b1_ = (const GAS float*)(A->in[I_LN1B] + l * D); asm volatile("" : "+s"(g1_), "+s"(b1_));
              ln_row_regs(v, (const float*)g1_, (const float*)b1_, F.lane); }
#pragma unroll
            for (int j = 0; j < 8; ++j) *(LAS f32x4*)(Hs + r * HP + 4 * F.lane + 256 * j) = v[j];
            __builtin_amdgcn_sched_barrier(0); }
        __builtin_amdgcn_sched_barrier(0);
        float q0[32], q1[32], q2[32];
        unsigned lo_ = (unsigned)(g * 32 + c) * 4u; asm volatile("" : "+v"(lo_));
        const char* rw_ = (const char*)(A->in[I_RW]) + (size_t)F.wave * 32768; asm volatile("" : "+s"(rw_));
#define P5A_LOADQ(q, qi) do { _Pragma("unroll") for (int h_ = 0; h_ < 2; ++h_) { const gcf32* ub_ = (const gcf32*)(rw_ + ((qi) * 2 + h_) * 4096 + lo_); \
            _Pragma("unroll") for (int k8 = 0; k8 < 8; ++k8) { q[(h_ * 8 + k8) * 2] = ub_[k8 * 128]; q[(h_ * 8 + k8) * 2 + 1] = ub_[k8 * 128 + 16]; } } } while (0)
#define P5A_MFMAQ(q, qi) do { _Pragma("unroll") for (int k_ = 0; k_ < 16; ++k_) { const float a_ = ap[4 * ((qi) * 16 + k_)]; \
            acc0 = __builtin_amdgcn_mfma_f32_16x16x4f32(a_, q[2 * k_], acc0, 0, 0, 0); acc1 = __builtin_amdgcn_mfma_f32_16x16x4f32(a_, q[2 * k_ + 1], acc1, 0, 0, 0); } } while (0)
        P5A_LOADQ(q0, 0); P5A_LOADQ(q1, 1); P5A_LOADQ(q2, 2);
        __builtin_amdgcn_sched_barrier(0);
#pragma unroll
        for (int rr = 0; rr < 2; ++rr) { const int r = 2 * F.wave + rr; const size_t m = (size_t)(m0 + r);
#pragma unroll
            for (int j = 0; j < 8; ++j) { const f32x4 u = *(const LAS f32x4*)(Hs + r * HP + 4 * F.lane + 256 * j);
                *(f32x4*)(Hfo + m * D + 4 * F.lane + 256 * j) = u; u32x2 w; w.x = pk2(u.x, u.y); w.y = pk2(u.z, u.w); *(u32x2*)(Hb + m * D + 4 * F.lane + 256 * j) = w;
                if ((j & 1) == 1) __builtin_amdgcn_sched_barrier(0); } }
        P5A_LBAR();
        f32x4 acc0 = {0.f, 0.f, 0.f, 0.f}, acc1 = {0.f, 0.f, 0.f, 0.f};
        { const LAS float* ap = Hs + c * HP + 256 * F.wave + g;
          P5A_MFMAQ(q0, 0); __builtin_amdgcn_sched_barrier(0);
          P5A_LOADQ(q0, 3); __builtin_amdgcn_sched_barrier(0);
          P5A_MFMAQ(q1, 1); __builtin_amdgcn_sched_barrier(0);
          P5A_MFMAQ(q2, 2); __builtin_amdgcn_sched_barrier(0);
          P5A_MFMAQ(q0, 3); }
#undef P5A_LOADQ
#undef P5A_MFMAQ
        P5A_LBAR();
#pragma unroll
        for (int rg = 0; rg < 4; ++rg) { Ps[(F.wave * 16 + g * 4 + rg) * 32 + c] = acc0[rg]; Ps[(F.wave * 16 + g * 4 + rg) * 32 + 16 + c] = acc1[rg]; }
        P5A_LBAR();
        { const int row = F.tid >> 5, e = F.tid & 31; float logit = 0.f;
#pragma unroll
          for (int w = 0; w < 8; ++w) logit += Ps[(w * 16 + row) * 32 + e];
          const float aff = 1.f / (1.f + __expf(-logit)); sel_s[row * 32 + e] = aff + A->in[I_RB][e]; aff_s[row * 32 + e] = aff; }
        P5A_LBAR();
        __builtin_amdgcn_sched_barrier(0);
        if (it + F.G < NTOK / 16) P5A_LOAD(it + F.G);
        if (F.tid < 16) { const int row = F.tid, m = m0 + row; const LAS float* ss = sel_s + row * 32;
            int bg = 0; float bs = -3.0e38f;
#pragma unroll
            for (int gi = 0; gi < 8; ++gi) { const f32x4 s4 = *(const LAS f32x4*)(ss + 4 * gi);
                const float h1 = fmaxf(s4.x, s4.y), l1 = fminf(s4.x, s4.y), h2 = fmaxf(s4.z, s4.w), l2 = fminf(s4.z, s4.w);
                const float sc = fmaxf(h1, h2) + fmaxf(fminf(h1, h2), fmaxf(l1, l2)); if (sc > bs) { bs = sc; bg = gi; } }
            float sv[4]; { const f32x4 s4 = *(const LAS f32x4*)(ss + 4 * bg); sv[0] = s4.x; sv[1] = s4.y; sv[2] = s4.z; sv[3] = s4.w; }
            int i0 = 0; float b0 = sv[0];
#pragma unroll
            for (int i = 1; i < 4; ++i) if (sv[i] > b0) { b0 = sv[i]; i0 = i; }
            int i1 = -1; float b1 = -3.0e38f;
#pragma unroll
            for (int i = 0; i < 4; ++i) if (i != i0 && sv[i] > b1) { b1 = sv[i]; i1 = i; }
            const int e0 = 4 * bg + i0, e1 = 4 * bg + i1; const float w0 = aff_s[row * 32 + e0], w1 = aff_s[row * 32 + e1], ws = w0 + w1;
            LAS int* pk = (LAS int*)(aff_s + 512); pk[2 * row] = e0; pk[2 * row + 1] = e1;
            asm volatile("s_waitcnt lgkmcnt(0)" ::: "memory");
            int r0 = 0, r1 = 0;
#pragma unroll
            for (int q = 0; q < 16; ++q) { const int a = pk[2 * q], b = pk[2 * q + 1]; if (q < row) { r0 += (a == e0) + (b == e0); r1 += (a == e1) + (b == e1); } }
            EID[2 * m] = e0; EID[2 * m + 1] = e1; WTS[2 * m] = w0 / ws; WTS[2 * m + 1] = w1 / ws; DST[2 * m] = r0; DST[2 * m + 1] = r1; }
        if (F.tid < 32) { const LAS int* pk = (const LAS int*)(aff_s + 512); int cn = 0;
            asm volatile("s_waitcnt lgkmcnt(0)" ::: "memory");
#pragma unroll
            for (int q = 0; q < 32; ++q) cn += (pk[q] == F.tid);
            ((int*)(F.ws + WS_CNT))[((size_t)(l * 2 + (dummy ? 1 : 0)) * (NTOK / 16) + it) * NEXP + F.tid] = cn; }
    }
#undef P5A_LOAD
    __syncthreads();
}
#undef P5A_LBAR
__device__ __forceinline__ int moe_tables(Frame& F, int l, LAS int* tt, LAS int* pstart, const LAS int* lcnt = nullptr) {
    if (F.tid < 64) {
        const int e = F.lane & 31;
        const int cnt = lcnt ? lcnt[e] : (int)__hip_atomic_load((unsigned*)(F.ctl + CW_ECNT + 64 * l + e), RLX_AGENT);
        const int nt = (cnt + 255) >> 8; int inc = nt;
#pragma unroll
        for (int d = 1; d < 32; d <<= 1) { const int t = __shfl_up(inc, d, 64); if (e >= d) inc += t; }
        const int excl = inc - nt;
        if (F.lane < 32) { pstart[e] = excl << 8;
#pragma nounroll
            for (int q = 0; q < nt; ++q) tt[excl + q] = e;
            if (e == NEXP - 1) pstart[NEXP] = inc; }
    }
    __syncthreads();
    return __builtin_amdgcn_readfirstlane(pstart[NEXP]);
}
__device__ __forceinline__ void p5b_scatter(Frame& F, int l, bool dummy) {
    LAS int* tt = (LAS int*)(F.lds); LAS int* pstart = tt + 128;
    constexpr int NIT = NTOK / 16, SEGI = (NIT + 15) / 16;
    LAS int* T = (LAS int*)(F.lds + 1024); LAS int* segs = T + NIT * NEXP; LAS int* tot = segs + 16 * NEXP;
    { const int* CNT = (const int*)(F.ws + WS_CNT) + (size_t)(l * 2) * NIT * NEXP;
      { constexpr int NV = NIT * NEXP / 4; typedef int i32x4c __attribute__((ext_vector_type(4))); i32x4c cv[(NV + NWAVES * 64 - 1) / (NWAVES * 64)];
#pragma unroll
        for (int q = 0; q < (NV + NWAVES * 64 - 1) / (NWAVES * 64); ++q) { const int i4 = F.tid + NWAVES * 64 * q; cv[q] = (i4 < NV) ? ((const i32x4c*)CNT)[i4] : (i32x4c){0, 0, 0, 0}; }
#pragma unroll
        for (int q = 0; q < (NV + NWAVES * 64 - 1) / (NWAVES * 64); ++q) { const int i4 = F.tid + NWAVES * 64 * q;
            if (i4 < NV) *(LAS i32x4c*)(T + 4 * i4) = (l == DEPTH - 1 && i4 < NEXP / 4) ? (i32x4c){0, 0, 0, 0} : cv[q]; } }
      __syncthreads();
      const int e = F.tid & 31, sg = F.tid >> 5, lo = sg * SEGI, hi = (lo + SEGI < NIT) ? lo + SEGI : NIT; int sum = 0;
      for (int i = lo; i < hi; ++i) sum += T[i * NEXP + e];
      segs[sg * NEXP + e] = sum;
      __syncthreads();
      int run = 0;
      for (int q = 0; q < sg; ++q) run += segs[q * NEXP + e];
      for (int i = lo; i < hi; ++i) { const int c = T[i * NEXP + e]; T[i * NEXP + e] = run; run += c; }
      if (sg == 15) { tot[e] = run; if (F.vcu == 0 && !dummy) __hip_atomic_store((unsigned*)(F.ctl + CW_ECNT + 64 * l + e), (unsigned)run, RLX_AGENT); }
      __syncthreads(); }
    (void)moe_tables(F, l, tt, pstart, tot);
    const bf16* Hb = (const bf16*)(F.ws + WS_HB); bf16* XR = (bf16*)(F.ws + (dummy ? WS_Y : WS_XR)); const int* EID = (const int*)(F.ws + WS_EID); const int* DST = (const int*)(F.ws + WS_DST); int* DSTo = (int*)(F.ws + (dummy ? WS_OPART : WS_DST));
    const int gw = F.vcu * NWAVES + F.wave, NGW = F.G * NWAVES;
    { int m = (l == DEPTH - 1 && gw < NMETA) ? gw + NGW : gw;
      if (m < NTOK) {
        u32x4 v[4]; int e0 = EID[2 * m], e1 = EID[2 * m + 1], s0 = DST[2 * m], s1 = DST[2 * m + 1];
#pragma unroll
        for (int j = 0; j < 4; ++j) v[j] = *(const u32x4*)(Hb + (size_t)m * D + 8 * F.lane + 512 * j);
        for (;;) {
            const int mn = m + NGW; const bool more = mn < NTOK; const int mc = more ? mn : m;
            u32x4 vn[4]; const int ne0 = EID[2 * mc], ne1 = EID[2 * mc + 1], ns0 = DST[2 * mc], ns1 = DST[2 * mc + 1];
#pragma unroll
            for (int j = 0; j < 4; ++j) vn[j] = *(const u32x4*)(Hb + (size_t)mc * D + 8 * F.lane + 512 * j);
            const int d0 = pstart[e0] + T[(m >> 4) * NEXP + e0] + s0, d1 = pstart[e1] + T[(m >> 4) * NEXP + e1] + s1;
#pragma unroll
            for (int j = 0; j < 4; ++j) { *(u32x4*)(XR + (size_t)d0 * D + 8 * F.lane + 512 * j) = v[j]; *(u32x4*)(XR + (size_t)d1 * D + 8 * F.lane + 512 * j) = v[j]; }
            if (F.lane == 0) { DSTo[2 * m] = d0; DSTo[2 * m + 1] = d1; }
            if (!more) break;
            m = mn; e0 = ne0; e1 = ne1; s0 = ns0; s1 = ns1;
#pragma unroll
            for (int j = 0; j < 4; ++j) v[j] = vn[j];
        } } }
    __syncthreads();
}
__device__ __forceinline__ void p8_ln2(Frame& F, KArgs A, int l, bool dummy) {
    const float* Hf = (const float*)(F.ws + WS_HF); float* Hfo = (float*)(F.ws + (dummy ? WS_MXF : WS_HF)); bf16* Hb = (bf16*)(F.ws + (dummy ? WS_OPART : WS_HB)); const bf16* Y = (const bf16*)(F.ws + WS_Y);
    const float* WTS = (const float*)(F.ws + WS_WTS); const int* DST = (const int*)(F.ws + WS_DST);
    const int gw = F.vcu * NWAVES + F.wave, NGW = F.G * NWAVES;
    f32x4 gg[8], bb[8];
    { const float* g = A->in[I_LN2G] + l * D; const float* b = A->in[I_LN2B] + l * D;
#pragma unroll
      for (int j = 0; j < 8; ++j) { gg[j] = *(const f32x4*)(g + 4 * F.lane + 256 * j); bb[j] = *(const f32x4*)(b + 4 * F.lane + 256 * j); } }
    int m = (l == DEPTH - 1 && gw < NMETA) ? gw + NGW : gw;
    if (m >= NTOK) return;
    u32x2 y0[8], y1[8]; f32x4 hf[8];
    int d0 = DST[2 * m], d1 = DST[2 * m + 1]; float w0 = WTS[2 * m], w1 = WTS[2 * m + 1];
#define P8_LOAD(mm, da, db) do { _Pragma("unroll") for (int j = 0; j < 8; ++j) { y0[j] = *(const u32x2*)(Y + (size_t)(da) * D + 4 * F.lane + 256 * j); y1[j] = *(const u32x2*)(Y + (size_t)(db) * D + 4 * F.lane + 256 * j); \
        hf[j] = *(const f32x4*)(Hf + (size_t)(mm) * D + 4 * F.lane + 256 * j); } } while (0)
    P8_LOAD(m, d0, d1);
    int mn = m + NGW; int nd0 = 0, nd1 = 0; float nw0 = 0.f, nw1 = 0.f;
    if (mn < NTOK) { nd0 = DST[2 * mn]; nd1 = DST[2 * mn + 1]; nw0 = WTS[2 * mn]; nw1 = WTS[2 * mn + 1]; }
    for (;;) {
        f32x4 v[8];
#pragma unroll
        for (int j = 0; j < 8; ++j) { const f32x4 a = (f32x4){bflo(y0[j].x), bfhi(y0[j].x), bflo(y0[j].y), bfhi(y0[j].y)}, b = (f32x4){bflo(y1[j].x), bfhi(y1[j].x), bflo(y1[j].y), bfhi(y1[j].y)};
            v[j] = hf[j] * ALPHA + (a * w0 + b * w1); }
        const bool more = mn < NTOK;
        const int mc = more ? mn : m;
        { const int da = more ? nd0 : d0, db = more ? nd1 : d1; P8_LOAD(mc, da, db); }
        const int mnn = mn + NGW; const int mi = (mnn < NTOK) ? mnn : m;
        const int xd0 = DST[2 * mi], xd1 = DST[2 * mi + 1]; const float xw0 = WTS[2 * mi], xw1 = WTS[2 * mi + 1];
        ln_row_pre(v, gg, bb);
        if (l == DEPTH - 1) store_row(v, (dummy ? Hfo : F.out) + (size_t)(m - NMETA) * D, nullptr, F.lane);
        else store_row(v, Hfo + (size_t)m * D, Hb + (size_t)m * D, F.lane, dummy ? nullptr : (unsigned char*)(F.ws + WS_HQ + (size_t)m * D));
        if (!more) break;
        m = mn; d0 = nd0; d1 = nd1; w0 = nw0; w1 = nw1; mn = mnn; nd0 = xd0; nd1 = xd1; nw0 = xw0; nw1 = xw1;
    }
#undef P8_LOAD
}

constexpr int PH_PER_LAYER = 10, N_PHASES = 1 + DEPTH * PH_PER_LAYER;
__global__ void __launch_bounds__(NWAVES * 64, 2) mk_fwd(Args args) {
    extern __shared__ __attribute__((aligned(16))) unsigned char lds[];
    Frame F;
    F.lds = (LAS unsigned char*)lds; F.MISC = (volatile LAS unsigned*)(F.lds + MISC_OFF);
    F.tid = threadIdx.x; F.lane = F.tid & 63; F.wave = __builtin_amdgcn_readfirstlane(F.tid >> 6);
    F.G = gridDim.x; { const int bx = blockIdx.x; F.vcu = (F.G % 8 == 0) ? (bx % 8) * (F.G / 8) + bx / 8 : bx; }
    F.ws = (GAS unsigned char*)args.ws; F.ctl = (gu32*)(args.ws + WS_CTL); F.out = args.out;
    for (int u = F.tid; u < (LDS_BYTES - LDSCTL_OFF) / 4; u += NWAVES * 64) ((LAS unsigned*)(F.lds + LDSCTL_OFF))[u] = 0u;
    __syncthreads();
    XcdBarrier bar; bar.bar = (unsigned*)(F.ctl + CW_BAR); bar.x = 0; bar.st = nullptr;
    if (!MK_PER_PHASE) bar = xcd_barrier_post((unsigned*)(F.ctl + CW_BAR), F.MISC + 8);
    const int lo = args.ph_lo, hi = args.ph_hi; KArgs KA = kargs();
#define IN(k) (lo <= (k) && (k) < hi)
#define SEAM(k) do { if (IN(k) && IN((k) + 1)) { if (MK_PER_PHASE) { if (F.tid == 0) __hip_atomic_store(F.ctl + CW_TMO, 0xBADBA0u, RLX_AGENT); } else xcd_barrier(bar); } } while (0)

    if ((MK_MASK & 1u) && IN(0)) { p0_prologue(F, KA); if (MK_REPEAT & 1u) p0_prologue(F, KA); } SEAM(0);

#define REFRESH() do { const int t_ = opaque_tid(); F.tid = t_; F.lane = t_ & 63; F.wave = __builtin_amdgcn_readfirstlane(t_ >> 6); \
        KA = kargs(); GAS unsigned char* w_ = (GAS unsigned char*)KA->ws; asm volatile("" : "+s"(w_)); F.ws = w_; F.ctl = (gu32*)(w_ + WS_CTL); } while (0)
#define LAYER_BODY(l) do { \
        const int pb = 1 + l * PH_PER_LAYER; \
        if ((MK_MASK & 2u) && IN(pb + 0)) for (int rep = 0; rep < ((MK_REPEAT & 2u) ? 2 : 1); ++rep) { REFRESH(); \
            { pg8::OrderDenseR S{(const char*)(F.ws + WS_HB), (const char*)(F.ws + WS_WIN) + (size_t)l * NIN_T * D * 2, (size_t)256 * D * 2, (size_t)256 * D * 2, MP / 256, ZC_GZ / 256 + 1, F.G, (int)blockIdx.x, 52}; \
              pg8::EpiZ E{(bf16*)(F.ws + WS_Z), (float*)(F.ws + WS_ZS), 1.f}; \
              pg8::gemm_phase<pg8::EpiZ, pg8::OrderDenseR>(F.lds, pg8::Gemm{D, D, D}, S, E); } \
            REFRESH(); \
            { pg8::OrderDenseQ S{(const char*)(F.ws + WS_HQ), (const char*)(F.ws + WS_WQ) + (size_t)l * 4 * D * D, (size_t)256 * D, (size_t)256 * D, MP / 256, ZC_GZ / 256, \
                                 (unsigned*)(F.ctl + CW_QG1 + 256 * l + 128 * rep), (int)(blockIdx.x & 7), F.MISC + 2}; \
              pg8::EpiZG E{(bf16*)(F.ws + WS_Z), KA->in[I_GATEB] + (size_t)l * 4 * D, 1.f / WQ_SCALE}; \
              pg8::gemm_phase<pg8::EpiZG, pg8::OrderDenseQ, true, true>(F.lds, pg8::Gemm{D / 2, D / 2, D / 2}, S, E); } \
            if (rep == ((MK_REPEAT & 2u) ? 1 : 0)) SEAM(pb + 0); else if (MK_REPBAR) xcd_barrier(bar); \
        } \
        if ((MK_MASK & 4u) && IN(pb + 1)) for (int rep = 0; rep < ((MK_REPEAT & 4u) ? 2 : 1); ++rep) { REFRESH(); \
            constexpr int N0 = 4, N1 = N0 + NCHUNK * 4, N2 = N1 + NCHUNK; \
            for (int it = F.vcu; it < N2; it += F.G) { \
                if (it < N0) p2a_cumsum(F, KA, l, it); \
                else if (it < N1) { const int q = it - N0; gla_stage1(F, KA, l, q >> 2, q & 3); } \
                else norm_item(F, l, it - N1); \
            } \
            if (rep == ((MK_REPEAT & 4u) ? 1 : 0)) SEAM(pb + 1); else if (MK_REPBAR) xcd_barrier(bar); \
        } \
        if ((MK_MASK & 8u) && IN(pb + 2)) for (int rep = 0; rep < ((MK_REPEAT & 8u) ? 2 : 1); ++rep) { REFRESH(); \
            const bf16* Z = (const bf16*)(F.ws + WS_Z); \
            for (bool first_ = true;; first_ = false) { \
                int it = F.vcu;     \
                if (!first_) { if (F.tid == 0) F.MISC[0] = __hip_atomic_fetch_add((unsigned*)(F.ctl + CW_QATT + 64 * l + 16 * rep), 1u, RLX_AGENT); \
                    __syncthreads(); \
                    it = (int)F.MISC[0] + F.G; \
                    __syncthreads(); } \
                constexpr int QA = att_sbase(2); \
                if (it >= SCAN_ITEMS + ATT_NU) break; \
                if (it >= QA && it < QA + SCAN_ITEMS) { gla_scan_item(F, it - QA); continue; } \
                const int u = it < QA ? it : it - SCAN_ITEMS; \
                int qb, s, h; att_decode(u, qb, s, h); \
                const int T = 4 * (qb + 1), jb = T - s * ATT_SEG; int ja = jb - ATT_SEG > 0 ? jb - ATT_SEG : 0; \
                const float* nck = (const float*)(F.ws + WS_C2) + (size_t)h * MP; float* MLp = (float*)(F.ws + WS_ML) + (size_t)u * 256 * 2; \
                { const float q2 = __builtin_bit_cast(float, __hip_atomic_load((unsigned*)(F.ctl + CW_NRM + 64 * l + 2 * h), RLX_AGENT)), k2 = __builtin_bit_cast(float, __hip_atomic_load((unsigned*)(F.ctl + CW_NRM + 64 * l + 2 * h + 1), RLX_AGENT)); \
                  const float thr = nck[qb * 256] - 2.f * LOG2E * 0.08838834764831845f * sqrtf(q2 * k2) - 150.f; \
                  const int jj = ja + F.lane; const bool keep = (jj < jb) && (nck[64 * (jj < jb ? jj : ja) + 63] >= thr); \
                  const unsigned long long bm = __ballot(keep); ja = bm ? ja + (int)__builtin_ctzll(bm) : jb; } \
                if (ja >= jb) { if (F.tid < 256) *(f32x2*)(MLp + 2 * F.tid) = (f32x2){-1e30f, 0.f}; continue; } \
                att::attn_unit(Z + ZC_FQ + h * 128, Z + ZC_FK + h * 128, Z + ZC_FV + h * 128, nck, qb * 256, ja, jb, \
                               (float*)(F.ws + WS_OPART) + (size_t)u * 256 * 128, MLp, F.lds); \
            } \
            REFRESH(); \
            for (bool first_ = true;; first_ = false) { \
                int it = F.vcu; \
                if (!first_) { if (F.tid == 0) F.MISC[0] = __hip_atomic_fetch_add((unsigned*)(F.ctl + CW_QATT + 64 * l + 48 + 8 * rep), 1u, RLX_AGENT); \
                    __syncthreads(); \
                    it = (int)F.MISC[0] + F.G; \
                    __syncthreads(); } \
                if (it >= NCHUNK * 5) break; \
                if (it < NCHUNK) conv_item(F, KA, l, it); else { const int q_ = it - NCHUNK; pool_item(F, KA, l, q_ >> 2, q_ & 3); } \
            } \
            if (rep == ((MK_REPEAT & 8u) ? 1 : 0)) SEAM(pb + 2); else if (MK_REPBAR) xcd_barrier(bar); \
        } \
        if ((MK_MASK & 16u) && IN(pb + 3)) for (int rep = 0; rep < ((MK_REPEAT & 16u) ? 2 : 1); ++rep) { REFRESH(); \
            constexpr int N0 = NCHUNK * 4, N1 = N0 + ATT_NQB * 4; \
            for (bool first_ = true;; first_ = false) { \
                int it = F.vcu; \
                if (!first_) { if (F.tid == 0) F.MISC[0] = __hip_atomic_fetch_add((unsigned*)(F.ctl + CW_QATT + 64 * l + 32 + 8 * rep), 1u, RLX_AGENT); \
                    __syncthreads(); \
                    it = (int)F.MISC[0] + F.G; \
                    __syncthreads(); } \
                if (it >= N1) break; \
                if (it < N0) gla_stage3(F, KA, l, it >> 2, it & 3); \
                else { const int q = it - N0; att_combine(F, q >> 2, q & 3); } \
            } \
            if (rep == ((MK_REPEAT & 16u) ? 1 : 0)) SEAM(pb + 3); else if (MK_REPBAR) xcd_barrier(bar); \
        } \
        if ((MK_MASK & 32u) && IN(pb + 4)) for (int rep = 0; rep < ((MK_REPEAT & 32u) ? 2 : 1); ++rep) { REFRESH(); \
            pg8::OrderDense S{(const char*)(F.ws + WS_OM) + (size_t)NMETA * D * 2, (const char*)(F.ws + WS_WBR) + (size_t)l * D * D * 2, (size_t)256 * D * 2, (size_t)256 * D * 2, SEQ / 256, D / 256, F.G, (int)blockIdx.x}; \
            pg8::EpiMergeSeg E{(const bf16*)(F.ws + WS_Z), KA->in[I_GATEB] + (size_t)l * 4 * D, (bf16*)(F.ws + WS_MX), NMETA}; \
            if (l != DEPTH - 1) p3_meta(F, KA, l);     \
            pg8::gemm_phase<pg8::EpiMergeSeg, pg8::OrderDense>(F.lds, pg8::Gemm{D, D, D}, S, E); \
            if (rep == ((MK_REPEAT & 32u) ? 1 : 0)) SEAM(pb + 4); else if (MK_REPBAR) xcd_barrier(bar); \
        } \
        if ((MK_MASK & 64u) && IN(pb + 5)) for (int rep = 0; rep < ((MK_REPEAT & 64u) ? 2 : 1); ++rep) { REFRESH(); \
            pg8::OrderDense S{(const char*)(F.ws + WS_MX) + (size_t)NMETA * D * 2, (const char*)(F.ws + WS_WOUT) + (size_t)l * D * D * 2, (size_t)256 * D * 2, (size_t)256 * D * 2, SEQ / 256, D / 256, F.G, (int)blockIdx.x}; \
            pg8::EpiBf16 E{(bf16*)(F.ws + WS_MO), D, NMETA}; \
            if (l != DEPTH - 1) p4_meta(F, l); \
            pg8::gemm_phase<pg8::EpiBf16, pg8::OrderDense>(F.lds, pg8::Gemm{D, D, D}, S, E); \
            if (rep == ((MK_REPEAT & 64u) ? 1 : 0)) SEAM(pb + 5); else if (MK_REPBAR) xcd_barrier(bar); \
        } \
        if ((MK_MASK & 128u) && IN(pb + 6)) for (int rep = 0; rep < ((MK_REPEAT & 128u) ? 2 : 1); ++rep) { REFRESH(); p5a_ln_router(F, KA, l, (MK_REPEAT & 128u) && rep == 0); if (rep == ((MK_REPEAT & 128u) ? 1 : 0)) SEAM(pb + 6); else if (MK_REPBAR) xcd_barrier(bar); } \
        if ((MK_MASK & 256u) && IN(pb + 7)) for (int rep = 0; rep < ((MK_REPEAT & 256u) ? 2 : 1); ++rep) { REFRESH(); p5b_scatter(F, l, (MK_REPEAT & 256u) && rep == 0); if (rep == ((MK_REPEAT & 256u) ? 1 : 0)) SEAM(pb + 7); else if (MK_REPBAR) xcd_barrier(bar); } \
        if ((MK_MASK & 512u) && IN(pb + 8)) { REFRESH(); \
            const int ntiles = moe_tables(F, l, (LAS int*)(F.lds + MISC_OFF + 128), (LAS int*)(F.lds + MISC_OFF + 128 + 512)); \
            { pg8::OrderMoeF S{(const char*)(F.ws + WS_XR), KA->in[I_WG] + (size_t)l * NEXP * D * DEXP, KA->in[I_WU] + (size_t)l * NEXP * D * DEXP, 256u * D * 2u, \
                             (const LAS int*)(F.lds + MISC_OFF + 128), ntiles, F.G, F.vcu, true}; \
              pg8::EpiSwiGLU E{(bf16*)(F.ws + WS_HM), (unsigned*)(F.ctl + CW_RDY + 256 * l)}; \
              pg8::gemm_phase_breg<pg8::EpiSwiGLU, pg8::OrderMoeF>(F.lds, pg8::Gemm{D, DEXP, D}, S, E); } \
            REFRESH(); \
            { pg8::OrderMoeDyn S{(const char*)(F.ws + WS_HM), KA->in[I_WD] + (size_t)l * NEXP * D * DEXP, 256u * DEXP * 2u, (const LAS int*)(F.lds + MISC_OFF + 128), ntiles * 8, \
                             (unsigned*)(F.ctl + CW_QMOE + 64 * l), (unsigned*)(F.ctl + CW_RDY + 256 * l), (unsigned*)(F.ctl + CW_BAR) + XB_TMO, F.MISC + 2}; \
              pg8::EpiBf16 E{(bf16*)(F.ws + WS_Y), D, 0}; \
              pg8::gemm_phase_breg<pg8::EpiBf16, pg8::OrderMoeDyn>(F.lds, pg8::Gemm{DEXP, D, DEXP}, S, E); } \
            SEAM(pb + 8); \
        } \
        if ((MK_MASK & 2048u) && IN(pb + 9)) for (int rep = 0; rep < ((MK_REPEAT & 2048u) ? 2 : 1); ++rep) { REFRESH(); p8_ln2(F, KA, l, (MK_REPEAT & 2048u) && rep == 0); if (rep == ((MK_REPEAT & 2048u) ? 1 : 0)) SEAM(pb + 9); else if (MK_REPBAR) xcd_barrier(bar); } \
    } while (0)
    LAYER_BODY(0);
    LAYER_BODY(1);
#undef LAYER_BODY
#undef IN
#undef SEAM
#undef REFRESH
}

extern "C" void kernel_launch(void* const* d_in, const int* in_sizes, int n_in, void* d_out, int out_size, void* d_ws, size_t ws_size, hipStream_t stream) {
    static int grid = 0;
    if (grid == 0) {
        if (n_in != 24 || out_size != SEQ * D || ws_size < WS_END) { fprintf(stderr, "kernel_launch: unexpected shapes (n_in %d, out %d, ws %zu < %zu)\n", n_in, out_size, ws_size, (size_t)WS_END); grid = -1; return; }
        int dev = 0, cus = 0, per_cu = 0;
        if (hipGetDevice(&dev) != hipSuccess || hipDeviceGetAttribute(&cus, hipDeviceAttributeMultiprocessorCount, dev) != hipSuccess) { grid = -1; return; }
        if (hipFuncSetAttribute((const void*)mk_fwd, hipFuncAttributeMaxDynamicSharedMemorySize, LDS_BYTES) != hipSuccess) { fprintf(stderr, "kernel_launch: hipFuncSetAttribute failed\n"); grid = -1; return; }
        if (hipOccupancyMaxActiveBlocksPerMultiprocessor(&per_cu, (const void*)mk_fwd, NWAVES * 64, LDS_BYTES) != hipSuccess || per_cu < 1) { fprintf(stderr, "kernel_launch: occupancy query says %d blocks per CU\n", per_cu); }
        (void)hipGetLastError();
        grid = cus;
    }
    if (grid < 0) return;
    if (hipMemsetAsync((char*)d_ws + WS_CTL, 0, CTL_BYTES, stream) != hipSuccess) return;
    Args a{};
    for (int i = 0; i < 24; ++i) a.in[i] = (const float*)d_in[i];
    a.out = (float*)d_out; a.ws = (unsigned char*)d_ws;
#if MK_PER_PHASE
    for (int p = 0; p < N_PHASES; ++p) { a.ph_lo = p; a.ph_hi = p + 1; hipLaunchKernelGGL(mk_fwd, dim3(grid), dim3(NWAVES * 64), LDS_BYTES, stream, a); }
#else
    a.ph_lo = 0; a.ph_hi = N_PHASES;
    hipLaunchKernelGGL(mk_fwd, dim3(grid), dim3(NWAVES * 64), LDS_BYTES, stream, a);
#endif
}
```

```cpp
#include <hip/hip_runtime.h>
#include <cstdio>
#include <cstdint>

#ifndef MK_PER_PHASE
#define MK_PER_PHASE 0
#endif
#ifndef MK_REPEAT
#define MK_REPEAT 0u
#endif
#ifndef MK_REPBAR
#define MK_REPBAR 0
#endif
#ifndef MK_MASK
#define MK_MASK 0xFFFu
#endif

#define GAS __attribute__((address_space(1)))
#define LAS __attribute__((address_space(3)))
typedef unsigned short bf16;
typedef unsigned short bf16_t;
typedef short bf16x8 __attribute__((ext_vector_type(8)));
typedef short s16x4 __attribute__((ext_vector_type(4)));
typedef float f32x4 __attribute__((ext_vector_type(4)));
typedef float f32x2 __attribute__((ext_vector_type(2)));
typedef float f32x16 __attribute__((ext_vector_type(16)));
typedef unsigned u32x4 __attribute__((ext_vector_type(4)));
typedef unsigned u32x2 __attribute__((ext_vector_type(2)));
typedef GAS unsigned gu32;
#define RLX_AGENT __ATOMIC_RELAXED, __HIP_MEMORY_SCOPE_AGENT
#define LDS_WAIT() asm volatile("s_waitcnt lgkmcnt(0)" ::: "memory")
#define VM_WAIT() asm volatile("s_waitcnt vmcnt(0)" ::: "memory")
#define SBAR() __builtin_amdgcn_sched_barrier(0)

constexpr int D = 2048, SEQ = 8192, NMETA = 16, NTOK = SEQ + NMETA  , MP = 8448  , DEPTH = 2;
constexpr int MIXW = 512, P_IN = 13332, NIN_T = 13568  , ZP = 13312  ;
constexpr int NEXP = 32, DEXP = 1024, NROWS_MAX = 24576;
constexpr float LN_EPS = 1e-5f, ALPHA = 1.41421356237309515f, LOG2E = 1.4426950408889634f, LN2 = 0.6931471805599453f;
constexpr int ZC_FQ = 0, ZC_FK = 512, ZC_FV = 1024, ZC_GQ = 1536, ZC_GK = 1792, ZC_GV = 2048, ZC_GR = 2560, ZC_CB = 3072, ZC_CC = 3584, ZC_CV = 4096, ZC_PZ = 4608, ZC_GZ = 5120;
constexpr int NCHUNK = 129, GLA_FRONT = 48;
constexpr int ATT_SEG = 20, ATT_NQB = 33, ATT_MAXNS = 7;
__host__ __device__ constexpr int att_ns(int qb) { return (qb + 5) / 5; }
__host__ __device__ constexpr int att_sbase(int s) { return 4 * (33 * s - 5 * s * (s - 1) / 2); }
constexpr int ATT_NU = att_sbase(ATT_MAXNS);
static_assert(att_ns(32) == ATT_MAXNS && ATT_NU == 504, "attention unit table");
constexpr int SCAN_ITEMS = 64;

constexpr size_t al256(size_t x) { return (x + 255) & ~(size_t)255; }
constexpr size_t WS_CTL = 0, CTL_BYTES = 1u << 20;
constexpr size_t WS_HF = WS_CTL + CTL_BYTES;
constexpr size_t WS_HB = WS_HF + al256((size_t)MP * D * 4);
constexpr size_t WS_Z = WS_HB + al256((size_t)MP * D * 2);
constexpr size_t WS_ZS = WS_Z + al256((size_t)MP * ZP * 2);
constexpr size_t WS_C2 = WS_ZS + al256((size_t)MP * 32 * 4);
constexpr size_t WS_OM = WS_C2 + al256((size_t)4 * MP * 4);
constexpr size_t WS_OPART = WS_OM + al256((size_t)MP * D * 2);
constexpr size_t WS_ML = WS_OPART + al256((size_t)ATT_NU * 256 * 128 * 4);
constexpr size_t WS_UT = WS_ML + al256((size_t)ATT_NU * 256 * 2 * 4);
constexpr size_t WS_DEC = WS_UT + al256((size_t)NCHUNK * 4 * 128 * 64 * 4);
constexpr size_t WS_ST = WS_DEC + al256((size_t)NCHUNK * 4 * 64 * 4);
constexpr size_t WS_MXF = WS_ST + al256((size_t)NCHUNK * 4 * 128 * 64 * 2);
constexpr size_t WS_MX = WS_MXF + al256((size_t)MP * D * 4);
constexpr size_t WS_MO = WS_MX + al256((size_t)MP * D * 2);
constexpr size_t WS_EID = WS_MO + al256((size_t)MP * D * 4);
constexpr size_t WS_WTS = WS_EID + al256((size_t)MP * 2 * 4);
constexpr size_t WS_DST = WS_WTS + al256((size_t)MP * 2 * 4);
constexpr size_t WS_XR = WS_DST + al256((size_t)MP * 2 * 4);
constexpr size_t WS_HM = WS_XR + al256((size_t)NROWS_MAX * D * 2);
constexpr size_t WS_Y = WS_HM + al256((size_t)NROWS_MAX * DEXP * 2);
constexpr size_t WS_WIN = WS_Y + al256((size_t)NROWS_MAX * D * 2);
constexpr size_t WS_WBR = WS_WIN + al256((size_t)DEPTH * NIN_T * D * 2);
constexpr size_t WS_WOUT = WS_WBR + al256((size_t)DEPTH * D * D * 2);
constexpr size_t WS_PW = WS_WOUT + al256((size_t)DEPTH * D * D * 2);
constexpr size_t WS_HQ = WS_PW + al256((size_t)DEPTH * 4 * 128 * 128 * 2);
constexpr size_t WS_WQ = WS_HQ + al256((size_t)MP * D);
constexpr size_t WS_CNT = WS_WQ + al256((size_t)DEPTH * 4 * D * D);
constexpr size_t WS_END = WS_CNT + al256((size_t)DEPTH * 2 * (NTOK / 16) * NEXP * 4);
constexpr float WQ_SCALE = 32.f;
static_assert(WS_END <= 2147483648ull, "workspace map exceeds 4x the largest input tensor");

constexpr int CW_TMO = 0;
constexpr int CW_QATT = 64;
constexpr int CW_ECNT = 256;
constexpr int CW_NRM = 1024;
constexpr int CW_BAR = 4096;
constexpr int CW_RDY = 8192;
constexpr int CW_QG1 = 10240;
constexpr int CW_QMOE = 9216;

constexpr int LDS_BYTES = 147456, LDSCTL_OFF = LDS_BYTES - 1024, MISC_OFF = LDSCTL_OFF;
constexpr int NWAVES = 8;

__device__ __forceinline__ int opaque_tid() { int t = threadIdx.x; asm volatile("" : "+v"(t)); return t; }
__device__ __forceinline__ unsigned f2bf(float f) { unsigned u = __builtin_bit_cast(unsigned, f); return (u + 0x7fffu + ((u >> 16) & 1u)) >> 16; }
__device__ __forceinline__ unsigned pk2(float lo, float hi) { return f2bf(lo) | (f2bf(hi) << 16); }
__device__ __forceinline__ unsigned pk4_fp8(float a, float b, float c, float d) {
    a = fminf(fmaxf(a, -448.f), 448.f); b = fminf(fmaxf(b, -448.f), 448.f); c = fminf(fmaxf(c, -448.f), 448.f); d = fminf(fmaxf(d, -448.f), 448.f);
    int w = 0; w = __builtin_amdgcn_cvt_pk_fp8_f32(a, b, w, false); w = __builtin_amdgcn_cvt_pk_fp8_f32(c, d, w, true); return (unsigned)w; }
__device__ __forceinline__ float bf2f(unsigned short b) { return __builtin_bit_cast(float, ((unsigned)b) << 16); }
__device__ __forceinline__ float bflo(unsigned w) { return __builtin_bit_cast(float, w << 16); }
__device__ __forceinline__ float bfhi(unsigned w) { return __builtin_bit_cast(float, w & 0xffff0000u); }
__device__ __forceinline__ unsigned cvt_pk_bf16(float lo, float hi) { unsigned r; asm volatile("v_cvt_pk_bf16_f32 %0, %1, %2" : "=v"(r) : "v"(lo), "v"(hi)); return r; }
__device__ __forceinline__ float wave_sum(float v) {
#pragma unroll
    for (int o = 1; o < 64; o <<= 1) v += __shfl_xor(v, o);
    return v;
}
__device__ __forceinline__ float sigmoidf_fast(float x) { return __builtin_amdgcn_rcpf(1.0f + __builtin_amdgcn_exp2f(-x * LOG2E)); }
__device__ __forceinline__ float log_sigmoidf(float x) { return fminf(x, 0.f) - LN2 * __builtin_amdgcn_logf(1.f + __builtin_amdgcn_exp2f(-LOG2E * fabsf(x))); }

namespace pg8 {
constexpr int BM = 256, BK = 64, HALF = 128, HTB = HALF * BK * 2, STAGE_BYTES = 8 * HTB, NXCD = 8, WGM = 8;
__host__ __device__ __forceinline__ int lds_byte(int r, int c) { const int st = (r >> 4) * 2 + (c >> 5), rr = r & 15, cc = c & 31, ob = rr * 64 + cc * 2; return st * 1024 + (ob ^ (((ob >> 9) & 1) << 5)); }
__host__ __device__ __forceinline__ void stage_rc(int b, int& R, int& C) { const int st = b / 1024, sb = b % 1024, swz = sb ^ (((sb >> 9) & 1) << 5); R = (st >> 1) * 16 + swz / 64; C = (st & 1) * 32 + (swz % 64) / 2; }
__host__ __device__ __forceinline__ int perm32(int rho) { const int n = rho >> 4, i = rho & 15; return 8 * (i >> 2) + 4 * n + (i & 3); }

struct Unit { const char* A; const char* B; int pm, pn, aux, aux2; };
struct Gemm { int lda, ldb, K; };

__device__ __forceinline__ void tile_of(int L, int nM, int nN, int& pm, int& pn) {
    const int nwg = nM * nN; int wgid = L; { const int q = nwg / NXCD, r = nwg % NXCD, xcd = wgid % NXCD, off = wgid / NXCD; wgid = (xcd < r ? xcd * (q + 1) : r * (q + 1) + (xcd - r) * q) + off; }
    const int nig = WGM * nN, gid = wgid / nig, fm = gid * WGM, gsz = (nM - fm) < WGM ? (nM - fm) : WGM;
    pm = fm + ((wgid % nig) % gsz); pn = (wgid % nig) / gsz;
}

__device__ __forceinline__ void ho_arrive(unsigned* cnt);
typedef int i32x8 __attribute__((ext_vector_type(8))); typedef int i32x4v __attribute__((ext_vector_type(4)));
__device__ __forceinline__ i32x8 cat8(bf16x8 a, bf16x8 b) { const i32x4v x = __builtin_bit_cast(i32x4v, a), y = __builtin_bit_cast(i32x4v, b); return __builtin_shufflevector(x, y, 0, 1, 2, 3, 4, 5, 6, 7); }
template <bool F8> struct FragSel { typedef bf16x8 T; };
template <> struct FragSel<true> { typedef i32x8 T; };
template <class T> __device__ __forceinline__ T frag_one(bf16x8 a);
template <> __device__ __forceinline__ bf16x8 frag_one<bf16x8>(bf16x8 a) { return a; }
template <> __device__ __forceinline__ i32x8 frag_one<i32x8>(bf16x8 a) { return cat8(a, a); }
template <class T> __device__ __forceinline__ T frag_cat(bf16x8 a, bf16x8 b);
template <> __device__ __forceinline__ bf16x8 frag_cat<bf16x8>(bf16x8 a, bf16x8) { return a; }
template <> __device__ __forceinline__ i32x8 frag_cat<i32x8>(bf16x8 a, bf16x8 b) { return cat8(a, b); }
__device__ __forceinline__ f32x4 frag_mma(bf16x8 b, bf16x8 a, f32x4 c) { return __builtin_amdgcn_mfma_f32_16x16x32_bf16(b, a, c, 0, 0, 0); }
__device__ __forceinline__ f32x4 frag_mma(i32x8 b, i32x8 a, f32x4 c) {
    asm volatile("v_mfma_f32_16x16x128_f8f6f4 %0, %1, %2, %0" : "+v"(c) : "v"(b), "v"(a)); return c; }
template <class Epi, class Sched, bool ALIGN_EPI = true, bool F8 = false>
__device__ __forceinline__ void gemm_phase(LAS unsigned char* lds, const Gemm g, const Sched& S, const Epi& E) {
    const int tid = opaque_tid(), wid = __builtin_amdgcn_readfirstlane(tid >> 6), lane = tid & 63, wr = wid >> 2, wc = wid & 3, fr = lane & 15, fq = lane >> 4;
    using FragT = typename FragSel<F8>::T; constexpr int NKF = F8 ? 1 : 2;
    const int K = g.K, nt = K / BK;
    unsigned voffA[2], voffB[2];
#pragma unroll
    for (int i = 0; i < 2; ++i) { int R, C; stage_rc(tid * 16 + i * 8192, R, C); const int Rb = Epi::PERM ? ((R & ~31) + perm32(R & 31)) : R;
        voffA[i] = (unsigned)(R * g.lda + C) * 2u; voffB[i] = (unsigned)(Rb * g.ldb + C) * 2u; }
    const size_t kstep = (size_t)(BK * 2);
    const size_t hstepA = (size_t)HALF * g.lda * 2, hstepB = (size_t)HALF * g.ldb * 2;
    const unsigned ldsw = (unsigned)wid * 1024u;
    const int aoff = F8 ? lds_byte(wr * 64 + fr, (fq >> 1) * 32 + (fq & 1) * 16) : lds_byte(wr * 64 + fr, fq * 8), boff = F8 ? lds_byte(wc * 32 + fr, (fq >> 1) * 32 + (fq & 1) * 16) : lds_byte(wc * 32 + fr, fq * 8);
#define PG8_SA(b, h) (((b) * 2 + (h)) * HTB)
#define PG8_SB(b, h) ((4 + (b) * 2 + (h)) * HTB)
#define PG8_STAGE(bufoff, gbase, voff) do { _Pragma("unroll") for (int _i = 0; _i < 2; ++_i) \
        __builtin_amdgcn_global_load_lds((const unsigned*)((const char*)(gbase) + (voff)[_i]), (LAS unsigned*)(lds + (bufoff) + ldsw + _i * 8192), 16, 0, 0); } while (0)
#define PG8_LD1(dst, base) do { _Pragma("unroll") for (int k = 0; k < NKF; ++k) dst[k] = *(const LAS FragT*)(lds + (base) + k * 1024); } while (0)
#define PG8_LDA(dst, b, h) do { _Pragma("unroll") for (int m = 0; m < 4; ++m) PG8_LD1(dst[m], PG8_SA(b, h) + aoff + m * 2048); } while (0)
#define PG8_LDB(dst, b, h) do { _Pragma("unroll") for (int n = 0; n < 2; ++n) PG8_LD1(dst[n], PG8_SB(b, h) + boff + n * 2048); } while (0)
#define PG8_MMA(ai, bj, At, Bt) do { __builtin_amdgcn_s_setprio(1); _Pragma("unroll") for (int m = 0; m < 4; ++m) _Pragma("unroll") for (int n = 0; n < 2; ++n) { \
        _Pragma("unroll") for (int k = 0; k < NKF; ++k) acc[ai][bj][m][n] = frag_mma(Bt[n][k], At[m][k], acc[ai][bj][m][n]); } \
        __builtin_amdgcn_s_setprio(0); } while (0)
#define PG8_WAIT_V(n) asm volatile("s_waitcnt vmcnt(" #n ")" ::: "memory")
#define PG8_WAIT_L(n) asm volatile("s_waitcnt lgkmcnt(" #n ")" ::: "memory")
#define PG8_BAR __builtin_amdgcn_s_barrier()
#define PG8_SCHED __builtin_amdgcn_sched_barrier(0)
    Unit cur, nxt; int ui = 0;
    if (!S.next(0, cur)) return;
    f32x4 acc[2][2][4][2];
#pragma unroll
    for (int a = 0; a < 2; ++a)
#pragma unroll
        for (int b = 0; b < 2; ++b)
#pragma unroll
            for (int m = 0; m < 4; ++m)
#pragma unroll
                for (int n = 0; n < 2; ++n) acc[a][b][m][n] = (f32x4){0.f, 0.f, 0.f, 0.f};
    FragT At[4][NKF], B0[2][NKF], B1[2][NKF];
    const char* cA = cur.A; const char* cB = cur.B;
    PG8_STAGE(PG8_SB(0, 0), cB, voffB); PG8_STAGE(PG8_SB(0, 1), cB + hstepB, voffB); PG8_STAGE(PG8_SA(0, 0), cA, voffA); PG8_STAGE(PG8_SA(0, 1), cA + hstepA, voffA);
    if (wr == 1) PG8_BAR;
    PG8_WAIT_V(2); PG8_BAR;
    PG8_STAGE(PG8_SB(1, 0), cB + kstep, voffB); PG8_STAGE(PG8_SA(1, 0), cA + kstep, voffA); PG8_STAGE(PG8_SB(1, 1), cB + hstepB + kstep, voffB);
    PG8_WAIT_V(6); PG8_BAR;
    for (;;) {
        const bool has_next = S.next(ui + 1, nxt);
        const char* nA = has_next ? nxt.A : cA; const char* nB = has_next ? nxt.B : cB;
        for (int t = 0; t < nt; t += 2) {
            if constexpr (Epi::SEG) { if (t != 0 && (t & 7) == 0) { PG8_SCHED; E.seg(acc, cur, t >> 3, wr, wc, fr, fq); PG8_SCHED; } }
            const bool last = (t == nt - 2);
            const char* a1 = cA + (size_t)(t + 1) * kstep;
            const char* a2 = last ? nA : cA + (size_t)(t + 2) * kstep; const char* b2 = last ? nB : cB + (size_t)(t + 2) * kstep;
            const char* a3 = a2 + kstep; const char* b3 = b2 + kstep;
            PG8_LDB(B0, 0, 0); PG8_LDB(B1, 0, 1); PG8_SCHED; PG8_LDA(At, 0, 0); PG8_STAGE(PG8_SA(1, 1), a1 + hstepA, voffA);
            PG8_WAIT_V(8); PG8_WAIT_L(0); PG8_BAR; PG8_MMA(0, 0, At, B0); PG8_MMA(0, 1, At, B1); PG8_BAR; PG8_SCHED;
            PG8_LDA(At, 0, 1); PG8_STAGE(PG8_SB(0, 0), b2, voffB); PG8_STAGE(PG8_SB(0, 1), b2 + hstepB, voffB); PG8_STAGE(PG8_SA(0, 0), a2, voffA);
            PG8_WAIT_V(8); PG8_WAIT_L(0); PG8_BAR; PG8_MMA(1, 0, At, B0); PG8_MMA(1, 1, At, B1); PG8_BAR; PG8_SCHED;
            PG8_LDB(B0, 1, 0); PG8_LDB(B1, 1, 1); PG8_SCHED; PG8_LDA(At, 1, 0); PG8_STAGE(PG8_SA(0, 1), a2 + hstepA, voffA);
            PG8_WAIT_V(8); PG8_WAIT_L(0); PG8_BAR; PG8_MMA(0, 0, At, B0); PG8_MMA(0, 1, At, B1); PG8_BAR; PG8_SCHED;
            PG8_LDA(At, 1, 1); PG8_STAGE(PG8_SB(1, 0), b3, voffB); PG8_STAGE(PG8_SB(1, 1), b3 + hstepB, voffB); PG8_STAGE(PG8_SA(1, 0), a3, voffA);
            PG8_WAIT_V(8); PG8_WAIT_L(0); PG8_BAR; PG8_MMA(1, 0, At, B0); PG8_MMA(1, 1, At, B1); PG8_BAR; PG8_SCHED;
        }
        if constexpr (ALIGN_EPI) { if (wr == 0) PG8_BAR; }
        if constexpr (F8) asm volatile("s_nop 15\n\ts_nop 15" ::: "memory");
        E(acc, cur, wr, wc, fr, fq);
        if (!has_next) break;
#pragma unroll
        for (int a = 0; a < 2; ++a)
#pragma unroll
            for (int b = 0; b < 2; ++b)
#pragma unroll
                for (int m = 0; m < 4; ++m)
#pragma unroll
                    for (int n = 0; n < 2; ++n) acc[a][b][m][n] = (f32x4){0.f, 0.f, 0.f, 0.f};
        cur = nxt; cA = nA; cB = nB; ++ui;
        if constexpr (ALIGN_EPI) { if (wr == 1) PG8_BAR; }
    }
    PG8_WAIT_V(0);
    if constexpr (!ALIGN_EPI) { if (wr == 0) PG8_BAR; }
    PG8_BAR;
#undef PG8_SA
#undef PG8_SB
#undef PG8_STAGE
#undef PG8_LDA
#undef PG8_LD1
#undef PG8_LDB
#undef PG8_MMA
#undef PG8_WAIT_V
#undef PG8_WAIT_L
#undef PG8_BAR
#undef PG8_SCHED
}

struct UnitF { const char* A; const char* B; const char* B2; int pm, pn, aux, aux2; };
template <class Epi, class Sched>
__device__ __forceinline__ void gemm_phase_breg(LAS unsigned char* lds, const Gemm g, const Sched& S, const Epi& E) {
    static_assert(Epi::PERM, "gemm_phase_breg stages B rows in perm32 order");
    const int tid = opaque_tid(), wid = __builtin_amdgcn_readfirstlane(tid >> 6), lane = tid & 63, wr = wid >> 2, wc = wid & 3, fr = lane & 15, fq = lane >> 4;
    const int K = g.K, nt = K / BK;
    unsigned voffA[2];
#pragma unroll
    for (int i = 0; i < 2; ++i) { int R, C; stage_rc(tid * 16 + i * 8192, R, C); voffA[i] = (unsigned)(R * g.lda + C) * 2u; }
    const size_t kstep = (size_t)(BK * 2);
    const size_t hstepA = (size_t)HALF * g.lda * 2;
    const unsigned ldsw = (unsigned)wid * 1024u;
    const int aoff = lds_byte(wr * 64 + fr, fq * 8), boff = lds_byte(wc * 32 + fr, fq * 8);
    const int bh = wid & 1, kg = (wid >> 1) * 2 + (lane >> 5), nn = 4 * (lane & 31);
    const int rho0 = (nn & ~31) + (((nn & 31) >> 2) & 1) * 16 + (((nn & 31) >> 3) << 2);
    const unsigned bdst = (unsigned)(4 * HTB + bh * HTB + lds_byte(rho0, 8 * kg));
    const unsigned browB = (unsigned)g.ldb * 4u;
    const unsigned bthr = (unsigned)(8 * kg) * browB + (unsigned)nn * 4u;
#define PG8_SA(b, h) (((b) * 2 + (h)) * HTB)
#define PG8_SB(b, h) ((4 + (b) * 2 + (h)) * HTB)
#define PG8_STAGE(bufoff, gbase, voff) do { _Pragma("unroll") for (int _i = 0; _i < 2; ++_i) \
        __builtin_amdgcn_global_load_lds((const unsigned*)((const char*)(gbase) + (voff)[_i]), (LAS unsigned*)(lds + (bufoff) + ldsw + _i * 8192), 16, 0, 0); } while (0)
#define PG8_LDA(dst, b, h) do { _Pragma("unroll") for (int m = 0; m < 4; ++m) _Pragma("unroll") for (int k = 0; k < 2; ++k) dst[m][k] = *(const LAS bf16x8*)(lds + PG8_SA(b, h) + aoff + m * 2048 + k * 1024); } while (0)
#define PG8_LDB(dst, b, h) do { _Pragma("unroll") for (int n = 0; n < 2; ++n) _Pragma("unroll") for (int k = 0; k < 2; ++k) dst[n][k] = *(const LAS bf16x8*)(lds + PG8_SB(b, h) + boff + n * 2048 + k * 1024); } while (0)
#define PG8_MMA(ai, bj, At, Bt) do { __builtin_amdgcn_s_setprio(1); _Pragma("unroll") for (int m = 0; m < 4; ++m) _Pragma("unroll") for (int n = 0; n < 2; ++n) _Pragma("unroll") for (int k = 0; k < 2; ++k) \
        acc[ai][bj][m][n] = __builtin_amdgcn_mfma_f32_16x16x32_bf16(Bt[n][k], At[m][k], acc[ai][bj][m][n], 0, 0, 0); __builtin_amdgcn_s_setprio(0); } while (0)
#define PG8_WAIT_V(n) asm volatile("s_waitcnt vmcnt(" #n ")" ::: "memory")
#define PG8_WAIT_L(n) asm volatile("s_waitcnt lgkmcnt(" #n ")" ::: "memory")
#define PG8_BAR __builtin_amdgcn_s_barrier()
#define PG8_SCHED __builtin_amdgcn_sched_barrier(0)
#define PG8_LOADB(tau) do { const int t_ = (tau); const char* p_ = (t_ < nt ? cBt : nBt); const unsigned o_ = bthr + (unsigned)(t_ < nt ? t_ : t_ - nt) * (64u * browB); \
        asm volatile("s_nop 4\n\tglobal_load_dwordx4 %0, %1, %2" : "=v"(breg[0]) : "v"(o_), "s"(p_) : "memory");     \
        _Pragma("unroll") for (int j_ = 1; j_ < 8; ++j_) asm volatile("global_load_dwordx4 %0, %1, %2" : "=v"(breg[j_]) : "v"(o_ + (unsigned)j_ * browB), "s"(p_) : "memory"); } while (0)
#define PG8_WAITB(n) asm volatile("s_waitcnt vmcnt(" #n ")" : "+v"(breg[0]), "+v"(breg[1]), "+v"(breg[2]), "+v"(breg[3]), "+v"(breg[4]), "+v"(breg[5]), "+v"(breg[6]), "+v"(breg[7]) :: "memory")
#define PG8_WRITEB(buf) do { _Pragma("unroll") for (int i_ = 0; i_ < 4; ++i_) { u32x4 w_; \
            w_.x = cvt_pk_bf16(breg[0][i_], breg[1][i_]); w_.y = cvt_pk_bf16(breg[2][i_], breg[3][i_]); w_.z = cvt_pk_bf16(breg[4][i_], breg[5][i_]); w_.w = cvt_pk_bf16(breg[6][i_], breg[7][i_]); \
            *(LAS u32x4*)(lds + bdst + (buf) * (2 * HTB) + 64 * i_) = w_; } } while (0)
    UnitF cur, nxt; int ui = 0;
    if (!S.next(0, cur)) return;
    f32x4 acc[2][2][4][2];
#pragma unroll
    for (int a = 0; a < 2; ++a)
#pragma unroll
        for (int b = 0; b < 2; ++b)
#pragma unroll
            for (int m = 0; m < 4; ++m)
#pragma unroll
                for (int n = 0; n < 2; ++n) acc[a][b][m][n] = (f32x4){0.f, 0.f, 0.f, 0.f};
    bf16x8 At[4][2], B0[2][2], B1[2][2]; f32x4 breg[8];
    const char* cA = cur.A; const char* cBt = bh ? cur.B2 : cur.B; const char* nBt = cBt;
    PG8_LOADB(0); PG8_STAGE(PG8_SA(0, 0), cA, voffA); PG8_STAGE(PG8_SA(0, 1), cA + hstepA, voffA);
    PG8_WAITB(4); PG8_WRITEB(0);
    PG8_LOADB(1);
    PG8_WAITB(0); PG8_WRITEB(1);
    PG8_LOADB(2); PG8_STAGE(PG8_SA(1, 0), cA + kstep, voffA);
    PG8_WAIT_V(10); PG8_WAIT_L(0);
    if (wr == 1) PG8_BAR;
    PG8_BAR;
    for (;;) {
        const bool has_next = S.next(ui + 1, nxt);
        const char* nA = has_next ? nxt.A : cA; nBt = has_next ? (bh ? nxt.B2 : nxt.B) : cBt;
        for (int t = 0; t < nt; t += 2) {
            const bool last = (t == nt - 2);
            const char* a1 = cA + (size_t)(t + 1) * kstep;
            const char* a2 = last ? nA : cA + (size_t)(t + 2) * kstep;
            const char* a3 = a2 + kstep;
            PG8_LDB(B0, 0, 0); PG8_LDB(B1, 0, 1); PG8_SCHED; PG8_LDA(At, 0, 0); PG8_STAGE(PG8_SA(1, 1), a1 + hstepA, voffA);
            PG8_WAIT_V(12); PG8_WAIT_L(0); PG8_BAR; PG8_MMA(0, 0, At, B0); PG8_MMA(0, 1, At, B1); PG8_BAR; PG8_SCHED;
            PG8_LDA(At, 0, 1); PG8_SCHED; PG8_WAITB(4); PG8_WRITEB(0); PG8_SCHED; PG8_LOADB(t + 3); PG8_STAGE(PG8_SA(0, 0), a2, voffA);
            PG8_WAIT_V(12); PG8_WAIT_L(0); PG8_BAR; PG8_MMA(1, 0, At, B0); PG8_MMA(1, 1, At, B1); PG8_BAR; PG8_SCHED;
            PG8_LDB(B0, 1, 0); PG8_LDB(B1, 1, 1); PG8_SCHED; PG8_LDA(At, 1, 0); PG8_STAGE(PG8_SA(0, 1), a2 + hstepA, voffA);
            PG8_WAIT_V(12); PG8_WAIT_L(0); PG8_BAR; PG8_MMA(0, 0, At, B0); PG8_MMA(0, 1, At, B1); PG8_BAR; PG8_SCHED;
            PG8_LDA(At, 1, 1); PG8_SCHED; PG8_WAITB(4); PG8_WRITEB(1); PG8_SCHED; PG8_LOADB(t + 4); PG8_STAGE(PG8_SA(1, 0), a3, voffA);
            PG8_WAIT_V(12); PG8_WAIT_L(0); PG8_BAR; PG8_MMA(1, 0, At, B0); PG8_MMA(1, 1, At, B1); PG8_BAR; PG8_SCHED;
        }
        if (wr == 0) PG8_BAR;
        E(acc, cur, wr, wc, fr, fq);
        if constexpr (Epi::ARRIVE) ho_arrive(E.ready + cur.pm);
        if (!has_next) break;
#pragma unroll
        for (int a = 0; a < 2; ++a)
#pragma unroll
            for (int b = 0; b < 2; ++b)
#pragma unroll
                for (int m = 0; m < 4; ++m)
#pragma unroll
                    for (int n = 0; n < 2; ++n) acc[a][b][m][n] = (f32x4){0.f, 0.f, 0.f, 0.f};
        cur = nxt; cA = nA; cBt = nBt; ++ui;
        if (wr == 1) PG8_BAR;
    }
    PG8_WAITB(0);
    PG8_BAR;
#undef PG8_SA
#undef PG8_SB
#undef PG8_STAGE
#undef PG8_LDA
#undef PG8_LDB
#undef PG8_MMA
#undef PG8_WAIT_V
#undef PG8_WAIT_L
#undef PG8_BAR
#undef PG8_SCHED
#undef PG8_LOADB
#undef PG8_WAITB
#undef PG8_WRITEB
}
}

namespace pg8 {
struct EpiZ {
    static constexpr bool SEG = false; static constexpr bool PERM = true;
    bf16_t* Z; float* Zs; float sc;
    __device__ __forceinline__ void operator()(const f32x4 (&acc)[2][2][4][2], const Unit& u, int wr, int wc, int fr, int fq) const {
        const int row0 = u.pm * BM + wr * 64 + fr;
        if (u.pn == 52) {
            if (wc == 0 && fq < 3) {
#pragma unroll
                for (int ai = 0; ai < 2; ++ai)
#pragma unroll
                    for (int m = 0; m < 4; ++m) { float* rowp = Zs + (size_t)(row0 + ai * HALF + m * 16) * 32 + 8 * fq;
                        *(GAS f32x4*)(rowp) = acc[ai][0][m][0]; if (fq < 2) *(GAS f32x4*)(rowp + 4) = acc[ai][0][m][1]; }
            }
            return;
        }
        const int col0 = u.pn * BM + wc * 32 + 8 * fq;
#pragma unroll
        for (int ai = 0; ai < 2; ++ai)
#pragma unroll
            for (int m = 0; m < 4; ++m) { bf16_t* rowp = Z + (size_t)(row0 + ai * HALF + m * 16) * ZP + col0;
#pragma unroll
                for (int bj = 0; bj < 2; ++bj) { const f32x4 v0 = acc[ai][bj][m][0], v1 = acc[ai][bj][m][1];
                    u32x4 w; w.x = cvt_pk_bf16(v0[0], v0[1]); w.y = cvt_pk_bf16(v0[2], v0[3]); w.z = cvt_pk_bf16(v1[0], v1[1]); w.w = cvt_pk_bf16(v1[2], v1[3]);
                    *(GAS u32x4*)(rowp + bj * HALF) = w; } }
    }
};
struct EpiZG {
    static constexpr bool SEG = false; static constexpr bool PERM = true;
    bf16_t* Z; const float* gb; float sc;
    __device__ __forceinline__ void operator()(const f32x4 (&acc)[2][2][4][2], const Unit& u, int wr, int wc, int fr, int fq) const {
        const int row0 = u.pm * BM + wr * 64 + fr, col0 = u.pn * BM + wc * 32 + 8 * fq; const float* gq = gb + (col0 - ZC_GZ);
        const float k = -sc * LOG2E, TL = 60.f * LOG2E;
        const f32x4 b00 = *(const GAS f32x4*)(gq) * (-LOG2E), b01 = *(const GAS f32x4*)(gq + 4) * (-LOG2E), b10 = *(const GAS f32x4*)(gq + HALF) * (-LOG2E), b11 = *(const GAS f32x4*)(gq + HALF + 4) * (-LOG2E);
#define ZG_E(t) (1.f + __builtin_amdgcn_exp2f(fminf(fmaxf((t), -TL), TL)))
#pragma unroll
        for (int ai = 0; ai < 2; ++ai)
#pragma unroll
            for (int m = 0; m < 4; ++m) { bf16_t* rowp = Z + (size_t)(row0 + ai * HALF + m * 16) * ZP + col0;
#pragma unroll
                for (int bj = 0; bj < 2; ++bj) { const f32x4 t0 = acc[ai][bj][m][0] * k + (bj ? b10 : b00), t1 = acc[ai][bj][m][1] * k + (bj ? b11 : b01);
                    u32x4 w; w.x = cvt_pk_bf16(ZG_E(t0[0]), ZG_E(t0[1])); w.y = cvt_pk_bf16(ZG_E(t0[2]), ZG_E(t0[3]));
                    w.z = cvt_pk_bf16(ZG_E(t1[0]), ZG_E(t1[1])); w.w = cvt_pk_bf16(ZG_E(t1[2]), ZG_E(t1[3]));
                    *(GAS u32x4*)(rowp + bj * HALF) = w; } }
#undef ZG_E
    }
};
struct EpiMerge {
    static constexpr bool SEG = false; static constexpr bool PERM = true;
    const bf16_t* Z; const float* gate_b; float* MXF; bf16_t* MX; int r0;
    __device__ __forceinline__ void operator()(const f32x4 (&acc)[2][2][4][2], const Unit& u, int wr, int wc, int fr, int fq) const {
        const int row0 = r0 + u.pm * BM + wr * 64 + fr, col0 = u.pn * BM + wc * 32 + 8 * fq, b = u.aux;
        const float* gb = gate_b + b * D + col0;
        f32x4 g0[2], g1[2];
#pragma unroll
        for (int bj = 0; bj < 2; ++bj) { g0[bj] = *(const GAS f32x4*)(gb + bj * HALF); g1[bj] = *(const GAS f32x4*)(gb + bj * HALF + 4); }
        u32x4 zw[2][2]; f32x4 old[2][2][2];
#define EM_LOAD(slot, grp) do { const size_t row_ = (size_t)(row0 + ((grp) >> 2) * HALF + ((grp) & 3) * 16); const bf16_t* zp_ = Z + row_ * ZP + ZC_GZ + b * D + col0; const float* fp_ = MXF + row_ * D + col0; \
        _Pragma("unroll") for (int bj = 0; bj < 2; ++bj) { zw[slot][bj] = *(const GAS u32x4*)(zp_ + bj * HALF); \
            if (b != 0) { old[slot][bj][0] = *(const GAS f32x4*)(fp_ + bj * HALF); old[slot][bj][1] = *(const GAS f32x4*)(fp_ + bj * HALF + 4); } } } while (0)
#define EM_DO(slot, grp) do { const int ai = (grp) >> 2, m = (grp) & 3; const size_t row_ = (size_t)(row0 + ai * HALF + m * 16); float* fp_ = MXF + row_ * D + col0; bf16_t* op_ = MX + row_ * D + col0; \
        _Pragma("unroll") for (int bj = 0; bj < 2; ++bj) { const u32x4 z_ = zw[slot][bj]; f32x4 v0, v1; \
            v0[0] = sigmoidf_fast(bflo(z_.x) + g0[bj][0]) * acc[ai][bj][m][0][0]; v0[1] = sigmoidf_fast(bfhi(z_.x) + g0[bj][1]) * acc[ai][bj][m][0][1]; \
            v0[2] = sigmoidf_fast(bflo(z_.y) + g0[bj][2]) * acc[ai][bj][m][0][2]; v0[3] = sigmoidf_fast(bfhi(z_.y) + g0[bj][3]) * acc[ai][bj][m][0][3]; \
            v1[0] = sigmoidf_fast(bflo(z_.z) + g1[bj][0]) * acc[ai][bj][m][1][0]; v1[1] = sigmoidf_fast(bfhi(z_.z) + g1[bj][1]) * acc[ai][bj][m][1][1]; \
            v1[2] = sigmoidf_fast(bflo(z_.w) + g1[bj][2]) * acc[ai][bj][m][1][2]; v1[3] = sigmoidf_fast(bfhi(z_.w) + g1[bj][3]) * acc[ai][bj][m][1][3]; \
            if (b != 0) { v0 += old[slot][bj][0]; v1 += old[slot][bj][1]; } \
            if (b != 3) { *(GAS f32x4*)(fp_ + bj * HALF) = v0; *(GAS f32x4*)(fp_ + bj * HALF + 4) = v1; } \
            else { u32x4 w_; w_.x = cvt_pk_bf16(v0[0], v0[1]); w_.y = cvt_pk_bf16(v0[2], v0[3]); w_.z = cvt_pk_bf16(v1[0], v1[1]); w_.w = cvt_pk_bf16(v1[2], v1[3]); *(GAS u32x4*)(op_ + bj * HALF) = w_; } } } while (0)
        EM_LOAD(0, 0);
        EM_LOAD(1, 1); EM_DO(0, 0);
        EM_LOAD(0, 2); EM_DO(1, 1);
        EM_LOAD(1, 3); EM_DO(0, 2);
        EM_LOAD(0, 4); EM_DO(1, 3);
        EM_LOAD(1, 5); EM_DO(0, 4);
        EM_LOAD(0, 6); EM_DO(1, 5);
        EM_LOAD(1, 7); EM_DO(0, 6);
        EM_DO(1, 7);
#undef EM_LOAD
#undef EM_DO
    }
};
struct EpiMergeSeg {
    static constexpr bool SEG = true; static constexpr bool PERM = true;
    const bf16_t* Z; const float* gate_b; bf16_t* MX; int r0;
    __device__ __forceinline__ void seg(f32x4 (&acc)[2][2][4][2], const Unit& u, int j, int wr, int wc, int fr, int fq) const {
        const int row0 = r0 + u.pm * BM + wr * 64 + fr, col0 = u.pn * BM + wc * 32 + 8 * fq;
        u32x4 zaA[4], zbA[4], zaB[4], zbB[4];
#define SG_R(zA, zB) ((zB) * __builtin_amdgcn_rcpf(zA))
#define SG_LZ(za, zb, bj, ai) do { const unsigned zoff = (unsigned)((row0 * ZP + ZC_GZ + (j - 1) * D + col0 + (bj) * HALF) * 2); _Pragma("unroll") for (int m = 0; m < 4; ++m) { const unsigned zo_ = zoff + (unsigned)(((ai) * HALF + m * 16) * ZP * 2); \
            za[m] = *(const GAS u32x4*)((const char*)Z + zo_); zb[m] = *(const GAS u32x4*)((const char*)Z + zo_ + D * 2); } } while (0)
#define SG_C(za, zb, bj, ai) do { _Pragma("unroll") for (int m = 0; m < 4; ++m) { const u32x4 a_ = za[m], b_ = zb[m]; \
            const f32x4 r0_ = {__builtin_amdgcn_rcpf(bflo(a_.x)), __builtin_amdgcn_rcpf(bfhi(a_.x)), __builtin_amdgcn_rcpf(bflo(a_.y)), __builtin_amdgcn_rcpf(bfhi(a_.y))}, \
                        r1_ = {__builtin_amdgcn_rcpf(bflo(a_.z)), __builtin_amdgcn_rcpf(bfhi(a_.z)), __builtin_amdgcn_rcpf(bflo(a_.w)), __builtin_amdgcn_rcpf(bfhi(a_.w))}, \
                        e0_ = {bflo(b_.x), bfhi(b_.x), bflo(b_.y), bfhi(b_.y)}, e1_ = {bflo(b_.z), bfhi(b_.z), bflo(b_.w), bfhi(b_.w)}; \
            acc[ai][bj][m][0] *= e0_ * r0_; acc[ai][bj][m][1] *= e1_ * r1_; } } while (0)
        SG_LZ(zaA, zbA, 0, 0); SG_LZ(zaB, zbB, 0, 1);
        __builtin_amdgcn_sched_barrier(0);
        SG_C(zaA, zbA, 0, 0);
        __builtin_amdgcn_sched_barrier(0);
        SG_LZ(zaA, zbA, 1, 0);
        __builtin_amdgcn_sched_barrier(0);
        SG_C(zaB, zbB, 0, 1);
        __builtin_amdgcn_sched_barrier(0);
        SG_LZ(zaB, zbB, 1, 1);
        __builtin_amdgcn_sched_barrier(0);
        SG_C(zaA, zbA, 1, 0);
        __builtin_amdgcn_sched_barrier(0);
        SG_C(zaB, zbB, 1, 1);
#undef SG_R
#undef SG_LZ
#undef SG_C
    }
    __device__ __forceinline__ void operator()(const f32x4 (&acc)[2][2][4][2], const Unit& u, int wr, int wc, int fr, int fq) const {
        const int row0 = r0 + u.pm * BM + wr * 64 + fr, col0 = u.pn * BM + wc * 32 + 8 * fq;
#define FG_G(z, k, n) __builtin_amdgcn_rcpf(z)
#pragma unroll
        for (int bj = 0; bj < 2; ++bj) { u32x4 zz[8]; const unsigned zoff = (unsigned)((row0 * ZP + ZC_GZ + 3 * D + col0 + bj * HALF) * 2);
#pragma unroll
            for (int grp = 0; grp < 8; ++grp) zz[grp] = *(const GAS u32x4*)((const char*)Z + zoff + (unsigned)(((grp >> 2) * HALF + (grp & 3) * 16) * ZP * 2));
#pragma unroll
            for (int grp = 0; grp < 8; ++grp) { const int ai = grp >> 2, m = grp & 3; bf16_t* op_ = MX + (size_t)(row0 + ai * HALF + m * 16) * D + col0; const u32x4 z_ = zz[grp]; u32x4 w_;
                w_.x = cvt_pk_bf16(acc[ai][bj][m][0][0] * FG_G(bflo(z_.x), 0, 0), acc[ai][bj][m][0][1] * FG_G(bfhi(z_.x), 1, 0));
                w_.y = cvt_pk_bf16(acc[ai][bj][m][0][2] * FG_G(bflo(z_.y), 2, 0), acc[ai][bj][m][0][3] * FG_G(bfhi(z_.y), 3, 0));
                w_.z = cvt_pk_bf16(acc[ai][bj][m][1][0] * FG_G(bflo(z_.z), 0, 1), acc[ai][bj][m][1][1] * FG_G(bfhi(z_.z), 1, 1));
                w_.w = cvt_pk_bf16(acc[ai][bj][m][1][2] * FG_G(bflo(z_.w), 2, 1), acc[ai][bj][m][1][3] * FG_G(bfhi(z_.w), 3, 1));
                *(GAS u32x4*)(op_ + bj * HALF) = w_; } }
#undef FG_G
#define FG_LOAD(a, b)
#undef FG_LOAD
    }
};
struct EpiF32 {
    static constexpr bool SEG = false; static constexpr bool PERM = false;
    float* C; int ldc; int r0;
    __device__ __forceinline__ void operator()(const f32x4 (&acc)[2][2][4][2], const Unit& u, int wr, int wc, int fr, int fq) const {
        const int row0 = r0 + u.pm * BM + wr * 64 + fr, col0 = u.pn * BM + wc * 32 + 4 * fq;
#pragma unroll
        for (int ai = 0; ai < 2; ++ai)
#pragma unroll
            for (int m = 0; m < 4; ++m) { float* rowp = C + (size_t)(row0 + ai * HALF + m * 16) * ldc + col0;
#pragma unroll
                for (int bj = 0; bj < 2; ++bj)
#pragma unroll
                    for (int n = 0; n < 2; ++n) *(GAS f32x4*)(rowp + bj * HALF + n * 16) = acc[ai][bj][m][n]; }
    }
};
struct EpiSwiGLU {
    static constexpr bool SEG = false; static constexpr bool PERM = true; static constexpr bool ARRIVE = true;
    bf16_t* HM; unsigned* ready;
    template <class U> __device__ __forceinline__ void operator()(const f32x4 (&acc)[2][2][4][2], const U& u, int wr, int wc, int fr, int fq) const {
        const int row0 = u.pm * BM + wr * 64 + fr, col0 = u.pn * HALF + wc * 32 + 8 * fq;
#pragma unroll
        for (int ai = 0; ai < 2; ++ai)
#pragma unroll
            for (int m = 0; m < 4; ++m) { bf16_t* rowp = HM + (size_t)(row0 + ai * HALF + m * 16) * DEXP + col0;
                float h[8];
#pragma unroll
                for (int n = 0; n < 2; ++n)
#pragma unroll
                    for (int j = 0; j < 4; ++j) { const float g = acc[ai][0][m][n][j], up = acc[ai][1][m][n][j]; h[n * 4 + j] = g * sigmoidf_fast(g) * up; }
                u32x4 w; w.x = cvt_pk_bf16(h[0], h[1]); w.y = cvt_pk_bf16(h[2], h[3]); w.z = cvt_pk_bf16(h[4], h[5]); w.w = cvt_pk_bf16(h[6], h[7]);
                *(GAS u32x4*)(rowp) = w; }
    }
};
struct EpiBf16 {
    static constexpr bool SEG = false; static constexpr bool PERM = true; static constexpr bool ARRIVE = false;
    bf16_t* O; int ldc; int r0;
    template <class U> __device__ __forceinline__ void operator()(const f32x4 (&acc)[2][2][4][2], const U& u, int wr, int wc, int fr, int fq) const {
        const int row0 = r0 + u.pm * BM + wr * 64 + fr, col0 = u.pn * BM + wc * 32 + 8 * fq;
#pragma unroll
        for (int ai = 0; ai < 2; ++ai)
#pragma unroll
            for (int m = 0; m < 4; ++m) { bf16_t* rowp = O + (size_t)(row0 + ai * HALF + m * 16) * ldc + col0;
#pragma unroll
                for (int bj = 0; bj < 2; ++bj) { const f32x4 v0 = acc[ai][bj][m][0], v1 = acc[ai][bj][m][1];
                    u32x4 w; w.x = cvt_pk_bf16(v0[0], v0[1]); w.y = cvt_pk_bf16(v0[2], v0[3]); w.z = cvt_pk_bf16(v1[0], v1[1]); w.w = cvt_pk_bf16(v1[2], v1[3]);
                    *(GAS u32x4*)(rowp + bj * HALF) = w; } }
    }
};

struct OrderDense {
    const char* A0; const char* B0; size_t tA, tB; int nM, nN, G, c;
    __device__ __forceinline__ bool next(int i, Unit& u) const {
        const long L = (long)i * G + c; if (L >= (long)nM * nN) return false;
        tile_of((int)L, nM, nN, u.pm, u.pn); u.A = A0 + (size_t)u.pm * tA; u.B = B0 + (size_t)u.pn * tB; u.aux = 0; u.aux2 = 0; return true;
    }
};
struct OrderDenseR {
    const char* A0; const char* B0; size_t tA, tB; int nM, nN, G, c, last_pn;
    __device__ __forceinline__ bool next(int i, Unit& u) const {
        const long L = (long)i * G + c; if (L >= (long)nM * nN) return false;
        tile_of((int)L, nM, nN, u.pm, u.pn); if (u.pn == nN - 1) u.pn = last_pn; u.A = A0 + (size_t)u.pm * tA; u.B = B0 + (size_t)u.pn * tB; u.aux = 0; u.aux2 = 0; return true;
    }
};
struct OrderMerge {
    const char* A0; const char* B0; size_t tA, tB; int nM, nN, G, c;
    __device__ __forceinline__ bool next(int i, Unit& u) const {
        const long L = (long)(i >> 2) * G + c; if (L >= (long)nM * nN) return false;
        const int b = i & 3; tile_of((int)L, nM, nN, u.pm, u.pn);
        u.A = A0 + (size_t)u.pm * tA + (size_t)b * MIXW * 2; u.B = B0 + (size_t)u.pn * tB + (size_t)b * MIXW * 2; u.aux = b; u.aux2 = 0; return true;
    }
};
struct OrderMoe {
    const char* A0; const char* B0; unsigned tA, tB, eB; const LAS int* tt; int ntiles, nN, G, c;
    __device__ __forceinline__ bool next(int i, Unit& u) const {
        const int L = i * G + c; if (L >= ntiles * 8) return false;
        const int j = L >> 3; u.pn = L & 7; u.pm = j; const int e = __builtin_amdgcn_readfirstlane(tt[j]);
        u.A = A0 + (size_t)((unsigned)j * tA); u.B = B0 + ((size_t)e * eB + (size_t)((unsigned)u.pn * tB)); u.aux = e; u.aux2 = 0; return true;
    }
};
struct OrderMoeF {
    const char* A0; const float* W0; const float* W1; unsigned tA; const LAS int* tt; int ntiles, G, c; bool up;
    __device__ __forceinline__ bool next(int i, UnitF& u) const {
        const int L = i * G + c; if (L >= ntiles * 8) return false;
        const int j = L >> 3; u.pn = L & 7; u.pm = j; const int e = __builtin_amdgcn_readfirstlane(tt[j]);
        u.A = A0 + (size_t)((unsigned)j * tA);
        const size_t eo = (size_t)e * D * DEXP;
        if (up) { u.B = (const char*)(W0 + eo + u.pn * 128); u.B2 = (const char*)(W1 + eo + u.pn * 128); } else { u.B = (const char*)(W0 + eo + u.pn * 256); u.B2 = u.B + 512; }
        u.aux = e; u.aux2 = 0; return true;
    }
};
}

namespace att {
constexpr int DH = 128, NW = 8, QBLK = 32, KVBLK = 64, QB = 256;
constexpr int SHM_V = KVBLK * DH * 2, SHM_K = KVBLK * DH * 2;
constexpr int OFF_WS = 2 * SHM_V + 2 * SHM_K, OFF_CK = OFF_WS + NW * 64 * 4, OFF_Q = OFF_CK + 2 * 64 * 4, LDS_ATT = OFF_Q + NW * 8 * 1024;
static_assert(LDS_ATT <= LDSCTL_OFF, "attention LDS");
constexpr float SCALE = 0.08838834764831845f, C2 = 1.4426950408889634f * SCALE, THR2 = 8.f * 1.4426950408889634f;
#define KSWZ(row, colB) ((row) * 256 + ((colB) ^ (((row) & 7) << 4)))
__device__ __forceinline__ int v_st(int k, int c) { const int kk = (k & ~0xC) | ((k & 4) << 1) | ((k & 8) >> 1); return ((kk >> 3) * 4 + (c >> 5)) * 512 + ((kk & 7) * 32 + (c & 31)) * 2; }
__device__ __forceinline__ int v_rd_base(int lane) { return ((lane & 3) << 3) | (((lane >> 2) & 3) << 6) | (((lane >> 4) & 1) << 5) | (((lane >> 5) & 1) << 8); }
constexpr int v_rd_off(int d0, int ks, int half) { return d0 * 512 + ks * 4096 + half * 2048; }
__device__ __forceinline__ int crow(int r, int hi) { return (r & 3) + 8 * (r >> 2) + 4 * hi; }
__device__ __forceinline__ bf16x8 load8(const bf16* p) { return *reinterpret_cast<const bf16x8*>(p); }
__device__ __forceinline__ void mask_tile(f32x16& p0, f32x16& p1, int dq) {
    const float NEG = -__builtin_inff();
#pragma unroll
    for (int r = 0; r < 16; ++r) {
        const int c = (r & 3) + 8 * (r >> 2);
        if (dq - c < 0) p0[r] = NEG;
        if (dq - c - 32 < 0) p1[r] = NEG;
    }
}
__device__ __forceinline__ void bias_tile(f32x16& p0, f32x16& p1, const float* ck, int hi) {
#pragma unroll
    for (int g = 0; g < 4; ++g) { const f32x4 c0 = *(const f32x4*)(ck + 8 * g + 4 * hi), c1 = *(const f32x4*)(ck + 32 + 8 * g + 4 * hi);
#pragma unroll
        for (int j = 0; j < 4; ++j) { p0[4 * g + j] = fmaf(p0[4 * g + j], C2, c0[j]); p1[4 * g + j] = fmaf(p1[4 * g + j], C2, c1[j]); } }
}
__device__ __forceinline__ void partialSM(f32x16& p0, f32x16& p1, float& m_reg, float& mn, float& alpha) {
    float pmax = p0[0]; for (int r = 1; r < 16; ++r) pmax = fmaxf(pmax, p0[r]); for (int r = 0; r < 16; ++r) pmax = fmaxf(pmax, p1[r]);
    { auto rr = __builtin_amdgcn_permlane32_swap(__float_as_uint(pmax), __float_as_uint(pmax), false, false);
      pmax = fmaxf(__uint_as_float(rr[0]), __uint_as_float(rr[1])); }
    if (__builtin_expect(__all((pmax - m_reg) <= THR2), 1)) { mn = m_reg; alpha = 1.f; }
    else { mn = fmaxf(m_reg, pmax); alpha = __builtin_amdgcn_exp2f(m_reg - mn); m_reg = mn; }
    for (int r = 0; r < 16; ++r) p0[r] = p0[r] - mn; for (int r = 0; r < 16; ++r) p1[r] = p1[r] - mn;
    for (int r = 0; r < 16; ++r) p0[r] = __builtin_amdgcn_exp2f(p0[r]);
}
__device__ __forceinline__ void finishSM(f32x16& p0, f32x16& p1, float alpha, float& l_reg, bf16x8& pa0, bf16x8& pa1, bf16x8& pa2, bf16x8& pa3) {
    for (int r = 0; r < 16; ++r) p1[r] = __builtin_amdgcn_exp2f(p1[r]);
    float ps = 0; for (int r = 0; r < 16; ++r) ps += p0[r]; for (int r = 0; r < 16; ++r) ps += p1[r];
    { auto rr = __builtin_amdgcn_permlane32_swap(__float_as_uint(ps), __float_as_uint(ps), false, false);
      ps = __uint_as_float(rr[0]) + __uint_as_float(rr[1]); }
    l_reg = l_reg * alpha + ps;
#define PK4(P, B_, OUT) do { unsigned a0 = cvt_pk_bf16(P[B_+0], P[B_+1]), a1 = cvt_pk_bf16(P[B_+2], P[B_+3]);                          \
        unsigned b0 = cvt_pk_bf16(P[B_+4], P[B_+5]), b1 = cvt_pk_bf16(P[B_+6], P[B_+7]);                                             \
        auto r0 = __builtin_amdgcn_permlane32_swap(a0, b0, false, false); auto r1 = __builtin_amdgcn_permlane32_swap(a1, b1, false, false); \
        u32x4 w = {r0[0], r1[0], r0[1], r1[1]}; OUT = *reinterpret_cast<bf16x8*>(&w); } while (0)
    PK4(p0, 0, pa0); PK4(p0, 8, pa1); PK4(p1, 0, pa2); PK4(p1, 8, pa3);
#undef PK4
}
template <int KB>
__device__ __forceinline__ void qkt(f32x16& p0, f32x16& p1, const char* K_lds, int r32, int hi, const char* qs) {
    p0 = f32x16{}; p1 = f32x16{};
    const char* kb[4];
#pragma unroll
    for (int dd = 0; dd < 4; ++dd) kb[dd] = K_lds + KB * SHM_K + KSWZ(r32, (dd * 16 + hi * 8) * 2);
#pragma unroll
    for (int d0 = 0; d0 < 8; ++d0) { const char* a = kb[d0 & 3] + (d0 >> 2) * 128;
        const bf16x8 q = *reinterpret_cast<const bf16x8*>(qs + d0 * 1024);
        bf16x8 b0 = *reinterpret_cast<const bf16x8*>(a);
        bf16x8 b1 = *reinterpret_cast<const bf16x8*>(a + 32 * 256);
        p0 = __builtin_amdgcn_mfma_f32_32x32x16_bf16(b0, q, p0, 0, 0, 0);
        p1 = __builtin_amdgcn_mfma_f32_32x32x16_bf16(b1, q, p1, 0, 0, 0); }
}
template <int VB>
__device__ __forceinline__ void pv_tile(f32x16* o, int vb0, bf16x8 pa0, bf16x8 pa1, bf16x8 pa2, bf16x8 pa3) {
#define TRRD(dst, off) asm volatile("ds_read_b64_tr_b16 %0, %1 offset:%2" : "=&v"(dst) : "v"(vb0), "i"(off) : "memory")
#define PV_D0(d0) do { s16x4 l0, l1, l2, l3, h0, h1, h2, h3; constexpr int b_ = VB * SHM_V + v_rd_off(d0, 0, 0); \
        TRRD(l0, b_); TRRD(h0, b_ + 2048); TRRD(l1, b_ + 4096); TRRD(h1, b_ + 6144); TRRD(l2, b_ + 8192); TRRD(h2, b_ + 10240); TRRD(l3, b_ + 12288); TRRD(h3, b_ + 14336); \
        asm volatile("s_waitcnt lgkmcnt(0)" ::: "memory"); SBAR();   \
        o[d0] = __builtin_amdgcn_mfma_f32_32x32x16_bf16(pa0, (bf16x8){l0[0], l0[1], l0[2], l0[3], h0[0], h0[1], h0[2], h0[3]}, o[d0], 0, 0, 0);   \
        o[d0] = __builtin_amdgcn_mfma_f32_32x32x16_bf16(pa1, (bf16x8){l1[0], l1[1], l1[2], l1[3], h1[0], h1[1], h1[2], h1[3]}, o[d0], 0, 0, 0);   \
        o[d0] = __builtin_amdgcn_mfma_f32_32x32x16_bf16(pa2, (bf16x8){l2[0], l2[1], l2[2], l2[3], h2[0], h2[1], h2[2], h2[3]}, o[d0], 0, 0, 0);   \
        o[d0] = __builtin_amdgcn_mfma_f32_32x32x16_bf16(pa3, (bf16x8){l3[0], l3[1], l3[2], l3[3], h3[0], h3[1], h3[2], h3[3]}, o[d0], 0, 0, 0); } while (0)
    PV_D0(0); PV_D0(1); PV_D0(2); PV_D0(3);
#undef PV_D0
#undef TRRD
}

__device__ __forceinline__ void attn_unit(const bf16* Qp, const bf16* Kp, const bf16* Vp, const float* nck, int P0, int ja, int jb, float* Op, float* MLp, LAS unsigned char* ldsl) {
    char* lds = (char*)ldsl;
    const int tid = opaque_tid(), wid = __builtin_amdgcn_readfirstlane(tid >> 6), lane = tid & 63, r32 = lane & 31, hi = lane >> 5;
    const int NT = jb - ja;
    const int qlo = P0 + wid * QBLK, qm = qlo + r32 - 4 * hi;
    char* V_lds = lds; char* K_lds = lds + 2 * SHM_V;
    float* ws = (float*)(lds + OFF_WS) + wid * 64; float* al_l = ws + 32;
    float* CK = (float*)(lds + OFF_CK);
    float m_reg = -1e30f, l_reg = 0; f32x16 o[4] = {};
    const int sr = tid >> 4, sc = (tid & 15) * 8, vst0 = v_st(sr, sc), vst1 = v_st(32 + sr, sc), kws = KSWZ(sr, sc * 2);
    const int vb0 = (int)(uintptr_t)V_lds + v_rd_base(lane);
    bf16x8 st_v0, st_v1, st_k0, st_k1; const char* qs = lds + OFF_Q + wid * 8192 + lane * 16;
    const unsigned ro0 = (unsigned)(sr * ZP + sc), ro1 = (unsigned)((32 + sr) * ZP + sc);
#define SLOAD_H(k0) do { const unsigned kz_ = (unsigned)(k0) * (unsigned)ZP; st_v0 = load8(Vp + (kz_ + ro0)); st_v1 = load8(Vp + (kz_ + ro1)); st_k0 = load8(Kp + (kz_ + ro0)); st_k1 = load8(Kp + (kz_ + ro1)); } while (0)
#define SWRITE_HK(bf) do { *(bf16x8*)(K_lds + (bf) * SHM_K + kws) = st_k0; *(bf16x8*)(K_lds + (bf) * SHM_K + kws + 32 * 256) = st_k1; } while (0)
#define CK_DMA(k0, bf) do { if (wid == 0) __builtin_amdgcn_global_load_lds((const unsigned*)(nck + (unsigned)(k0) + (unsigned)lane), (LAS unsigned*)(ldsl + OFF_CK + (bf) * 256), 4, 0, 0); } while (0)
#define SWRITE_HV(bf) do { *(bf16x8*)(V_lds + (bf) * SHM_V + vst0) = st_v0; *(bf16x8*)(V_lds + (bf) * SHM_V + vst1) = st_v1; } while (0)
#define SWRITE_H(bf) do { SWRITE_HV(bf); SWRITE_HK(bf); } while (0)
#define RESC(a) do { if (__any((a) < 1.f)) { if (hi == 0) al_l[r32] = (a); asm volatile("s_waitcnt lgkmcnt(0)" ::: "memory");              \
                     for (int d_ = 0; d_ < 4; ++d_) for (int r = 0; r < 16; ++r) o[d_][r] *= al_l[crow(r, hi)]; } } while (0)
#define KBASE(t) ((ja + (t)) * KVBLK)
#define MASKT(P0_, P1_, t) do { const int kb_ = KBASE(t); if (kb_ + KVBLK - 1 > qlo) mask_tile(P0_, P1_, qm - kb_); } while (0)
#pragma unroll
    for (int d0 = 0; d0 < 8; ++d0) *(bf16x8*)(qs + d0 * 1024) = load8(Qp + (unsigned)((qlo + r32) * ZP + d0 * 16 + hi * 8));
    SLOAD_H(KBASE(0)); CK_DMA(KBASE(0), 0); VM_WAIT(); SWRITE_H(0);
    if (NT > 1) { SLOAD_H(KBASE(1)); CK_DMA(KBASE(1), 1); }
    __syncthreads();
    f32x16 pA0, pA1, pB0, pB1; float mnA, mnB, alA, alB; bf16x8 pa0, pa1, pa2, pa3;
    SBAR(); qkt<0>(pA0, pA1, K_lds, r32, hi, qs);
    MASKT(pA0, pA1, 0); bias_tile(pA0, pA1, CK, hi); partialSM(pA0, pA1, m_reg, mnA, alA);
    if (NT > 1) { VM_WAIT(); SWRITE_H(1); }
    __syncthreads();
#define HALF_STEP(PX0, PX1, mnX, alX, PY0, PY1, alY, t, KB, VB, SB) do {                                                      \
        SBAR(); qkt<KB>(PX0, PX1, K_lds, r32, hi, qs);                                                                        \
        finishSM(PY0, PY1, alY, l_reg, pa0, pa1, pa2, pa3); SBAR();                                                           \
        if ((t) + 1 < NT) { SLOAD_H(KBASE((t) + 1)); CK_DMA(KBASE((t) + 1), SB); SBAR(); }                                                                \
        pv_tile<VB>(o, vb0, pa0, pa1, pa2, pa3); MASKT(PX0, PX1, (t)); bias_tile(PX0, PX1, CK + (KB) * 64, hi); partialSM(PX0, PX1, m_reg, mnX, alX);   \
        __syncthreads();                                                                                                      \
        if ((t) + 1 < NT) { VM_WAIT(); SWRITE_H(SB); }                                                                        \
        RESC(alX); __syncthreads(); } while (0)
    for (int t = 1; t + 1 < NT; t += 2) {
        HALF_STEP(pB0, pB1, mnB, alB, pA0, pA1, alA, t, 1, 0, 0);
        HALF_STEP(pA0, pA1, mnA, alA, pB0, pB1, alB, t + 1, 0, 1, 1);
    }
    const bool even = (NT & 1) == 0;
    if (even) { SBAR(); qkt<1>(pB0, pB1, K_lds, r32, hi, qs); SBAR(); }
    finishSM(pA0, pA1, alA, l_reg, pa0, pa1, pa2, pa3); SBAR();
    pv_tile<0>(o, vb0, pa0, pa1, pa2, pa3);
    if (even) { MASKT(pB0, pB1, NT - 1); bias_tile(pB0, pB1, CK + 64, hi); partialSM(pB0, pB1, m_reg, mnB, alB); __syncthreads(); RESC(alB);
        finishSM(pB0, pB1, alB, l_reg, pa0, pa1, pa2, pa3); SBAR(); pv_tile<1>(o, vb0, pa0, pa1, pa2, pa3); }
    float* Ow = Op + (size_t)(wid * QBLK) * DH;
#pragma unroll
    for (int r = 0; r < 16; ++r) { const int orow = crow(r, hi);
#pragma unroll
        for (int d0 = 0; d0 < 4; ++d0) Ow[(size_t)orow * DH + d0 * 32 + r32] = o[d0][r]; }
    if (hi == 0) { *(f32x2*)(MLp + (size_t)(wid * QBLK + r32) * 2) = (f32x2){m_reg, l_reg}; }
    __syncthreads();
#undef SLOAD_H
#undef SWRITE_HK
#undef CK_DMA
#undef SWRITE_HV
#undef SWRITE_H
#undef RESC
#undef KBASE
#undef MASKT
#undef HALF_STEP
}
}

#define XB_TMO      128
#define XB_XCNT(j)  (256  + 64 * (j))
#define XB_XSUB(j)  (1280 + 64 * (j))
#define XB_XGEN(j)  (2304 + 64 * (j))
#define XB_TOP      3328
#define XB_TOPGEN   3392
#define XCD_BAR_WORDS 3456
#define XB_SPIN_CAP (1u << 18)
__device__ __forceinline__ unsigned xb_ld(unsigned* p)              { return __hip_atomic_load(p, __ATOMIC_RELAXED, __HIP_MEMORY_SCOPE_AGENT); }
__device__ __forceinline__ unsigned xb_add(unsigned* p, unsigned v) { return __hip_atomic_fetch_add(p, v, __ATOMIC_RELAXED, __HIP_MEMORY_SCOPE_AGENT); }
__device__ __forceinline__ unsigned xb_xcc_id() { return (unsigned)__builtin_amdgcn_s_getreg((3 << 11) | 20) & 0xFu; }
#define XB_SPIN(cond, bar) do { unsigned _sp = 0; while (cond) { __builtin_amdgcn_s_sleep(1); \
    if ((++_sp & 255u) == 0u) { if (xb_ld(&(bar)[XB_TMO])) break; if (_sp > XB_SPIN_CAP) { atomicAdd(&(bar)[XB_TMO], 1u); break; } } } } while (0)
struct XcdBarrier { unsigned* bar; unsigned x; volatile LAS unsigned* st; };
__device__ __forceinline__ XcdBarrier xcd_barrier_post(unsigned* bar, volatile LAS unsigned* st) {
    XcdBarrier b; b.bar = bar; b.x = xb_xcc_id(); b.st = st;
    if (threadIdx.x == 0) (void)xb_add(&bar[XB_XCNT(b.x)], 1u);
    return b;
}
__device__ __forceinline__ void xcd_barrier_complete(unsigned* bar, unsigned x, unsigned& nloc, unsigned& nx) {
    const unsigned G = gridDim.x * gridDim.y * gridDim.z;
    unsigned sum, cnt, mine, sp = 0u;
    for (;;) {
        sum = 0u; cnt = 0u; mine = 0u;
#pragma nounroll
        for (unsigned j = 0; j < 16; ++j) { const unsigned c = xb_ld(&bar[XB_XCNT(j)]); sum += c; cnt += (c > 0u) ? 1u : 0u; mine = (j == x) ? c : mine; }
        if (sum == G) break;
        __builtin_amdgcn_s_sleep(1);
        if ((++sp & 255u) == 0u) { if (xb_ld(&bar[XB_TMO])) break; if (sp > XB_SPIN_CAP) { atomicAdd(&bar[XB_TMO], 1u); break; } }
    }
    nloc = mine > 0u ? mine : 1u; nx = cnt > 0u ? cnt : 1u;
}
__device__ __forceinline__ void xcd_barrier(const XcdBarrier& b) {
    asm volatile("s_waitcnt vmcnt(0)" ::: "memory");
    __syncthreads();
    if (threadIdx.x == 0) {
        unsigned* bar = b.bar; asm volatile("" : "+s"(bar));
        __builtin_amdgcn_s_waitcnt(0);
        unsigned nloc = b.st[0], nx = b.st[1];
        if (nloc == 0u) { xcd_barrier_complete(bar, b.x, nloc, nx); b.st[0] = nloc; b.st[1] = nx; }
        const unsigned old = xb_add(&bar[XB_XSUB(b.x)], 1u);
        const unsigned gen = old / nloc;
        if (old + 1u == (gen + 1u) * nloc) {
            __builtin_amdgcn_fence(__ATOMIC_RELEASE, "agent");
            asm volatile("s_waitcnt vmcnt(0)" ::: "memory");
            const unsigned og = xb_add(&bar[XB_TOP], 1u);
            const unsigned tg = og / nx;
            if (og + 1u == (tg + 1u) * nx) xb_add(&bar[XB_TOPGEN], 1u);
            else XB_SPIN(xb_ld(&bar[XB_TOPGEN]) == tg, bar);
            __builtin_amdgcn_fence(__ATOMIC_ACQUIRE, "agent");
            xb_add(&bar[XB_XGEN(b.x)], 1u);
            asm volatile("s_waitcnt vmcnt(0)" ::: "memory");
        } else {
            XB_SPIN(xb_ld(&bar[XB_XGEN(b.x)]) == gen, bar);
            __builtin_amdgcn_fence(__ATOMIC_ACQUIRE, "agent");
            asm volatile("s_waitcnt vmcnt(0)" ::: "memory");
        }
    }
    __syncthreads();
}

namespace pg8 {
__device__ __forceinline__ void ho_arrive(unsigned* cnt) {
    asm volatile("s_waitcnt vmcnt(0) lgkmcnt(0)" ::: "memory");
    __syncthreads();
    if (threadIdx.x == 0) { unsigned* c = cnt; asm volatile("" : "+s"(c));
        __builtin_amdgcn_fence(__ATOMIC_RELEASE, "agent"); asm volatile("s_waitcnt vmcnt(0)" ::: "memory");
        (void)xb_add(c, 1u); }
}
struct OrderDenseQ {
    const char* A0; const char* B0; size_t tA, tB; int nM, pn0; unsigned* q; int x; volatile LAS unsigned* slot;
    __device__ __forceinline__ bool next(int i, Unit& u) const {
        if (threadIdx.x == 0) {
            unsigned* qq = q; asm volatile("" : "+s"(qq));
            unsigned L = 0xFFFFFFFFu;
            if (i == 0) L = (unsigned)x * (unsigned)(4 * nM) + (blockIdx.x >> 3);
            else {
#pragma nounroll
            for (int s_ = 0; s_ < 8; ++s_) { const unsigned xx = (unsigned)(x + s_) & 7u; const unsigned v = xb_add(qq + 16 * xx, 1u) + (gridDim.x + 7u - xx) / 8u; if (v < (unsigned)(4 * nM)) { L = xx * (unsigned)(4 * nM) + v; break; } } }
            slot[i & 1] = L;
            asm volatile("s_waitcnt lgkmcnt(0)" ::: "memory");
        }
        __builtin_amdgcn_s_barrier();
        const unsigned L = (unsigned)__builtin_amdgcn_readfirstlane((int)slot[i & 1]);
        if (L == 0xFFFFFFFFu) return false;
        const unsigned xx = L / (unsigned)(4 * nM), v = L % (unsigned)(4 * nM);
        u.pm = (int)(v >> 2); u.pn = pn0 + 4 * (int)xx + (int)(v & 3u); u.A = A0 + (size_t)u.pm * tA; u.B = B0 + (size_t)(u.pn - pn0) * tB; u.aux = 0; u.aux2 = 0; return true;
    }
};
struct OrderMoeDyn {
    const char* A0; const float* W0; unsigned tA; const LAS int* tt; int nunits; unsigned* q; unsigned* ready; unsigned* tmo; volatile LAS unsigned* slot;
    __device__ __forceinline__ bool next(int i, UnitF& u) const {
        if (threadIdx.x == 0) {
            unsigned* qq = q; asm volatile("" : "+s"(qq));
            const unsigned v = xb_add(qq, 1u);
            if (v < (unsigned)nunits) { unsigned* c = ready + (v >> 3); unsigned sp = 0;
                while (xb_ld(c) < 8u) { __builtin_amdgcn_s_sleep(2); if ((++sp & 255u) == 0u) { if (xb_ld(tmo)) break; if (sp > XB_SPIN_CAP) { atomicAdd(tmo, 1u); break; } } }
                __builtin_amdgcn_fence(__ATOMIC_ACQUIRE, "agent"); }
            slot[i & 1] = v;
            asm volatile("s_waitcnt lgkmcnt(0)" ::: "memory");
        }
        __builtin_amdgcn_s_barrier();
        const int L = __builtin_amdgcn_readfirstlane((int)slot[i & 1]);
        if (L >= nunits) return false;
        const int j = L >> 3; u.pn = L & 7; u.pm = j; const int e = __builtin_amdgcn_readfirstlane(tt[j]);
        u.A = A0 + (size_t)((unsigned)j * tA);
        u.B = (const char*)(W0 + (size_t)e * D * DEXP + u.pn * 256); u.B2 = u.B + 512;
        u.aux = e; u.aux2 = 0; return true;
    }
};
}

struct Frame {
    LAS unsigned char* lds; volatile LAS unsigned* MISC; gu32* ctl;
    int tid, lane, wave, vcu, G;
    float* out; GAS unsigned char* ws;
};
struct Args { const float* in[24]; float* out; unsigned char* ws; int ph_lo, ph_hi; };
typedef const __attribute__((address_space(4))) Args* KArgs;
__device__ __forceinline__ KArgs kargs() { KArgs p = (KArgs)__builtin_amdgcn_kernarg_segment_ptr(); asm volatile("" : "+s"(p)); return p; }
enum { I_X = 0, I_META, I_LNIN_G, I_LNIN_B, I_WIN, I_FOXB, I_WA2, I_BA, I_GNORM, I_CONVW, I_POOLW, I_POOLS, I_GATEB, I_WBR, I_WOUT, I_LN1G, I_LN1B, I_RW, I_RB, I_WG, I_WU, I_WD, I_LN2G, I_LN2B };

struct RmId { __device__ __forceinline__ int operator()(int n) const { return n; } };
struct RmIn { __device__ __forceinline__ int operator()(int n) const {
    if (n < 1536) return n; if (n < 1540) return 13312 + (n - 1536); if (n < 2564) return n - 4; if (n < 2580) return 13316 + (n - 2564); return n - 20; } };
struct RmGU { int add; __device__ __forceinline__ int operator()(int n) const { return ((n >> 7) << 8) + add + (n & 127); } };
template <class RM>
__device__ __forceinline__ void tr_item(const float* W, int N, bf16* dst, int dpitch, int koff, const RM& rm, LAS float* scr, int kb, int nb, int lane, unsigned char* dq = nullptr) {
    const int k0 = 64 * kb, n0 = 32 * nb, nn = n0 + (lane & 31); const bool okn = nn < N;
    { const int nc = okn ? nn : N - 1; float v[32];
#pragma unroll
      for (int i = 0; i < 32; ++i) v[i] = W[(size_t)(k0 + 2 * i + (lane >> 5)) * N + nc];
#pragma unroll
      for (int i = 0; i < 32; ++i) scr[(2 * i + (lane >> 5)) * 33 + (lane & 31)] = okn ? v[i] : 0.f; }
    LDS_WAIT(); asm volatile("" ::: "memory");
    const int c = lane & 7;
#pragma unroll
    for (int j = 0; j < 4; ++j) { const int n = (lane >> 3) + 8 * j;
        if (n0 + n < N) { const LAS float* s = scr + (8 * c) * 33 + n;
            const int ro = rm(n0 + n);
            if (dq && ro >= ZC_GZ && ro < ZC_GZ + 4 * D) {
                u32x2 o; o.x = pk4_fp8(s[0 * 33] * WQ_SCALE, s[1 * 33] * WQ_SCALE, s[2 * 33] * WQ_SCALE, s[3 * 33] * WQ_SCALE); o.y = pk4_fp8(s[4 * 33] * WQ_SCALE, s[5 * 33] * WQ_SCALE, s[6 * 33] * WQ_SCALE, s[7 * 33] * WQ_SCALE);
                *(GAS u32x2*)(dq + (size_t)(ro - ZC_GZ) * D + k0 + 8 * c) = o; }
            else {
            u32x4 o; o.x = pk2(s[0 * 33], s[1 * 33]); o.y = pk2(s[2 * 33], s[3 * 33]); o.z = pk2(s[4 * 33], s[5 * 33]); o.w = pk2(s[6 * 33], s[7 * 33]);
            *(GAS u32x4*)(dst + (size_t)ro * dpitch + koff + k0 + 8 * c) = o; } } }
    LDS_WAIT(); asm volatile("" ::: "memory");
}
__device__ __forceinline__ void ln_row_regs(f32x4 (&v)[8], const float* g, const float* beta, int lane) {
    float s = 0.f;
#pragma unroll
    for (int j = 0; j < 8; ++j) s += (v[j].x + v[j].y) + (v[j].z + v[j].w);
    const float mean = wave_sum(s) * (1.f / D); float s2 = 0.f;
#pragma unroll
    for (int j = 0; j < 8; ++j) { v[j] = v[j] - mean; s2 += (v[j].x * v[j].x + v[j].y * v[j].y) + (v[j].z * v[j].z + v[j].w * v[j].w); }
    const float rstd = __builtin_amdgcn_rsqf(wave_sum(s2) * (1.f / D) + LN_EPS);
#pragma unroll
    for (int j = 0; j < 8; ++j) { const f32x4 gg = *(const f32x4*)(g + 4 * lane + 256 * j), bb = *(const f32x4*)(beta + 4 * lane + 256 * j); v[j] = v[j] * rstd * gg + bb; }
}
struct TrDesc { const float* W; int N; bf16* dst; int dpitch, koff, kb, nb; unsigned char* dq; int rmin; };
__device__ __forceinline__ void tr_load(const TrDesc& t, float (&v)[32], int lane) {
    const int k0 = 64 * t.kb, nn = 32 * t.nb + (lane & 31); const int nc = nn < t.N ? nn : t.N - 1;
    const float* p = t.W + (size_t)(k0 + (lane >> 5)) * t.N + nc; const size_t st = (size_t)2 * t.N;
#pragma unroll
    for (int i = 0; i < 32; ++i) v[i] = p[i * st];
}
__device__ __forceinline__ void tr_finish(const TrDesc& t, const float (&v)[32], LAS float* scr, int lane) {
    const int k0 = 64 * t.kb, n0 = 32 * t.nb; const bool okn = n0 + (lane & 31) < t.N;
#pragma unroll
    for (int i = 0; i < 32; ++i) scr[(2 * i + (lane >> 5)) * 33 + (lane & 31)] = okn ? v[i] : 0.f;
    LDS_WAIT(); asm volatile("" ::: "memory");
    const int c = lane & 7;
#pragma unroll
    for (int j = 0; j < 4; ++j) { const int n = (lane >> 3) + 8 * j;
        if (n0 + n < t.N) { const LAS float* s = scr + (8 * c) * 33 + n;
            const int ro = t.rmin ? RmIn{}(n0 + n) : n0 + n;
            if (t.dq && ro >= ZC_GZ && ro < ZC_GZ + 4 * D) {
                u32x2 o; o.x = pk4_fp8(s[0 * 33] * WQ_SCALE, s[1 * 33] * WQ_SCALE, s[2 * 33] * WQ_SCALE, s[3 * 33] * WQ_SCALE); o.y = pk4_fp8(s[4 * 33] * WQ_SCALE, s[5 * 33] * WQ_SCALE, s[6 * 33] * WQ_SCALE, s[7 * 33] * WQ_SCALE);
                *(GAS u32x2*)(t.dq + (size_t)(ro - ZC_GZ) * D + k0 + 8 * c) = o; }
            else {
                u32x4 o; o.x = pk2(s[0 * 33], s[1 * 33]); o.y = pk2(s[2 * 33], s[3 * 33]); o.z = pk2(s[4 * 33], s[5 * 33]); o.w = pk2(s[6 * 33], s[7 * 33]);
                *(GAS u32x4*)(t.dst + (size_t)ro * t.dpitch + t.koff + k0 + 8 * c) = o; } } }
    LDS_WAIT(); asm volatile("" ::: "memory");
}
__device__ __forceinline__ void ln_row_pre(f32x4 (&v)[8], const f32x4 (&gg)[8], const f32x4 (&bb)[8]) {
    float s = 0.f;
#pragma unroll
    for (int j = 0; j < 8; ++j) s += (v[j].x + v[j].y) + (v[j].z + v[j].w);
    const float mean = wave_sum(s) * (1.f / D); float s2 = 0.f;
#pragma unroll
    for (int j = 0; j < 8; ++j) { v[j] = v[j] - mean; s2 += (v[j].x * v[j].x + v[j].y * v[j].y) + (v[j].z * v[j].z + v[j].w * v[j].w); }
    const float rstd = __builtin_amdgcn_rsqf(wave_sum(s2) * (1.f / D) + LN_EPS);
#pragma unroll
    for (int j = 0; j < 8; ++j) v[j] = v[j] * rstd * gg[j] + bb[j];
}
__device__ __forceinline__ void store_row(const f32x4 (&v)[8], float* of, bf16* ob, int lane, unsigned char* oq = nullptr) {
#pragma unroll
    for (int j = 0; j < 8; ++j) {
        if (of) *(f32x4*)(of + 4 * lane + 256 * j) = v[j];
        if (oq) *(unsigned*)(oq + 4 * lane + 256 * j) = pk4_fp8(v[j].x, v[j].y, v[j].z, v[j].w);
        if (ob) { u32x2 w; w.x = pk2(v[j].x, v[j].y); w.y = pk2(v[j].z, v[j].w); *(u32x2*)(ob + 4 * lane + 256 * j) = w; } }
}

__device__ __forceinline__ void p0_prologue(Frame& F, KArgs A) {
    LAS float* scr = (LAS float*)(F.lds + F.wave * 16384);
    const int gw = F.vcu * NWAVES + F.wave, NGW = F.G * NWAVES;
    constexpr int I_IN = 32 * 417, I_BR = 4 * 8 * 64, I_OUT = 32 * 64, I_G = NEXP * 32 * 32, I_D = NEXP * 16 * 64, I_PW = 4 * 2 * 4;
    constexpr int PER_LAYER = I_IN + I_BR + I_OUT + I_PW; (void)I_G; (void)I_D;
    auto decode = [&](int it) -> TrDesc {
        const int l = it / PER_LAYER; const int r = it - l * PER_LAYER; const int r1 = r - I_IN, r2 = r1 - I_BR, r3 = r2 - I_OUT;
        const int ty = (r < I_IN) ? 0 : (r1 < I_BR) ? 1 : (r2 < I_OUT) ? 2 : 3;
        const int b = r1 / 512, q1 = r1 % 512, g = r3 / 8, q3 = r3 % 8;
        TrDesc t;
        t.W = ty == 0 ? A->in[I_WIN] + (size_t)l * D * P_IN : ty == 1 ? A->in[I_WBR] + ((size_t)l * 4 + b) * MIXW * D : ty == 2 ? A->in[I_WOUT] + (size_t)l * D * D : A->in[I_POOLW] + ((size_t)l * 4 + g) * 128 * 128;
        t.N = ty == 0 ? P_IN : ty == 3 ? 128 : D;
        t.dst = ty == 0 ? (bf16*)(F.ws + WS_WIN) + (size_t)l * NIN_T * D : ty == 1 ? (bf16*)(F.ws + WS_WBR) + (size_t)l * D * D : ty == 2 ? (bf16*)(F.ws + WS_WOUT) + (size_t)l * D * D : (bf16*)(F.ws + WS_PW) + ((size_t)l * 4 + g) * 128 * 128;
        t.dpitch = ty == 3 ? 128 : D; t.koff = ty == 1 ? b * MIXW : 0;
        t.kb = ty == 0 ? r / 417 : ty == 1 ? q1 / 64 : ty == 2 ? r2 / 64 : q3 / 4;
        t.nb = ty == 0 ? r % 417 : ty == 1 ? q1 % 64 : ty == 2 ? r2 % 64 : q3 % 4;
        t.dq = ty == 0 ? (unsigned char*)(F.ws + WS_WQ + (size_t)l * 4 * D * D) : nullptr; t.rmin = ty == 0;
        return t; };
    { constexpr int TOT = DEPTH * PER_LAYER; float va[32], vb[32]; int it = gw;
      if (it < TOT) { TrDesc ta = decode(it); tr_load(ta, va, F.lane);
        for (;;) {
            const int i1 = it + NGW; const bool h1 = i1 < TOT; const TrDesc tb = decode(h1 ? i1 : it); tr_load(tb, vb, F.lane); __builtin_amdgcn_sched_barrier(0);
            tr_finish(ta, va, scr, F.lane); __builtin_amdgcn_sched_barrier(0);
            if (!h1) break;
            const int i2 = i1 + NGW; const bool h2 = i2 < TOT; ta = decode(h2 ? i2 : i1); tr_load(ta, va, F.lane); __builtin_amdgcn_sched_barrier(0);
            tr_finish(tb, vb, scr, F.lane); __builtin_amdgcn_sched_barrier(0);
            if (!h2) break;
            it = i2; } } }
    for (int it = gw; it < DEPTH * 236; it += NGW) { const int l = it / 236, r = 13332 + it % 236; u32x4* p = (u32x4*)((bf16*)(F.ws + WS_WIN) + ((size_t)l * NIN_T + r) * D);
#pragma unroll
        for (int j = 0; j < 4; ++j) p[F.lane + 64 * j] = (u32x4){0u, 0u, 0u, 0u}; }
    { f32x4 gg[8], bb[8];
#pragma unroll
      for (int j = 0; j < 8; ++j) { gg[j] = *(const f32x4*)(A->in[I_LNIN_G] + 4 * F.lane + 256 * j); bb[j] = *(const f32x4*)(A->in[I_LNIN_B] + 4 * F.lane + 256 * j); }
      int m = gw;
      if (m < MP) {
        f32x4 x[8];
#define P0_SRC(mm) ((mm) < NMETA ? A->in[I_META] + (size_t)(mm) * D : A->in[I_X] + (size_t)(((mm) < NTOK ? (mm) : NTOK - 1) - NMETA) * D)
        { const float* src = P0_SRC(m);
#pragma unroll
          for (int j = 0; j < 8; ++j) x[j] = *(const f32x4*)(src + 4 * F.lane + 256 * j); }
        for (;;) {
            f32x4 v[8];
#pragma unroll
            for (int j = 0; j < 8; ++j) v[j] = x[j];
            const int mn = m + NGW; const bool more = mn < MP; const int mc = more ? mn : m;
            { const float* src = P0_SRC(mc);
#pragma unroll
              for (int j = 0; j < 8; ++j) x[j] = *(const f32x4*)(src + 4 * F.lane + 256 * j); }
            if (m < NTOK) ln_row_pre(v, gg, bb);
            else {
#pragma unroll
                for (int j = 0; j < 8; ++j) v[j] = (f32x4){0.f, 0.f, 0.f, 0.f}; }
            store_row(v, (float*)(F.ws + WS_HF) + (size_t)m * D, (bf16*)(F.ws + WS_HB) + (size_t)m * D, F.lane, (unsigned char*)(F.ws + WS_HQ + (size_t)m * D));
            if (!more) break;
            m = mn;
        }
#undef P0_SRC
      } }
}

__device__ __forceinline__ f32x16 mma_tile(const LAS bf16* A, int pa, const LAS bf16* B, int pb, int K, f32x16 acc, int lane) {
    const int r = lane & 31, h8 = (lane >> 5) * 8;
    for (int ks = 0; ks < K; ks += 16) {
        const bf16x8 a = *(const LAS bf16x8*)(A + r * pa + ks + h8), b = *(const LAS bf16x8*)(B + r * pb + ks + h8);
        acc = __builtin_amdgcn_mfma_f32_32x32x16_bf16(a, b, acc, 0, 0, 0);
    }
    return acc;
}
__device__ __forceinline__ int crow16(int r, int hi) { return (r & 3) + 8 * (r >> 2) + 4 * hi; }

__device__ __forceinline__ void p2a_cumsum(Frame& F, KArgs A, int l, int h) {
    const float* Zs = (const float*)(F.ws + WS_ZS); float* C2 = (float*)(F.ws + WS_C2) + (size_t)h * MP;
    const float fb = A->in[I_FOXB][l * 4 + h];
    LAS float* wsum = (LAS float*)(F.lds);
    const int t0 = F.tid * 17; float loc[17]; float run = 0.f;
#pragma unroll
    for (int i = 0; i < 17; ++i) { const int t = t0 + i; const float x = (t < NTOK) ? log_sigmoidf(Zs[(size_t)t * 32 + h] + fb) : 0.f; run += x; loc[i] = run; }
    float incl = run;
#pragma unroll
    for (int o = 1; o < 64; o <<= 1) { const float y = __shfl_up(incl, o); if (F.lane >= o) incl += y; }
    if (F.lane == 63) wsum[F.wave] = incl;
    __syncthreads();
    float off = incl - run;
    for (int w = 0; w < F.wave; ++w) off += wsum[w];
#pragma unroll
    for (int i = 0; i < 17; ++i) { const int t = t0 + i; if (t < MP) C2[t] = -(off + loc[i]) * LOG2E; }
    __syncthreads();
}

constexpr int GL_GA = 0, GL_WA = 4096, GL_PART = 8192, GL_BC = 10240, GL_A0 = 27136;
constexpr int GP = 72;
__device__ __forceinline__ void gla_bc(Frame& F, KArgs A, int l, int c, int h, float (&bcv)[8], float& last_k) {
    const float* Zs = (const float*)(F.ws + WS_ZS);
    LAS float* ga_s = (LAS float*)(F.lds + GL_GA); LAS float* wa_s = (LAS float*)(F.lds + GL_WA); LAS float* part = (LAS float*)(F.lds + GL_PART); LAS float* bc_s = (LAS float*)(F.lds + GL_BC);
    if (F.tid < 256) { const int i = F.tid >> 2, q = F.tid & 3, r = 64 * c + i - GLA_FRONT;
        const f32x4 v = (r >= 0 && r < NTOK) ? *(const f32x4*)(Zs + (size_t)r * 32 + 4 + 4 * q) : (f32x4){0.f, 0.f, 0.f, 0.f};
        *(LAS f32x4*)(ga_s + i * 16 + 4 * q) = v; }
    { float wv[2];
#pragma unroll
      for (int q = 0; q < 2; ++q) { const int idx = F.tid + 512 * q, j = idx >> 6, k = idx & 63; wv[q] = A->in[I_WA2][((size_t)l * 16 + j) * 256 + h * 64 + k]; }
#pragma unroll
      for (int q = 0; q < 2; ++q) wa_s[F.tid + 512 * q] = wv[q]; }
    __syncthreads();
    const int k = F.tid & 63, ig = F.tid >> 6; const float ba = A->in[I_BA][l * 256 + h * 64 + k];
    float run = 0.f;
#pragma unroll
    for (int ii = 0; ii < 8; ++ii) { const int i = 8 * ig + ii, r = 64 * c + i - GLA_FRONT; float x = ba;
#pragma unroll
        for (int j = 0; j < 16; ++j) x = fmaf(ga_s[i * 16 + j], wa_s[j * 64 + k], x);
        const float g = (r >= 0 && r < NTOK) ? log_sigmoidf(x) * (1.f / 16.f) : 0.f; run += g; bcv[ii] = run; }
    part[ig * 64 + k] = run;
    __syncthreads();
    float off = 0.f, tot = 0.f;
#pragma unroll
    for (int g2 = 0; g2 < 8; ++g2) { const float p = part[g2 * 64 + k]; tot += p; if (g2 < ig) off += p; }
#pragma unroll
    for (int ii = 0; ii < 8; ++ii) { bcv[ii] += off; bc_s[(8 * ig + ii) * 65 + k] = bcv[ii]; }
    last_k = tot;
}
__device__ __forceinline__ void gla_load_vt(Frame& F, int c, int h, LAS bf16* VT) {
    const bf16* Z = (const bf16*)(F.ws + WS_Z);
    const int v = F.tid & 127, sg = F.tid >> 7; unsigned w[8];
#pragma unroll
    for (int jj = 0; jj < 8; ++jj) { unsigned lo = 0, hi = 0; const int s0 = 16 * sg + 2 * jj, r0 = 64 * c + s0 - GLA_FRONT;
        if (r0 >= 0 && r0 < NTOK) lo = Z[(size_t)r0 * ZP + ZC_GV + h * 128 + v];
        if (r0 + 1 >= 0 && r0 + 1 < NTOK) hi = Z[(size_t)(r0 + 1) * ZP + ZC_GV + h * 128 + v];
        w[jj] = lo | (hi << 16); }
    *(LAS u32x4*)(VT + v * GP + 16 * sg) = (u32x4){w[0], w[1], w[2], w[3]};
    *(LAS u32x4*)(VT + v * GP + 16 * sg + 8) = (u32x4){w[4], w[5], w[6], w[7]};
}
__device__ __forceinline__ void gla_stage1(Frame& F, KArgs A, int l, int c, int h) {
    const bf16* Z = (const bf16*)(F.ws + WS_Z);
    LAS bf16* KhT = (LAS bf16*)(F.lds + GL_A0); LAS bf16* VT = (LAS bf16*)(F.lds + GL_A0 + 64 * GP * 2);
    float bcv[8], last_k; gla_bc(F, A, l, c, h, bcv, last_k);
    const int k = F.tid & 63, ig = F.tid >> 6; unsigned w[4];
#pragma unroll
    for (int jj = 0; jj < 4; ++jj) { float x[2];
#pragma unroll
        for (int q = 0; q < 2; ++q) { const int ii = 2 * jj + q, r = 64 * c + 8 * ig + ii - GLA_FRONT;
            const float kc = (r >= 0 && r < NTOK) ? bf2f(Z[(size_t)r * ZP + ZC_GK + h * 64 + k]) : 0.f; x[q] = kc * __expf(last_k - bcv[ii]); }
        w[jj] = pk2(x[0], x[1]); }
    *(LAS u32x4*)(KhT + k * GP + 8 * ig) = (u32x4){w[0], w[1], w[2], w[3]};
    gla_load_vt(F, c, h, VT);
    if (ig == 0) ((float*)(F.ws + WS_DEC))[((size_t)c * 4 + h) * 64 + k] = __expf(last_k);
    __syncthreads();
    { const int mt = F.wave >> 1, nt = F.wave & 1, r = F.lane & 31, hi = F.lane >> 5; f32x16 acc = {};
      acc = mma_tile(VT + mt * 32 * GP, GP, KhT + nt * 32 * GP, GP, 64, acc, F.lane);
      float* U = (float*)(F.ws + WS_UT) + (((size_t)c * 4 + h) * 128) * 64;
#pragma unroll
      for (int rg = 0; rg < 16; ++rg) U[(size_t)(mt * 32 + crow16(rg, hi)) * 64 + nt * 32 + r] = acc[rg]; }
    __syncthreads();
}
__device__ __forceinline__ void gla_scan_item(Frame& F, int it) {
    const int e = it * 512 + F.tid, h = e >> 13, v = (e >> 6) & 127, k = e & 63;
    const float* U = (const float*)(F.ws + WS_UT); const float* DEC = (const float*)(F.ws + WS_DEC); bf16* St = (bf16*)(F.ws + WS_ST);
    float S = 0.f; float u[8], d[8];
#define SCAN_LOAD(c0_) do { _Pragma("unroll") for (int j = 0; j < 8; ++j) { const int c_ = (c0_) + j; const int cc_ = c_ < NCHUNK ? c_ : NCHUNK - 1; \
        u[j] = U[(((size_t)cc_ * 4 + h) * 128 + v) * 64 + k]; d[j] = DEC[((size_t)cc_ * 4 + h) * 64 + k]; } } while (0)
    SCAN_LOAD(0);
    for (int c0 = 0; c0 < NCHUNK; c0 += 8) { float uc[8], dc[8];
#pragma unroll
        for (int j = 0; j < 8; ++j) { uc[j] = u[j]; dc[j] = d[j]; }
        SCAN_LOAD(c0 + 8 < NCHUNK ? c0 + 8 : c0);
#pragma unroll
        for (int j = 0; j < 8; ++j) { const int c = c0 + j; if (c < NCHUNK) { St[(((size_t)c * 4 + h) * 128 + v) * 64 + k] = (bf16)f2bf(S); S = fmaf(dc[j], S, uc[j]); } }
    }
#undef SCAN_LOAD
}
__device__ __forceinline__ void gla_stage3(Frame& F, KArgs A, int l, int c, int h) {
    const bf16* Z = (const bf16*)(F.ws + WS_Z);
    LAS bf16* QT = (LAS bf16*)(F.lds + GL_A0); LAS bf16* KT = QT + 64 * GP; LAS bf16* ATT = KT + 64 * GP; LAS bf16* VT = ATT + 64 * GP; LAS bf16* ST = VT + 128 * GP;
    LAS float* O_s = (LAS float*)(F.lds + GL_A0 + (3 * 64 + 2 * 128) * GP * 2);
    float bcv[8], last_k; gla_bc(F, A, l, c, h, bcv, last_k);
    const int k = F.tid & 63, ig = F.tid >> 6;
#pragma unroll
    for (int ii = 0; ii < 8; ++ii) { const int i = 8 * ig + ii, r = 64 * c + i - GLA_FRONT; float qv = 0.f, kv = 0.f;
        if (r >= 0 && r < NTOK) { qv = bf2f(Z[(size_t)r * ZP + ZC_GQ + h * 64 + k]) * 0.125f; kv = bf2f(Z[(size_t)r * ZP + ZC_GK + h * 64 + k]); }
        QT[i * GP + k] = (bf16)f2bf(qv * __expf(bcv[ii])); KT[i * GP + k] = (bf16)f2bf(kv * __expf(-bcv[ii])); }
    gla_load_vt(F, c, h, VT);
    { const bf16* Sp = (const bf16*)(F.ws + WS_ST) + (((size_t)c * 4 + h) * 128) * 64;
#pragma unroll
      for (int j = 0; j < 2; ++j) { const int q = F.tid + 512 * j, v = q >> 3, kk = (q & 7) * 8; *(LAS u32x4*)(ST + v * GP + kk) = *(const u32x4*)(Sp + (size_t)v * 64 + kk); } }
    __syncthreads();
    if (F.wave < 4) { const int mt = F.wave >> 1, nt = F.wave & 1, r = F.lane & 31, hi = F.lane >> 5; f32x16 acc = {};
        acc = mma_tile(QT + mt * 32 * GP, GP, KT + nt * 32 * GP, GP, 64, acc, F.lane);
#pragma unroll
        for (int rg = 0; rg < 16; ++rg) { const int t = mt * 32 + crow16(rg, hi), s = nt * 32 + r; ATT[t * GP + s] = (bf16)f2bf(s <= t ? acc[rg] : 0.f); } }
    __syncthreads();
    { const int mt = F.wave >> 2, nt = F.wave & 3, r = F.lane & 31, hi = F.lane >> 5; f32x16 acc = {};
      acc = mma_tile(ATT + mt * 32 * GP, GP, VT + nt * 32 * GP, GP, 64, acc, F.lane);
      acc = mma_tile(QT + mt * 32 * GP, GP, ST + nt * 32 * GP, GP, 64, acc, F.lane);
#pragma unroll
      for (int rg = 0; rg < 16; ++rg) O_s[(mt * 32 + crow16(rg, hi)) * 132 + nt * 32 + r] = acc[rg]; }
    __syncthreads();
    { bf16* OM = (bf16*)(F.ws + WS_OM); const float* gn = A->in[I_GNORM] + l * 512 + h * 128;
      const float g0 = gn[F.lane], g1 = gn[F.lane + 64];
      float gr0[8], gr1[8];
#pragma unroll
      for (int ii = 0; ii < 8; ++ii) { const int r = 64 * c + 8 * F.wave + ii - GLA_FRONT; const int rc = r < 0 ? 0 : (r < NTOK ? r : NTOK - 1);
          gr0[ii] = bf2f(Z[(size_t)rc * ZP + ZC_GR + h * 128 + F.lane]); gr1[ii] = bf2f(Z[(size_t)rc * ZP + ZC_GR + h * 128 + F.lane + 64]); }
#pragma unroll
      for (int ii = 0; ii < 8; ++ii) { const int t = 8 * F.wave + ii, r = 64 * c + t - GLA_FRONT;
          const float x0 = O_s[t * 132 + F.lane], x1 = O_s[t * 132 + F.lane + 64];
          const float ss = wave_sum(x0 * x0 + x1 * x1); const float rstd = __builtin_amdgcn_rsqf(ss * (1.f / 128.f) + LN_EPS);
          if (r >= 0 && r < NTOK) { const float r0 = gr0[ii], r1 = gr1[ii];
              OM[(size_t)r * D + 512 + h * 128 + F.lane] = (bf16)f2bf(x0 * rstd * g0 * (r0 * sigmoidf_fast(r0)));
              OM[(size_t)r * D + 512 + h * 128 + F.lane + 64] = (bf16)f2bf(x1 * rstd * g1 * (r1 * sigmoidf_fast(r1))); } } }
    __syncthreads();
}
__device__ __forceinline__ void conv_item(Frame& F, KArgs A, int l, int rt) {
    const bf16* Z = (const bf16*)(F.ws + WS_Z); bf16* OM = (bf16*)(F.ws + WS_OM);
    const int c4 = 4 * (F.tid & 127), rb = 64 * rt + 16 * __builtin_amdgcn_readfirstlane(F.tid >> 7);
    const float* cw = A->in[I_CONVW] + (size_t)l * 3 * 512;
    const f32x4 w0 = *(const f32x4*)(cw + c4), w1 = *(const f32x4*)(cw + 512 + c4), w2 = *(const f32x4*)(cw + 1024 + c4);
    u32x2 cc[18], cv[18], cb[16];
#pragma unroll
    for (int i = 0; i < 18; ++i) { const int r = rb + i - 2; const int rc = r < 0 ? 0 : (r < NTOK ? r : NTOK - 1);
        cc[i] = *(const u32x2*)(Z + (size_t)rc * ZP + ZC_CC + c4); cv[i] = *(const u32x2*)(Z + (size_t)rc * ZP + ZC_CV + c4);
        if (i >= 2) cb[i - 2] = *(const u32x2*)(Z + (size_t)rc * ZP + ZC_CB + c4); }
#define CV_U(i) ((rb + (i) - 2 >= 0) ? (f32x4){bflo(cc[i].x) * bflo(cv[i].x), bfhi(cc[i].x) * bfhi(cv[i].x), bflo(cc[i].y) * bflo(cv[i].y), bfhi(cc[i].y) * bfhi(cv[i].y)} : (f32x4){0.f, 0.f, 0.f, 0.f})
    f32x4 u2 = CV_U(0), u1 = CV_U(1);
#pragma unroll
    for (int i = 0; i < 16; ++i) { const int r = rb + i; const f32x4 u0 = CV_U(i + 2);
        const f32x4 b = (f32x4){bflo(cb[i].x), bfhi(cb[i].x), bflo(cb[i].y), bfhi(cb[i].y)}, o = b * (w0 * u2 + w1 * u1 + w2 * u0);
        if (r < NTOK) { u32x2 w; w.x = pk2(o[0], o[1]); w.y = pk2(o[2], o[3]); *(u32x2*)(OM + (size_t)r * D + 1024 + c4) = w; }
        u2 = u1; u1 = u0; }
#undef CV_U
}
__device__ __forceinline__ void pool_item(Frame& F, KArgs A, int l, int rt, int g) {
    const bf16* Z = (const bf16*)(F.ws + WS_Z); bf16* OM = (bf16*)(F.ws + WS_OM);
    constexpr int PP = 136;
    LAS float* X_s = (LAS float*)(F.lds); LAS bf16* P_s = (LAS bf16*)(F.lds + 40448); LAS bf16* PW_s = (LAS bf16*)(F.lds + 40448 + 64 * PP * 2);
    const int r0 = 64 * rt, w = 2 << g;
    { float xv[20];
#pragma unroll
      for (int q = 0; q < 20; ++q) { const int idx = F.tid + 512 * q, rr = idx >> 7, c = idx & 127, r = r0 - 15 + rr;
          xv[q] = (idx < 79 * 128 && r >= 0 && r < NTOK) ? bf2f(Z[(size_t)r * ZP + ZC_PZ + g * 128 + c]) : 0.f; }
#pragma unroll
      for (int q = 0; q < 20; ++q) { const int idx = F.tid + 512 * q; if (idx < 79 * 128) X_s[idx] = xv[q]; } }
    { const bf16* pw = (const bf16*)(F.ws + WS_PW) + ((size_t)l * 4 + g) * 128 * 128;
#pragma unroll
      for (int j = 0; j < 4; ++j) { const int q = F.tid + 512 * j, d = q >> 4, cc = (q & 15) * 8; *(LAS u32x4*)(PW_s + d * PP + cc) = *(const u32x4*)(pw + (size_t)d * 128 + cc); } }
    __syncthreads();
    { const int c = F.tid & 127, ib = (F.tid >> 7) * 16;
      float xs[32];
#pragma unroll
      for (int q = 0; q < 32; ++q) xs[q] = (ib + q - 1 >= 0) ? X_s[(ib + q - 1) * 128 + c] : 0.f;
      float sw = 0.f;
#pragma unroll
      for (int j = 0; j < 16; ++j) if (j < w) sw += xs[16 - j];
#pragma unroll
      for (int ii = 0; ii < 16; ++ii) { const int i = ib + ii, t = r0 + i;
          if (ii > 0) { float leave = 0.f;
#pragma unroll
              for (int g2 = 0; g2 < 4; ++g2) if (g2 == g) leave = xs[16 + ii - (2 << g2)];
              sw += xs[16 + ii] - leave; }
          const int cnt = (t + 1 < w) ? (t + 1) : w;
          P_s[i * PP + c] = (bf16)f2bf(sw * __builtin_amdgcn_rcpf((float)cnt) - xs[16 + ii]); } }
    __syncthreads();
    { const int mt = F.wave >> 2, nt = F.wave & 3, r = F.lane & 31, hi = F.lane >> 5; f32x16 acc = {};
      acc = mma_tile(P_s + mt * 32 * PP, PP, PW_s + nt * 32 * PP, PP, 128, acc, F.lane);
      const float sc = A->in[I_POOLS][l * 512 + g * 128 + nt * 32 + r];
#pragma unroll
      for (int rg = 0; rg < 16; ++rg) { const int t = r0 + mt * 32 + crow16(rg, hi); if (t < NTOK) OM[(size_t)t * D + 1536 + g * 128 + nt * 32 + r] = (bf16)f2bf(acc[rg] * sc); } }
    __syncthreads();
}
__device__ __forceinline__ void norm_item(Frame& F, int l, int rt) {
    const bf16* Z = (const bf16*)(F.ws + WS_Z);
    const int hq = F.wave, r = 64 * rt + F.lane; float ss = 0.f;
    if (r < NTOK) { const bf16* p = Z + (size_t)r * ZP + ((hq & 1) ? ZC_FK : ZC_FQ) + (hq >> 1) * 128;
#pragma unroll
        for (int j = 0; j < 16; ++j) { const u32x4 w = *(const u32x4*)(p + 8 * j);
            ss += (bflo(w.x) * bflo(w.x) + bfhi(w.x) * bfhi(w.x)) + (bflo(w.y) * bflo(w.y) + bfhi(w.y) * bfhi(w.y)) + (bflo(w.z) * bflo(w.z) + bfhi(w.z) * bfhi(w.z)) + (bflo(w.w) * bflo(w.w) + bfhi(w.w) * bfhi(w.w)); } }
#pragma unroll
    for (int o = 1; o < 64; o <<= 1) ss = fmaxf(ss, __shfl_xor(ss, o));
    if (F.lane == 0) atomicMax((unsigned*)(F.ctl + CW_NRM + 64 * l + hq), __builtin_bit_cast(unsigned, ss));
}
__device__ __forceinline__ void att_decode(int u, int& qb, int& s, int& h) {
    s = 0;
#pragma nounroll
    while (s + 1 < ATT_MAXNS && u >= att_sbase(s + 1)) ++s;
    const int r = u - att_sbase(s); qb = 32 - (r >> 2); h = r & 3;
}
__device__ __forceinline__ int att_unit(int qb, int s, int h) { return att_sbase(s) + 4 * (32 - qb) + h; }
__device__ __forceinline__ void att_combine(Frame& F, int qb, int h) {
    const float* OP = (const float*)(F.ws + WS_OPART); const float* ML = (const float*)(F.ws + WS_ML); bf16* OM = (bf16*)(F.ws + WS_OM);
    const int ns = att_ns(qb), d4 = (F.lane & 31) * 4, rsub = F.lane >> 5;
    f32x2 mln[4]; f32x4 opn[4];
#pragma unroll
    for (int s2 = 0; s2 < 4; ++s2) { mln[s2] = (f32x2){-3.0e38f, 0.f}; opn[s2] = (f32x4){0.f, 0.f, 0.f, 0.f}; }
#define AC_LOAD(st_) do { const int row_ = 32 * F.wave + 2 * (st_) + rsub; _Pragma("unroll") for (int s2 = 0; s2 < 4; ++s2) if (s2 < ns) { const size_t ub = (size_t)att_unit(qb, s2, h) * 256 + row_; \
        mln[s2] = *(const f32x2*)(ML + ub * 2); opn[s2] = *(const f32x4*)(OP + ub * 128 + d4); } } while (0)
    AC_LOAD(0);
#pragma nounroll
    for (int st = 0; st < 16; ++st) { const int row = 32 * F.wave + 2 * st + rsub;
        f32x2 ml[4]; f32x4 op[4];
#pragma unroll
        for (int s2 = 0; s2 < 4; ++s2) { ml[s2] = mln[s2]; op[s2] = opn[s2]; }
        AC_LOAD(st < 15 ? st + 1 : 15);
        float M = -3.0e38f;
#pragma unroll
        for (int s2 = 0; s2 < 4; ++s2) if (s2 < ns) M = fmaxf(M, ml[s2].x);
        bool more = ns > 4 && ml[3].x > -1.0e29f;
        for (int s2 = 4; more && s2 < ns; ++s2) { const float m2 = ML[((size_t)att_unit(qb, s2, h) * 256 + row) * 2]; more = m2 > -1.0e29f; M = fmaxf(M, m2); }
        float wsum = 0.f; f32x4 o = {0.f, 0.f, 0.f, 0.f};
#pragma unroll
        for (int s2 = 0; s2 < 4; ++s2) if (s2 < ns && ml[s2].x > -1.0e29f) { const float e = __builtin_amdgcn_exp2f(ml[s2].x - M); wsum += e * ml[s2].y; o += op[s2] * e; }
        more = ns > 4 && ml[3].x > -1.0e29f;
        for (int s2 = 4; more && s2 < ns; ++s2) { const size_t ub = (size_t)att_unit(qb, s2, h) * 256 + row; const f32x2 m2 = *(const f32x2*)(ML + ub * 2); more = m2.x > -1.0e29f;
            if (more) { const float e = __builtin_amdgcn_exp2f(m2.x - M); wsum += e * m2.y; o += *(const f32x4*)(OP + ub * 128 + d4) * e; } }
        const float inv = __builtin_amdgcn_rcpf(wsum); const size_t r = (size_t)qb * 256 + row;
        u32x2 w; w.x = pk2(o[0] * inv, o[1] * inv); w.y = pk2(o[2] * inv, o[3] * inv);
        *(u32x2*)(OM + r * D + h * 128 + d4) = w; }
#undef AC_LOAD
}

__device__ __forceinline__ void p3_meta(Frame& F, KArgs A, int l) {
    if (F.vcu >= 128) return;
    const bf16* OM = (const bf16*)(F.ws + WS_OM); const bf16* W = (const bf16*)(F.ws + WS_WBR) + (size_t)l * D * D; const bf16* Z = (const bf16*)(F.ws + WS_Z); bf16* MX = (bf16*)(F.ws + WS_MX);
    const int n0 = 16 * F.vcu, r = F.lane & 15, g = F.lane >> 4, b = F.wave >> 1, kh = F.wave & 1;
    f32x4 acc = {0.f, 0.f, 0.f, 0.f};
    const bf16* ap = OM + (size_t)r * D + b * MIXW + kh * 256 + 8 * g; const bf16* bp = W + (size_t)(n0 + r) * D + b * MIXW + kh * 256 + 8 * g;
#pragma unroll
    for (int ks = 0; ks < 8; ++ks) acc = __builtin_amdgcn_mfma_f32_16x16x32_bf16(*(const bf16x8*)(ap + 32 * ks), *(const bf16x8*)(bp + 32 * ks), acc, 0, 0, 0);
    LAS float* Ps = (LAS float*)(F.lds);
#pragma unroll
    for (int rg = 0; rg < 4; ++rg) Ps[(F.wave * 16 + g * 4 + rg) * 16 + r] = acc[rg];
    __syncthreads();
    if (F.tid < 256) { const int row = F.tid >> 4, col = F.tid & 15; float sum = 0.f;
#pragma unroll
        for (int bb = 0; bb < 4; ++bb) { const float p = Ps[((2 * bb) * 16 + row) * 16 + col] + Ps[((2 * bb + 1) * 16 + row) * 16 + col];
            const float tz = bf2f(Z[(size_t)row * ZP + ZC_GZ + bb * D + n0 + col]);
            sum += __builtin_amdgcn_rcpf(tz) * p; }
        MX[(size_t)row * D + n0 + col] = (bf16)f2bf(sum); }
    __syncthreads();
}
__device__ __forceinline__ void p4_meta(Frame& F, int l) {
    if (F.vcu >= 128) return;
    const bf16* MX = (const bf16*)(F.ws + WS_MX); const bf16* W = (const bf16*)(F.ws + WS_WOUT) + (size_t)l * D * D; bf16* MO = (bf16*)(F.ws + WS_MO);
    const int n0 = 16 * F.vcu, r = F.lane & 15, g = F.lane >> 4;
    f32x4 acc = {0.f, 0.f, 0.f, 0.f};
    const bf16* ap = MX + (size_t)r * D + 256 * F.wave + 8 * g; const bf16* bp = W + (size_t)(n0 + r) * D + 256 * F.wave + 8 * g;
#pragma unroll
    for (int ks = 0; ks < 8; ++ks) acc = __builtin_amdgcn_mfma_f32_16x16x32_bf16(*(const bf16x8*)(ap + 32 * ks), *(const bf16x8*)(bp + 32 * ks), acc, 0, 0, 0);
    LAS float* Ps = (LAS float*)(F.lds);
#pragma unroll
    for (int rg = 0; rg < 4; ++rg) Ps[(F.wave * 16 + g * 4 + rg) * 16 + r] = acc[rg];
    __syncthreads();
    if (F.tid < 256) { const int row = F.tid >> 4, col = F.tid & 15; float sum = 0.f;
#pragma unroll
        for (int w = 0; w < 8; ++w) sum += Ps[(w * 16 + row) * 16 + col];
        MO[(size_t)row * D + n0 + col] = (bf16)f2bf(sum); }
    __syncthreads();
}
typedef __attribute__((address_space(1))) const float gcf32;
#define P5A_LBAR() do { asm volatile("s_waitcnt lgkmcnt(0)" ::: "memory"); __builtin_amdgcn_s_barrier(); } while (0)
__device__ __forceinline__ void p5a_ln_router(Frame& F, KArgs A, int l, bool dummy) {
    const float* Hf = (const float*)(F.ws + WS_HF); const bf16* MO = (const bf16*)(F.ws + WS_MO);
    float* Hfo = (float*)(F.ws + (dummy ? WS_MXF : WS_HF)); bf16* Hb = (bf16*)(F.ws + (dummy ? WS_OPART : WS_HB));
    int* EID = (int*)(F.ws + (dummy ? WS_ML : WS_EID)); float* WTS = (float*)(F.ws + (dummy ? WS_ML + 70000 : WS_WTS)); int* DST = (int*)(F.ws + (dummy ? WS_ML + 140000 : WS_DST)); const int cw = CW_ECNT + 64 * l + (dummy ? 32 : 0);
    constexpr int HP = 2052;
    LAS float* Hs = (LAS float*)(F.lds); LAS float* Ps = Hs; LAS float* sel_s = Hs + 16 * HP; LAS float* aff_s = sel_s + 512;
    static_assert((16 * HP + 1024 + 32) * 4 <= LDSCTL_OFF, "P5a LDS");
    const int c = F.lane & 15, g = F.lane >> 4;
    f32x4 hv[2][8]; u32x2 mv[2][8];
#define P5A_LOAD(item) do { _Pragma("unroll") for (int rr = 0; rr < 2; ++rr) { const size_t m_ = (size_t)(16 * (item) + 2 * F.wave + rr); \
        _Pragma("unroll") for (int j = 0; j < 8; ++j) { mv[rr][j] = *(const u32x2*)(MO + m_ * D + 4 * F.lane + 256 * j); hv[rr][j] = *(const f32x4*)(Hf + m_ * D + 4 * F.lane + 256 * j); } } } while (0)
    int it = F.vcu + ((l == DEPTH - 1 && F.vcu == 0) ? F.G : 0);
    if (it < NTOK / 16) P5A_LOAD(it);
    for (; it < NTOK / 16; it += F.G) {
        const int m0 = 16 * it;
#pragma unroll
        for (int rr = 0; rr < 2; ++rr) { const int r = 2 * F.wave + rr; const size_t m = (size_t)(m0 + r);
            f32x4 v[8];
#pragma unroll
            for (int j = 0; j < 8; ++j) { const u32x2 mo = mv[rr][j]; v[j] = hv[rr][j] * ALPHA + (f32x4){bflo(mo.x), bfhi(mo.x), bflo(mo.y), bfhi(mo.y)}; }
            { const GAS float* g1_ = (const GAS float*)(A->in[I_LN1G] + l * D); const GAS float* b1_ = (const GAS float*)(A->in[I_LN1B] + l * D); asm volatile("" : "+s"(g1_), "+s"(b1_));
              ln_row_regs(v, (const float*)g1_, (const float*)b1_, F.lane); }
#pragma unroll
            for (int j = 0; j < 8; ++j) *(LAS f32x4*)(Hs + r * HP + 4 * F.lane + 256 * j) = v[j];
            __builtin_amdgcn_sched_barrier(0); }
        __builtin_amdgcn_sched_barrier(0);
        float q0[32], q1[32], q2[32];
        unsigned lo_ = (unsigned)(g * 32 + c) * 4u; asm volatile("" : "+v"(lo_));
        const char* rw_ = (const char*)(A->in[I_RW]) + (size_t)F.wave * 32768; asm volatile("" : "+s"(rw_));
#define P5A_LOADQ(q, qi) do { _Pragma("unroll") for (int h_ = 0; h_ < 2; ++h_) { const gcf32* ub_ = (const gcf32*)(rw_ + ((qi) * 2 + h_) * 4096 + lo_); \
            _Pragma("unroll") for (int k8 = 0; k8 < 8; ++k8) { q[(h_ * 8 + k8) * 2] = ub_[k8 * 128]; q[(h_ * 8 + k8) * 2 + 1] = ub_[k8 * 128 + 16]; } } } while (0)
#define P5A_MFMAQ(q, qi) do { _Pragma("unroll") for (int k_ = 0; k_ < 16; ++k_) { const float a_ = ap[4 * ((qi) * 16 + k_)]; \
            acc0 = __builtin_amdgcn_mfma_f32_16x16x4f32(a_, q[2 * k_], acc0, 0, 0, 0); acc1 = __builtin_amdgcn_mfma_f32_16x16x4f32(a_, q[2 * k_ + 1], acc1, 0, 0, 0); } } while (0)
        P5A_LOADQ(q0, 0); P5A_LOADQ(q1, 1); P5A_LOADQ(q2, 2);
        __builtin_amdgcn_sched_barrier(0);
#pragma unroll
        for (int rr = 0; rr < 2; ++rr) { const int r = 2 * F.wave + rr; const size_t m = (size_t)(m0 + r);
#pragma unroll
            for (int j = 0; j < 8; ++j) { const f32x4 u = *(const LAS f32x4*)(Hs + r * HP + 4 * F.lane + 256 * j);
                *(f32x4*)(Hfo + m * D + 4 * F.lane + 256 * j) = u; u32x2 w; w.x = pk2(u.x, u.y); w.y = pk2(u.z, u.w); *(u32x2*)(Hb + m * D + 4 * F.lane + 256 * j) = w;
                if ((j & 1) == 1) __builtin_amdgcn_sched_barrier(0); } }
        P5A_LBAR();
        f32x4 acc0 = {0.f, 0.f, 0.f, 0.f}, acc1 = {0.f, 0.f, 0.f, 0.f};
        { const LAS float* ap = Hs + c * HP + 256 * F.wave + g;
          P5A_MFMAQ(q0, 0); __builtin_amdgcn_sched_barrier(0);
          P5A_LOADQ(q0, 3); __builtin_amdgcn_sched_barrier(0);
          P5A_MFMAQ(q1, 1); __builtin_amdgcn_sched_barrier(0);
          P5A_MFMAQ(q2, 2); __builtin_amdgcn_sched_barrier(0);
          P5A_MFMAQ(q0, 3); }
#undef P5A_LOADQ
#undef P5A_MFMAQ
        P5A_LBAR();
#pragma unroll
        for (int rg = 0; rg < 4; ++rg) { Ps[(F.wave * 16 + g * 4 + rg) * 32 + c] = acc0[rg]; Ps[(F.wave * 16 + g * 4 + rg) * 32 + 16 + c] = acc1[rg]; }
        P5A_LBAR();
        { const int row = F.tid >> 5, e = F.tid & 31; float logit = 0.f;
#pragma unroll
          for (int w = 0; w < 8; ++w) logit += Ps[(w * 16 + row) * 32 + e];
          const float aff = 1.f / (1.f + __expf(-logit)); sel_s[row * 32 + e] = aff + A->in[I_RB][e]; aff_s[row * 32 + e] = aff; }
        P5A_LBAR();
        __builtin_amdgcn_sched_barrier(0);
        if (it + F.G < NTOK / 16) P5A_LOAD(it + F.G);
        if (F.tid < 16) { const int row = F.tid, m = m0 + row; const LAS float* ss = sel_s + row * 32;
            int bg = 0; float bs = -3.0e38f;
#pragma unroll
            for (int gi = 0; gi < 8; ++gi) { const f32x4 s4 = *(const LAS f32x4*)(ss + 4 * gi);
                const float h1 = fmaxf(s4.x, s4.y), l1 = fminf(s4.x, s4.y), h2 = fmaxf(s4.z, s4.w), l2 = fminf(s4.z, s4.w);
                const float sc = fmaxf(h1, h2) + fmaxf(fminf(h1, h2), fmaxf(l1, l2)); if (sc > bs) { bs = sc; bg = gi; } }
            float sv[4]; { const f32x4 s4 = *(const LAS f32x4*)(ss + 4 * bg); sv[0] = s4.x; sv[1] = s4.y; sv[2] = s4.z; sv[3] = s4.w; }
            int i0 = 0; float b0 = sv[0];
#pragma unroll
            for (int i = 1; i < 4; ++i) if (sv[i] > b0) { b0 = sv[i]; i0 = i; }
            int i1 = -1; float b1 = -3.0e38f;
#pragma unroll
            for (int i = 0; i < 4; ++i) if (i != i0 && sv[i] > b1) { b1 = sv[i]; i1 = i; }
            const int e0 = 4 * bg + i0, e1 = 4 * bg + i1; const float w0 = aff_s[row * 32 + e0], w1 = aff_s[row * 32 + e1], ws = w0 + w1;
            LAS int* pk = (LAS int*)(aff_s + 512); pk[2 * row] = e0; pk[2 * row + 1] = e1;
            asm volatile("s_waitcnt lgkmcnt(0)" ::: "memory");
            int r0 = 0, r1 = 0;
#pragma unroll
            for (int q = 0; q < 16; ++q) { const int a = pk[2 * q], b = pk[2 * q + 1]; if (q < row) { r0 += (a == e0) + (b == e0); r1 += (a == e1) + (b == e1); } }
            EID[2 * m] = e0; EID[2 * m + 1] = e1; WTS[2 * m] = w0 / ws; WTS[2 * m + 1] = w1 / ws; DST[2 * m] = r0; DST[2 * m + 1] = r1; }
        if (F.tid < 32) { const LAS int* pk = (const LAS int*)(aff_s + 512); int cn = 0;
            asm volatile("s_waitcnt lgkmcnt(0)" ::: "memory");
#pragma unroll
            for (int q = 0; q < 32; ++q) cn += (pk[q] == F.tid);
            ((int*)(F.ws + WS_CNT))[((size_t)(l * 2 + (dummy ? 1 : 0)) * (NTOK / 16) + it) * NEXP + F.tid] = cn; }
    }
#undef P5A_LOAD
    __syncthreads();
}
#undef P5A_LBAR
__device__ __forceinline__ int moe_tables(Frame& F, int l, LAS int* tt, LAS int* pstart, const LAS int* lcnt = nullptr) {
    if (F.tid < 64) {
        const int e = F.lane & 31;
        const int cnt = lcnt ? lcnt[e] : (int)__hip_atomic_load((unsigned*)(F.ctl + CW_ECNT + 64 * l + e), RLX_AGENT);
        const int nt = (cnt + 255) >> 8; int inc = nt;
#pragma unroll
        for (int d = 1; d < 32; d <<= 1) { const int t = __shfl_up(inc, d, 64); if (e >= d) inc += t; }
        const int excl = inc - nt;
        if (F.lane < 32) { pstart[e] = excl << 8;
#pragma nounroll
            for (int q = 0; q < nt; ++q) tt[excl + q] = e;
            if (e == NEXP - 1) pstart[NEXP] = inc; }
    }
    __syncthreads();
    return __builtin_amdgcn_readfirstlane(pstart[NEXP]);
}
__device__ __forceinline__ void p5b_scatter(Frame& F, int l, bool dummy) {
    LAS int* tt = (LAS int*)(F.lds); LAS int* pstart = tt + 128;
    constexpr int NIT = NTOK / 16, SEGI = (NIT + 15) / 16;
    LAS int* T = (LAS int*)(F.lds + 1024); LAS int* segs = T + NIT * NEXP; LAS int* tot = segs + 16 * NEXP;
    { const int* CNT = (const int*)(F.ws + WS_CNT) + (size_t)(l * 2) * NIT * NEXP;
      { constexpr int NV = NIT * NEXP / 4; typedef int i32x4c __attribute__((ext_vector_type(4))); i32x4c cv[(NV + NWAVES * 64 - 1) / (NWAVES * 64)];
#pragma unroll
        for (int q = 0; q < (NV + NWAVES * 64 - 1) / (NWAVES * 64); ++q) { const int i4 = F.tid + NWAVES * 64 * q; cv[q] = (i4 < NV) ? ((const i32x4c*)CNT)[i4] : (i32x4c){0, 0, 0, 0}; }
#pragma unroll
        for (int q = 0; q < (NV + NWAVES * 64 - 1) / (NWAVES * 64); ++q) { const int i4 = F.tid + NWAVES * 64 * q;
            if (i4 < NV) *(LAS i32x4c*)(T + 4 * i4) = (l == DEPTH - 1 && i4 < NEXP / 4) ? (i32x4c){0, 0, 0, 0} : cv[q]; } }
      __syncthreads();
      const int e = F.tid & 31, sg = F.tid >> 5, lo = sg * SEGI, hi = (lo + SEGI < NIT) ? lo + SEGI : NIT; int sum = 0;
      for (int i = lo; i < hi; ++i) sum += T[i * NEXP + e];
      segs[sg * NEXP + e] = sum;
      __syncthreads();
      int run = 0;
      for (int q = 0; q < sg; ++q) run += segs[q * NEXP + e];
      for (int i = lo; i < hi; ++i) { const int c = T[i * NEXP + e]; T[i * NEXP + e] = run; run += c; }
      if (sg == 15) { tot[e] = run; if (F.vcu == 0 && !dummy) __hip_atomic_store((unsigned*)(F.ctl + CW_ECNT + 64 * l + e), (unsigned)run, RLX_AGENT); }
      __syncthreads(); }
    (void)moe_tables(F, l, tt, pstart, tot);
    const bf16* Hb = (const bf16*)(F.ws + WS_HB); bf16* XR = (bf16*)(F.ws + (dummy ? WS_Y : WS_XR)); const int* EID = (const int*)(F.ws + WS_EID); const int* DST = (const int*)(F.ws + WS_DST); int* DSTo = (int*)(F.ws + (dummy ? WS_OPART : WS_DST));
    const int gw = F.vcu * NWAVES + F.wave, NGW = F.G * NWAVES;
    { int m = (l == DEPTH - 1 && gw < NMETA) ? gw + NGW : gw;
      if (m < NTOK) {
        u32x4 v[4]; int e0 = EID[2 * m], e1 = EID[2 * m + 1], s0 = DST[2 * m], s1 = DST[2 * m + 1];
#pragma unroll
        for (int j = 0; j < 4; ++j) v[j] = *(const u32x4*)(Hb + (size_t)m * D + 8 * F.lane + 512 * j);
        for (;;) {
            const int mn = m + NGW; const bool more = mn < NTOK; const int mc = more ? mn : m;
            u32x4 vn[4]; const int ne0 = EID[2 * mc], ne1 = EID[2 * mc + 1], ns0 = DST[2 * mc], ns1 = DST[2 * mc + 1];
#pragma unroll
            for (int j = 0; j < 4; ++j) vn[j] = *(const u32x4*)(Hb + (size_t)mc * D + 8 * F.lane + 512 * j);
            const int d0 = pstart[e0] + T[(m >> 4) * NEXP + e0] + s0, d1 = pstart[e1] + T[(m >> 4) * NEXP + e1] + s1;
#pragma unroll
            for (int j = 0; j < 4; ++j) { *(u32x4*)(XR + (size_t)d0 * D + 8 * F.lane + 512 * j) = v[j]; *(u32x4*)(XR + (size_t)d1 * D + 8 * F.lane + 512 * j) = v[j]; }
            if (F.lane == 0) { DSTo[2 * m] = d0; DSTo[2 * m + 1] = d1; }
            if (!more) break;
            m = mn; e0 = ne0; e1 = ne1; s0 = ns0; s1 = ns1;
#pragma unroll
            for (int j = 0; j < 4; ++j) v[j] = vn[j];
        } } }
    __syncthreads();
}
__device__ __forceinline__ void p8_ln2(Frame& F, KArgs A, int l, bool dummy) {
    const float* Hf = (const float*)(F.ws + WS_HF); float* Hfo = (float*)(F.ws + (dummy ? WS_MXF : WS_HF)); bf16* Hb = (bf16*)(F.ws + (dummy ? WS_OPART : WS_HB)); const bf16* Y = (const bf16*)(F.ws + WS_Y);
    const float* WTS = (const float*)(F.ws + WS_WTS); const int* DST = (const int*)(F.ws + WS_DST);
    const int gw = F.vcu * NWAVES + F.wave, NGW = F.G * NWAVES;
    f32x4 gg[8], bb[8];
    { const float* g = A->in[I_LN2G] + l * D; const float* b = A->in[I_LN2B] + l * D;
#pragma unroll
      for (int j = 0; j < 8; ++j) { gg[j] = *(const f32x4*)(g + 4 * F.lane + 256 * j); bb[j] = *(const f32x4*)(b + 4 * F.lane + 256 * j); } }
    int m = (l == DEPTH - 1 && gw < NMETA) ? gw + NGW : gw;
    if (m >= NTOK) return;
    u32x2 y0[8], y1[8]; f32x4 hf[8];
    int d0 = DST[2 * m], d1 = DST[2 * m + 1]; float w0 = WTS[2 * m], w1 = WTS[2 * m + 1];
#define P8_LOAD(mm, da, db) do { _Pragma("unroll") for (int j = 0; j < 8; ++j) { y0[j] = *(const u32x2*)(Y + (size_t)(da) * D + 4 * F.lane + 256 * j); y1[j] = *(const u32x2*)(Y + (size_t)(db) * D + 4 * F.lane + 256 * j); \
        hf[j] = *(const f32x4*)(Hf + (size_t)(mm) * D + 4 * F.lane + 256 * j); } } while (0)
    P8_LOAD(m, d0, d1);
    int mn = m + NGW; int nd0 = 0, nd1 = 0; float nw0 = 0.f, nw1 = 0.f;
    if (mn < NTOK) { nd0 = DST[2 * mn]; nd1 = DST[2 * mn + 1]; nw0 = WTS[2 * mn]; nw1 = WTS[2 * mn + 1]; }
    for (;;) {
        f32x4 v[8];
#pragma unroll
        for (int j = 0; j < 8; ++j) { const f32x4 a = (f32x4){bflo(y0[j].x), bfhi(y0[j].x), bflo(y0[j].y), bfhi(y0[j].y)}, b = (f32x4){bflo(y1[j].x), bfhi(y1[j].x), bflo(y1[j].y), bfhi(y1[j].y)};
            v[j] = hf[j] * ALPHA + (a * w0 + b * w1); }
        const bool more = mn < NTOK;
        const int mc = more ? mn : m;
        { const int da = more ? nd0 : d0, db = more ? nd1 : d1; P8_LOAD(mc, da, db); }
        const int mnn = mn + NGW; const int mi = (mnn < NTOK) ? mnn : m;
        const int xd0 = DST[2 * mi], xd1 = DST[2 * mi + 1]; const float xw0 = WTS[2 * mi], xw1 = WTS[2 * mi + 1];
        ln_row_pre(v, gg, bb);
        if (l == DEPTH - 1) store_row(v, (dummy ? Hfo : F.out) + (size_t)(m - NMETA) * D, nullptr, F.lane);
        else store_row(v, Hfo + (size_t)m * D, Hb + (size_t)m * D, F.lane, dummy ? nullptr : (unsigned char*)(F.ws + WS_HQ + (size_t)m * D));
        if (!more) break;
        m = mn; d0 = nd0; d1 = nd1; w0 = nw0; w1 = nw1; mn = mnn; nd0 = xd0; nd1 = xd1; nw0 = xw0; nw1 = xw1;
    }
#undef P8_LOAD
}

constexpr int PH_PER_LAYER = 10, N_PHASES = 1 + DEPTH * PH_PER_LAYER;
__global__ void __launch_bounds__(NWAVES * 64, 2) mk_fwd(Args args) {
    extern __shared__ __attribute__((aligned(16))) unsigned char lds[];
    Frame F;
    F.lds = (LAS unsigned char*)lds; F.MISC = (volatile LAS unsigned*)(F.lds + MISC_OFF);
    F.tid = threadIdx.x; F.lane = F.tid & 63; F.wave = __builtin_amdgcn_readfirstlane(F.tid >> 6);
    F.G = gridDim.x; { const int bx = blockIdx.x; F.vcu = (F.G % 8 == 0) ? (bx % 8) * (F.G / 8) + bx / 8 : bx; }
    F.ws = (GAS unsigned char*)args.ws; F.ctl = (gu32*)(args.ws + WS_CTL); F.out = args.out;
    for (int u = F.tid; u < (LDS_BYTES - LDSCTL_OFF) / 4; u += NWAVES * 64) ((LAS unsigned*)(F.lds + LDSCTL_OFF))[u] = 0u;
    __syncthreads();
    XcdBarrier bar; bar.bar = (unsigned*)(F.ctl + CW_BAR); bar.x = 0; bar.st = nullptr;
    if (!MK_PER_PHASE) bar = xcd_barrier_post((unsigned*)(F.ctl + CW_BAR), F.MISC + 8);
    const int lo = args.ph_lo, hi = args.ph_hi; KArgs KA = kargs();
#define IN(k) (lo <= (k) && (k) < hi)
#define SEAM(k) do { if (IN(k) && IN((k) + 1)) { if (MK_PER_PHASE) { if (F.tid == 0) __hip_atomic_store(F.ctl + CW_TMO, 0xBADBA0u, RLX_AGENT); } else xcd_barrier(bar); } } while (0)

    if ((MK_MASK & 1u) && IN(0)) { p0_prologue(F, KA); if (MK_REPEAT & 1u) p0_prologue(F, KA); } SEAM(0);

#define REFRESH() do { const int t_ = opaque_tid(); F.tid = t_; F.lane = t_ & 63; F.wave = __builtin_amdgcn_readfirstlane(t_ >> 6); \
        KA = kargs(); GAS unsigned char* w_ = (GAS unsigned char*)KA->ws; asm volatile("" : "+s"(w_)); F.ws = w_; F.ctl = (gu32*)(w_ + WS_CTL); } while (0)
#define LAYER_BODY(l) do { \
        const int pb = 1 + l * PH_PER_LAYER; \
        if ((MK_MASK & 2u) && IN(pb + 0)) for (int rep = 0; rep < ((MK_REPEAT & 2u) ? 2 : 1); ++rep) { REFRESH(); \
            { pg8::OrderDenseR S{(const char*)(F.ws + WS_HB), (const char*)(F.ws + WS_WIN) + (size_t)l * NIN_T * D * 2, (size_t)256 * D * 2, (size_t)256 * D * 2, MP / 256, ZC_GZ / 256 + 1, F.G, (int)blockIdx.x, 52}; \
              pg8::EpiZ E{(bf16*)(F.ws + WS_Z), (float*)(F.ws + WS_ZS), 1.f}; \
              pg8::gemm_phase<pg8::EpiZ, pg8::OrderDenseR>(F.lds, pg8::Gemm{D, D, D}, S, E); } \
            REFRESH(); \
            { pg8::OrderDenseQ S{(const char*)(F.ws + WS_HQ), (const char*)(F.ws + WS_WQ) + (size_t)l * 4 * D * D, (size_t)256 * D, (size_t)256 * D, MP / 256, ZC_GZ / 256, \
                                 (unsigned*)(F.ctl + CW_QG1 + 256 * l + 128 * rep), (int)(blockIdx.x & 7), F.MISC + 2}; \
              pg8::EpiZG E{(bf16*)(F.ws + WS_Z), KA->in[I_GATEB] + (size_t)l * 4 * D, 1.f / WQ_SCALE}; \
              pg8::gemm_phase<pg8::EpiZG, pg8::OrderDenseQ, true, true>(F.lds, pg8::Gemm{D / 2, D / 2, D / 2}, S, E); } \
            if (rep == ((MK_REPEAT & 2u) ? 1 : 0)) SEAM(pb + 0); else if (MK_REPBAR) xcd_barrier(bar); \
        } \
        if ((MK_MASK & 4u) && IN(pb + 1)) for (int rep = 0; rep < ((MK_REPEAT & 4u) ? 2 : 1); ++rep) { REFRESH(); \
            constexpr int N0 = 4, N1 = N0 + NCHUNK * 4, N2 = N1 + NCHUNK; \
            for (int it = F.vcu; it < N2; it += F.G) { \
                if (it < N0) p2a_cumsum(F, KA, l, it); \
                else if (it < N1) { const int q = it - N0; gla_stage1(F, KA, l, q >> 2, q & 3); } \
                else norm_item(F, l, it - N1); \
            } \
            if (rep == ((MK_REPEAT & 4u) ? 1 : 0)) SEAM(pb + 1); else if (MK_REPBAR) xcd_barrier(bar); \
        } \
        if ((MK_MASK & 8u) && IN(pb + 2)) for (int rep = 0; rep < ((MK_REPEAT & 8u) ? 2 : 1); ++rep) { REFRESH(); \
            const bf16* Z = (const bf16*)(F.ws + WS_Z); \
            for (bool first_ = true;; first_ = false) { \
                int it = F.vcu;     \
                if (!first_) { if (F.tid == 0) F.MISC[0] = __hip_atomic_fetch_add((unsigned*)(F.ctl + CW_QATT + 64 * l + 16 * rep), 1u, RLX_AGENT); \
                    __syncthreads(); \
                    it = (int)F.MISC[0] + F.G; \
                    __syncthreads(); } \
                constexpr int QA = att_sbase(2); \
                if (it >= SCAN_ITEMS + ATT_NU) break; \
                if (it >= QA && it < QA + SCAN_ITEMS) { gla_scan_item(F, it - QA); continue; } \
                const int u = it < QA ? it : it - SCAN_ITEMS; \
                int qb, s, h; att_decode(u, qb, s, h); \
                const int T = 4 * (qb + 1), jb = T - s * ATT_SEG; int ja = jb - ATT_SEG > 0 ? jb - ATT_SEG : 0; \
                const float* nck = (const float*)(F.ws + WS_C2) + (size_t)h * MP; float* MLp = (float*)(F.ws + WS_ML) + (size_t)u * 256 * 2; \
                { const float q2 = __builtin_bit_cast(float, __hip_atomic_load((unsigned*)(F.ctl + CW_NRM + 64 * l + 2 * h), RLX_AGENT)), k2 = __builtin_bit_cast(float, __hip_atomic_load((unsigned*)(F.ctl + CW_NRM + 64 * l + 2 * h + 1), RLX_AGENT)); \
                  const float thr = nck[qb * 256] - 2.f * LOG2E * 0.08838834764831845f * sqrtf(q2 * k2) - 150.f; \
                  const int jj = ja + F.lane; const bool keep = (jj < jb) && (nck[64 * (jj < jb ? jj : ja) + 63] >= thr); \
                  const unsigned long long bm = __ballot(keep); ja = bm ? ja + (int)__builtin_ctzll(bm) : jb; } \
                if (ja >= jb) { if (F.tid < 256) *(f32x2*)(MLp + 2 * F.tid) = (f32x2){-1e30f, 0.f}; continue; } \
                att::attn_unit(Z + ZC_FQ + h * 128, Z + ZC_FK + h * 128, Z + ZC_FV + h * 128, nck, qb * 256, ja, jb, \
                               (float*)(F.ws + WS_OPART) + (size_t)u * 256 * 128, MLp, F.lds); \
            } \
            REFRESH(); \
            for (bool first_ = true;; first_ = false) { \
                int it = F.vcu; \
                if (!first_) { if (F.tid == 0) F.MISC[0] = __hip_atomic_fetch_add((unsigned*)(F.ctl + CW_QATT + 64 * l + 48 + 8 * rep), 1u, RLX_AGENT); \
                    __syncthreads(); \
                    it = (int)F.MISC[0] + F.G; \
                    __syncthreads(); } \
                if (it >= NCHUNK * 5) break; \
                if (it < NCHUNK) conv_item(F, KA, l, it); else { const int q_ = it - NCHUNK; pool_item(F, KA, l, q_ >> 2, q_ & 3); } \
            } \
            if (rep == ((MK_REPEAT & 8u) ? 1 : 0)) SEAM(pb + 2); else if (MK_REPBAR) xcd_barrier(bar); \
        } \
        if ((MK_MASK & 16u) && IN(pb + 3)) for (int rep = 0; rep < ((MK_REPEAT & 16u) ? 2 : 1); ++rep) { REFRESH(); \
            constexpr int N0 = NCHUNK * 4, N1 = N0 + ATT_NQB * 4; \
            for (bool first_ = true;; first_ = false) { \
                int it = F.vcu; \
                if (!first_) { if (F.tid == 0) F.MISC[0] = __hip_atomic_fetch_add((unsigned*)(F.ctl + CW_QATT + 64 * l + 32 + 8 * rep), 1u, RLX_AGENT); \
                    __syncthreads(); \
                    it = (int)F.MISC[0] + F.G; \
                    __syncthreads(); } \
                if (it >= N1) break; \
                if (it < N0) gla_stage3(F, KA, l, it >> 2, it & 3); \
                else { const int q = it - N0; att_combine(F, q >> 2, q & 3); } \
            } \
            if (rep == ((MK_REPEAT & 16u) ? 1 : 0)) SEAM(pb + 3); else if (MK_REPBAR) xcd_barrier(bar); \
        } \
        if ((MK_MASK & 32u) && IN(pb + 4)) for (int rep = 0; rep < ((MK_REPEAT & 32u) ? 2 : 1); ++rep) { REFRESH(); \
            pg8::OrderDense S{(const char*)(F.ws + WS_OM) + (size_t)NMETA * D * 2, (const char*)(F.ws + WS_WBR) + (size_t)l * D * D * 2, (size_t)256 * D * 2, (size_t)256 * D * 2, SEQ / 256, D / 256, F.G, (int)blockIdx.x}; \
            pg8::EpiMergeSeg E{(const bf16*)(F.ws + WS_Z), KA->in[I_GATEB] + (size_t)l * 4 * D, (bf16*)(F.ws + WS_MX), NMETA}; \
            if (l != DEPTH - 1) p3_meta(F, KA, l);     \
            pg8::gemm_phase<pg8::EpiMergeSeg, pg8::OrderDense>(F.lds, pg8::Gemm{D, D, D}, S, E); \
            if (rep == ((MK_REPEAT & 32u) ? 1 : 0)) SEAM(pb + 4); else if (MK_REPBAR) xcd_barrier(bar); \
        } \
        if ((MK_MASK & 64u) && IN(pb + 5)) for (int rep = 0; rep < ((MK_REPEAT & 64u) ? 2 : 1); ++rep) { REFRESH(); \
            pg8::OrderDense S{(const char*)(F.ws + WS_MX) + (size_t)NMETA * D * 2, (const char*)(F.ws + WS_WOUT) + (size_t)l * D * D * 2, (size_t)256 * D * 2, (size_t)256 * D * 2, SEQ / 256, D / 256, F.G, (int)blockIdx.x}; \
            pg8::EpiBf16 E{(bf16*)(F.ws + WS_MO), D, NMETA}; \
            if (l != DEPTH - 1) p4_meta(F, l); \
            pg8::gemm_phase<pg8::EpiBf16, pg8::OrderDense>(F.lds, pg8::Gemm{D, D, D}, S, E); \
            if (rep == ((MK_REPEAT & 64u) ? 1 : 0)) SEAM(pb + 5); else if (MK_REPBAR) xcd_barrier(bar); \
        } \
        if ((MK_MASK & 128u) && IN(pb + 6)) for (int rep = 0; rep < ((MK_REPEAT & 128u) ? 2 : 1); ++rep) { REFRESH(); p5a_ln_router(F, KA, l, (MK_REPEAT & 128u) && rep == 0); if (rep == ((MK_REPEAT & 128u) ? 1 : 0)) SEAM(pb + 6); else if (MK_REPBAR) xcd_barrier(bar); } \
        if ((MK_MASK & 256u) && IN(pb + 7)) for (int rep = 0; rep < ((MK_REPEAT & 256u) ? 2 : 1); ++rep) { REFRESH(); p5b_scatter(F, l, (MK_REPEAT & 256u) && rep == 0); if (rep == ((MK_REPEAT & 256u) ? 1 : 0)) SEAM(pb + 7); else if (MK_REPBAR) xcd_barrier(bar); } \
        if ((MK_MASK & 512u) && IN(pb + 8)) { REFRESH(); \
            const int ntiles = moe_tables(F, l, (LAS int*)(F.lds + MISC_OFF + 128), (LAS int*)(F.lds + MISC_OFF + 128 + 512)); \
            { pg8::OrderMoeF S{(const char*)(F.ws + WS_XR), KA->in[I_WG] + (size_t)l * NEXP * D * DEXP, KA->in[I_WU] + (size_t)l * NEXP * D * DEXP, 256u * D * 2u, \
                             (const LAS int*)(F.lds + MISC_OFF + 128), ntiles, F.G, F.vcu, true}; \
              pg8::EpiSwiGLU E{(bf16*)(F.ws + WS_HM), (unsigned*)(F.ctl + CW_RDY + 256 * l)}; \
              pg8::gemm_phase_breg<pg8::EpiSwiGLU, pg8::OrderMoeF>(F.lds, pg8::Gemm{D, DEXP, D}, S, E); } \
            REFRESH(); \
            { pg8::OrderMoeDyn S{(const char*)(F.ws + WS_HM), KA->in[I_WD] + (size_t)l * NEXP * D * DEXP, 256u * DEXP * 2u, (const LAS int*)(F.lds + MISC_OFF + 128), ntiles * 8, \
                             (unsigned*)(F.ctl + CW_QMOE + 64 * l), (unsigned*)(F.ctl + CW_RDY + 256 * l), (unsigned*)(F.ctl + CW_BAR) + XB_TMO, F.MISC + 2}; \
              pg8::EpiBf16 E{(bf16*)(F.ws + WS_Y), D, 0}; \
              pg8::gemm_phase_breg<pg8::EpiBf16, pg8::OrderMoeDyn>(F.lds, pg8::Gemm{DEXP, D, DEXP}, S, E); } \
            SEAM(pb + 8); \
        } \
        if ((MK_MASK & 2048u) && IN(pb + 9)) for (int rep = 0; rep < ((MK_REPEAT & 2048u) ? 2 : 1); ++rep) { REFRESH(); p8_ln2(F, KA, l, (MK_REPEAT & 2048u) && rep == 0); if (rep == ((MK_REPEAT & 2048u) ? 1 : 0)) SEAM(pb + 9); else if (MK_REPBAR) xcd_barrier(bar); } \
    } while (0)
    LAYER_BODY(0);
    LAYER_BODY(1);
#undef LAYER_BODY
#undef IN
#undef SEAM
#undef REFRESH
}

extern "C" void kernel_launch(void* const* d_in, const int* in_sizes, int n_in, void* d_out, int out_size, void* d_ws, size_t ws_size, hipStream_t stream) {
    static int grid = 0;
    if (grid == 0) {
        if (n_in != 24 || out_size != SEQ * D || ws_size < WS_END) { fprintf(stderr, "kernel_launch: unexpected shapes (n_in %d, out %d, ws %zu < %zu)\n", n_in, out_size, ws_size, (size_t)WS_END); grid = -1; return; }
        int dev = 0, cus = 0, per_cu = 0;
        if (hipGetDevice(&dev) != hipSuccess || hipDeviceGetAttribute(&cus, hipDeviceAttributeMultiprocessorCount, dev) != hipSuccess) { grid = -1; return; }
        if (hipFuncSetAttribute((const void*)mk_fwd, hipFuncAttributeMaxDynamicSharedMemorySize, LDS_BYTES) != hipSuccess) { fprintf(stderr, "kernel_launch: hipFuncSetAttribute failed\n"); grid = -1; return; }
        if (hipOccupancyMaxActiveBlocksPerMultiprocessor(&per_cu, (const void*)mk_fwd, NWAVES * 64, LDS_BYTES) != hipSuccess || per_cu < 1) { fprintf(stderr, "kernel_launch: occupancy query says %d blocks per CU\n", per_cu); }
        (void)hipGetLastError();
        grid = cus;
    }
    if (grid < 0) return;
    if (hipMemsetAsync((char*)d_ws + WS_CTL, 0, CTL_BYTES, stream) != hipSuccess) return;
    Args a{};
    for (int i = 0; i < 24; ++i) a.in[i] = (const float*)d_in[i];
    a.out = (float*)d_out; a.ws = (unsigned char*)d_ws;
#if MK_PER_PHASE
    for (int p = 0; p < N_PHASES; ++p) { a.ph_lo = p; a.ph_hi = p + 1; hipLaunchKernelGGL(mk_fwd, dim3(grid), dim3(NWAVES * 64), LDS_BYTES, stream, a); }
#else
    a.ph_lo = 0; a.ph_hi = N_PHASES;
    hipLaunchKernelGGL(mk_fwd, dim3(grid), dim3(NWAVES * 64), LDS_BYTES, stream, a);
#endif
}
```
